# Optimizing an MI355X kernel written in HIP

```python
import math
import jax
import jax.numpy as jnp
from jax import lax
import numpy as np

D_MODEL = 1024
BATCH = 16
SEQ = 2048
DEPTH = 2

HEAD_DIM = 64
BLOCK = 128
NSA_HEADS = 4
NSA_KV_HEADS = 1
CMP_LEN = 32
CMP_STRIDE = 16
SEL_LEN = 64
N_SEL = 16
NSA_WINDOW = 512
SEL_Q_BLOCK = 64
SWA_HEADS = 4
SWA_KV_HEADS = 2
SWA_WINDOW = 128
DIL_PATTERNS = ((128, 1), (512, 4), (2048, 16))
DIL_HEADS_PER_GROUP = 4
DIL_Q_HEADS = len(DIL_PATTERNS) * DIL_HEADS_PER_GROUP
DIL_KV_HEADS = 4
SB_HEADS = 4
N_BRANCHES = 4
BRANCH_WIDTH = 4 * HEAD_DIM
NUM_BUCKETS = 32
MAX_DISTANCE = 2048
N_BIAS_HEADS = NSA_HEADS + SWA_HEADS + DIL_Q_HEADS
D_FF_DENSE = 2816
N_EXPERTS = 8
TOP_K = 2
D_FF_EXPERT = 3584
N_DENSE_LAYERS = (DEPTH + 1) // 2
N_MOE_LAYERS = DEPTH // 2
ALPHA = (2 * DEPTH) ** 0.25
BETA = (8 * DEPTH) ** -0.25
LN_EPS = 1e-5
NEG_INF = -1e30
TINY = 1e-30
FORCE_SCORE = 1e4

IN_SPLITS = (
    ('nsa_q', NSA_HEADS * HEAD_DIM), ('nsa_k_cmp', NSA_KV_HEADS * HEAD_DIM), ('nsa_v_cmp', NSA_KV_HEADS * HEAD_DIM),
    ('nsa_k_sel', NSA_KV_HEADS * HEAD_DIM), ('nsa_v_sel', NSA_KV_HEADS * HEAD_DIM),
    ('nsa_k_win', NSA_KV_HEADS * HEAD_DIM), ('nsa_v_win', NSA_KV_HEADS * HEAD_DIM), ('nsa_gate', NSA_HEADS * 3),
    ('swa_q', SWA_HEADS * HEAD_DIM), ('swa_k', SWA_KV_HEADS * HEAD_DIM), ('swa_v', SWA_KV_HEADS * HEAD_DIM),
    ('dil_q', DIL_Q_HEADS * HEAD_DIM), ('dil_k', DIL_KV_HEADS * HEAD_DIM), ('dil_v', DIL_KV_HEADS * HEAD_DIM),
    ('sb_q', SB_HEADS * HEAD_DIM), ('sb_k', SB_HEADS * HEAD_DIM), ('sb_v', SB_HEADS * HEAD_DIM),
    ('merge_gate', N_BRANCHES * D_MODEL),
)
D_IN = sum(sz for _, sz in IN_SPLITS)

kernel_name = 'hybrid_nsa_swa_dilated_stickbreak_moe_block'


def split_cols(z):
    out = {}
    off = 0
    for name, size in IN_SPLITS:
        out[name] = z[..., off:off + size]
        off += size
    return out


def layer_norm(x):
    x32 = x.astype(jnp.float32)
    mu = x32.mean(-1, keepdims=True)
    var = jnp.square(x32 - mu).mean(-1, keepdims=True)
    return ((x32 - mu) * lax.rsqrt(var + LN_EPS)).astype(x.dtype)


def t5_bucket(dist):
    dist = jnp.maximum(dist, 0)
    max_exact = NUM_BUCKETS // 2
    d_f = jnp.maximum(dist, 1).astype(jnp.float32)
    large = max_exact + (jnp.log(d_f / max_exact) / math.log(MAX_DISTANCE / max_exact)
                         * (NUM_BUCKETS - max_exact)).astype(jnp.int32)
    large = jnp.minimum(large, NUM_BUCKETS - 1)
    return jnp.where(dist < max_exact, dist, large)


def banded_attention(q, k, v, n_back, bias_tbl, dist_mult, sink=None):
    n, length, h, dh = q.shape
    g = k.shape[2]
    r = h // g
    blk = min(BLOCK, length)
    nb = -(-length // blk)
    lp = nb * blk
    n_prev = -(-n_back // blk)
    span = (n_prev + 1) * blk
    pad_end = lp - length
    qp = jnp.pad(q, ((0, 0), (0, pad_end), (0, 0), (0, 0))).reshape(n, nb, blk, g, r, dh)
    kv_pad = ((0, 0), (n_prev * blk, pad_end), (0, 0), (0, 0))
    kp = jnp.pad(k, kv_pad)
    vp = jnp.pad(v, kv_pad)

    def band(a):
        return jnp.concatenate(
            [a[:, j * blk:(j + nb) * blk].reshape(n, nb, blk, g, dh) for j in range(n_prev + 1)], axis=2)

    kb, vb = band(kp), band(vp)
    dist = np.arange(blk)[:, None] + n_prev * blk - np.arange(span)[None, :]
    local_ok = (dist >= 0) & (dist <= n_back)
    front_ok = (np.arange(nb)[:, None] - n_prev) * blk + np.arange(span)[None, :] >= 0
    mask = local_ok[None] & front_ok[:, None, :]
    bias = bias_tbl[t5_bucket(jnp.asarray(dist * dist_mult))]
    bias = jnp.transpose(bias, (2, 0, 1)).reshape(g, r, blk, span).astype(jnp.float32)
    s = jnp.einsum('nbqgrd,nbkgd->nbgrqk', qp, kb).astype(jnp.float32) / math.sqrt(dh)
    s = jnp.where(mask[None, :, None, None], s + bias, NEG_INF)
    m = s.max(-1)
    if sink is not None:
        sink_f = sink.astype(jnp.float32).reshape(g, r, 1)
        m = jnp.maximum(m, sink_f)
    p = jnp.exp(s - m[..., None])
    den = p.sum(-1)
    if sink is not None:
        den = den + jnp.exp(sink_f - m)
    o = jnp.einsum('nbgrqk,nbkgd->nbqgrd', p.astype(v.dtype), vb)
    o = o / jnp.transpose(den, (0, 1, 4, 2, 3))[..., None].astype(v.dtype)
    o = o.reshape(n, lp, h, dh)[:, :length]
    lse = jnp.transpose(m + jnp.log(den), (0, 1, 4, 2, 3)).reshape(n, lp, h)[:, :length]
    return o, lse


def compress_blocks(a, pe, w1, w2):
    b, s, g, dh = a.shape
    ratio = CMP_LEN // CMP_STRIDE
    n_chunk = s // CMP_STRIDE
    n_cmp = n_chunk - ratio + 1
    chunks = a.reshape(b, n_chunk, CMP_STRIDE, g, dh)
    blocks = jnp.concatenate([chunks[:, j:j + n_cmp] for j in range(ratio)], axis=2)
    blocks = blocks + pe[None, None, :, None, :]
    flat = jnp.transpose(blocks, (0, 1, 3, 2, 4)).reshape(b, n_cmp, g, CMP_LEN * dh)
    return jax.nn.gelu(flat @ w1) @ w2


def nsa_mixer(q, k_cmp, v_cmp, k_sel, v_sel, k_win, v_win, gate_logits, cmp_pe, cmp_w1, cmp_w2, bias_tbl):
    b, s, h, dh = q.shape
    g = k_cmp.shape[2]
    r = h // g
    qg = q.reshape(b, s, g, r, dh)
    pos = jnp.arange(s)
    kc = compress_blocks(k_cmp, cmp_pe[0], cmp_w1[0], cmp_w2[0])
    vc = compress_blocks(v_cmp, cmp_pe[1], cmp_w1[1], cmp_w2[1])
    n_cmp = kc.shape[1]
    cmp_end = jnp.arange(n_cmp) * CMP_STRIDE + CMP_LEN - 1
    cmp_ok = (cmp_end[None, :] <= pos[:, None])[None, :, None, None, :]
    sc = jnp.einsum('btgrd,bigd->btgri', qg, kc).astype(jnp.float32) / math.sqrt(dh)
    sc = jnp.where(cmp_ok, sc, NEG_INF)
    p = jnp.exp(sc - sc.max(-1, keepdims=True)) * cmp_ok
    p = p / jnp.maximum(p.sum(-1, keepdims=True), TINY)
    o_cmp = jnp.einsum('btgri,bigd->btgrd', p.astype(vc.dtype), vc).reshape(b, s, h, dh)
    n_blk = s // SEL_LEN
    n_blk_pad = max(n_blk, N_SEL)
    ci = np.arange(n_cmp)[:, None]
    sj = np.arange(n_blk_pad)[None, :]
    overlap = ((ci * CMP_STRIDE + CMP_LEN - 1 >= sj * SEL_LEN) & (ci * CMP_STRIDE < (sj + 1) * SEL_LEN)
               & (sj < n_blk)).astype(np.float32)
    blk_score = jnp.einsum('btgi,ij->btgj', p.sum(3), overlap)
    cur = pos // SEL_LEN
    jj = jnp.arange(n_blk_pad)
    forced = (jj[None] == 0) | (jj[None] == cur[:, None]) | (jj[None] == cur[:, None] - 1)
    future = jj[None] > cur[:, None]
    blk_score = jnp.where(forced[None, :, None], FORCE_SCORE,
                          jnp.where(future[None, :, None], NEG_INF, blk_score))
    _, sel_idx = lax.top_k(blk_score, N_SEL)
    pad_len = n_blk_pad * SEL_LEN - s

    def to_blocks(a):
        a = jnp.pad(a, ((0, 0), (0, pad_len), (0, 0), (0, 0)))
        return jnp.transpose(a.reshape(b, n_blk_pad, SEL_LEN, g, dh), (0, 3, 1, 2, 4))

    kb, vb = to_blocks(k_sel), to_blocks(v_sel)
    n_chunks = s // SEL_Q_BLOCK
    q_c = jnp.transpose(qg.reshape(b, n_chunks, SEL_Q_BLOCK, g, r, dh), (1, 0, 2, 3, 4, 5))
    idx_c = jnp.transpose(sel_idx.reshape(b, n_chunks, SEL_Q_BLOCK, g, N_SEL), (1, 0, 3, 2, 4))
    pos_c = pos.reshape(n_chunks, SEL_Q_BLOCK)
    gather = jax.vmap(jax.vmap(lambda tbl, ix: tbl[ix]))
    tbl_g = jnp.transpose(bias_tbl.reshape(NUM_BUCKETS, g, r), (1, 0, 2))
    lookup = jax.vmap(lambda tb, bk: tb[bk], in_axes=(0, 1), out_axes=1)

    def sel_chunk(args):
        qq, ix, qpos = args
        kg = gather(kb, ix)
        vg = gather(vb, ix)
        kpos = ix[..., None] * SEL_LEN + jnp.arange(SEL_LEN)
        dist = qpos[None, None, :, None, None] - kpos
        ok = dist >= 0
        bias = jnp.transpose(lookup(tbl_g, t5_bucket(dist)), (0, 1, 2, 5, 3, 4)).astype(jnp.float32)
        sc_s = jnp.einsum('btgrd,bgtnsd->bgtrns', qq, kg).astype(jnp.float32) / math.sqrt(dh) + bias
        sc_s = jnp.where(ok[:, :, :, None], sc_s, NEG_INF)
        tq = qq.shape[1]
        p_s = jax.nn.softmax(sc_s.reshape(b, g, tq, r, N_SEL * SEL_LEN), axis=-1)
        return jnp.einsum('bgtrk,bgtkd->btgrd', p_s.astype(vg.dtype), vg.reshape(b, g, tq, N_SEL * SEL_LEN, dh))

    o_sel = lax.map(sel_chunk, (q_c, idx_c, pos_c))
    o_sel = jnp.transpose(o_sel, (1, 0, 2, 3, 4, 5)).reshape(b, s, h, dh)
    o_win, _ = banded_attention(q, k_win, v_win, NSA_WINDOW - 1, bias_tbl, 1)
    gt = jax.nn.sigmoid(gate_logits.reshape(b, s, h, 3))
    o = gt[..., 0:1] * o_cmp + gt[..., 1:2] * o_sel + gt[..., 2:3] * o_win
    return o.reshape(b, s, h * dh)


def dilated_mixer(q, k, v, bias_tbl):
    b, s, _, dh = q.shape
    hh = DIL_HEADS_PER_GROUP
    outs = []
    lses = []
    for gi, (win, dil) in enumerate(DIL_PATTERNS):
        L = s // dil

        def to_residue(a):
            return jnp.transpose(a.reshape(b, L, dil, a.shape[2], dh), (0, 2, 1, 3, 4)).reshape(b * dil, L, a.shape[2], dh)

        o, lse = banded_attention(to_residue(q[:, :, gi * hh:(gi + 1) * hh]), to_residue(k), to_residue(v),
                                  win // dil, bias_tbl[:, gi * hh:(gi + 1) * hh], dil)
        outs.append(jnp.transpose(o.reshape(b, dil, L, hh, dh), (0, 2, 1, 3, 4)).reshape(b, s, hh, dh))
        lses.append(jnp.transpose(lse.reshape(b, dil, L, hh), (0, 2, 1, 3)).reshape(b, s, hh))
    wts = jax.nn.softmax(jnp.stack(lses, 0), axis=0)
    o = jnp.sum(wts[..., None].astype(q.dtype) * jnp.stack(outs, 0), axis=0)
    return o.reshape(b, s, hh * dh)


def stick_breaking(q, k, v):
    b, s, h, dh = q.shape
    blk = min(BLOCK, s)
    nb = s // blk
    q_c = jnp.transpose(q.reshape(b, nb, blk, h, dh), (1, 0, 2, 3, 4))
    pos_c = jnp.arange(s).reshape(nb, blk)
    kpos = jnp.arange(s)

    def block_fn(args):
        qq, qpos = args
        z = jnp.einsum('bqhd,bkhd->bhqk', qq, k).astype(jnp.float32) / math.sqrt(dh)
        strict = (kpos[None, :] < qpos[:, None])[None, None]
        log_fail = jnp.where(strict, jax.nn.log_sigmoid(-z), 0.0)
        after = lax.cumsum(log_fail, axis=3, reverse=True) - log_fail
        a = jnp.where(strict, jnp.exp(jax.nn.log_sigmoid(z) + after), 0.0)
        return jnp.einsum('bhqk,bkhd->bqhd', a.astype(v.dtype), v)

    o = lax.map(block_fn, (q_c, pos_c))
    return jnp.transpose(o, (1, 0, 2, 3, 4)).reshape(b, s, h * dh)


def mixer_sublayer(h, w_in, w_branch, w_out, cmp_pe, cmp_w1, cmp_w2, sinks, rel_bias):
    b, s, _ = h.shape
    cols = split_cols(h @ w_in)

    def heads(name, n):
        return cols[name].reshape(b, s, n, HEAD_DIM)

    o_a = nsa_mixer(heads('nsa_q', NSA_HEADS), heads('nsa_k_cmp', NSA_KV_HEADS), heads('nsa_v_cmp', NSA_KV_HEADS),
                    heads('nsa_k_sel', NSA_KV_HEADS), heads('nsa_v_sel', NSA_KV_HEADS),
                    heads('nsa_k_win', NSA_KV_HEADS), heads('nsa_v_win', NSA_KV_HEADS), cols['nsa_gate'],
                    cmp_pe, cmp_w1, cmp_w2, rel_bias[:, :NSA_HEADS])
    o_b, _ = banded_attention(heads('swa_q', SWA_HEADS), heads('swa_k', SWA_KV_HEADS), heads('swa_v', SWA_KV_HEADS),
                              SWA_WINDOW - 1, rel_bias[:, NSA_HEADS:NSA_HEADS + SWA_HEADS], 1, sinks)
    o_b = o_b.reshape(b, s, BRANCH_WIDTH)
    o_c = dilated_mixer(heads('dil_q', DIL_Q_HEADS), heads('dil_k', DIL_KV_HEADS), heads('dil_v', DIL_KV_HEADS),
                        rel_bias[:, NSA_HEADS + SWA_HEADS:])
    o_d = stick_breaking(heads('sb_q', SB_HEADS), heads('sb_k', SB_HEADS), heads('sb_v', SB_HEADS))
    gates = jax.nn.sigmoid(cols['merge_gate'].reshape(b, s, N_BRANCHES, D_MODEL))
    merged = (gates[:, :, 0] * (o_a @ w_branch[0]) + gates[:, :, 1] * (o_b @ w_branch[1])
              + gates[:, :, 2] * (o_c @ w_branch[2]) + gates[:, :, 3] * (o_d @ w_branch[3]))
    return merged @ w_out


def swiglu(h, w_gate, w_up, w_down):
    return (jax.nn.silu(h @ w_gate) * (h @ w_up)) @ w_down


def moe_ffn(h, w_router, e_gate, e_up, e_down):
    logits = (h @ w_router).astype(jnp.float32)
    top_val, top_idx = lax.top_k(logits, TOP_K)
    top_w = jax.nn.softmax(top_val, axis=-1)
    gates = jnp.sum(jax.nn.one_hot(top_idx, N_EXPERTS, dtype=jnp.float32) * top_w[..., None], axis=-2)
    y = jnp.zeros_like(h)
    for e in range(N_EXPERTS):
        y = y + gates[..., e:e + 1].astype(h.dtype) * swiglu(h, e_gate[e], e_up[e], e_down[e])
    return y


def setup_inputs(seed: int = 0) -> dict:
    key = jax.random.key(seed)
    ks = jax.random.split(key, 21)

    def nrm(k, shape, scale):
        return jax.random.normal(k, shape, jnp.float32) * scale

    return {
        'x': nrm(ks[0], (BATCH, SEQ, D_MODEL), 1.0),
        'c': nrm(ks[1], (BATCH, D_MODEL), 1.0),
        'rel_bias': nrm(ks[2], (NUM_BUCKETS, N_BIAS_HEADS), 0.5),
        'w_ada': nrm(ks[3], (DEPTH, D_MODEL, 6 * D_MODEL), 0.5 * D_MODEL ** -0.5),
        'b_ada': nrm(ks[4], (DEPTH, 6 * D_MODEL), 0.01),
        'w_in': nrm(ks[5], (DEPTH, D_MODEL, D_IN), D_MODEL ** -0.5),
        'w_branch': nrm(ks[6], (DEPTH, N_BRANCHES, BRANCH_WIDTH, D_MODEL), BETA * BRANCH_WIDTH ** -0.5),
        'w_out': nrm(ks[7], (DEPTH, D_MODEL, D_MODEL), BETA * D_MODEL ** -0.5),
        'cmp_pe': nrm(ks[8], (DEPTH, 2, CMP_LEN, HEAD_DIM), 0.1),
        'cmp_w1': nrm(ks[9], (DEPTH, 2, CMP_LEN * HEAD_DIM, HEAD_DIM), (CMP_LEN * HEAD_DIM) ** -0.5),
        'cmp_w2': nrm(ks[10], (DEPTH, 2, HEAD_DIM, HEAD_DIM), HEAD_DIM ** -0.5),
        'swa_sinks': nrm(ks[11], (DEPTH, SWA_HEADS), 1.0),
        'ln_g': 1.0 + nrm(ks[12], (DEPTH, 2, D_MODEL), 0.02),
        'ln_b': nrm(ks[13], (DEPTH, 2, D_MODEL), 0.02),
        'ffn_w_gate': nrm(ks[14], (N_DENSE_LAYERS, D_MODEL, D_FF_DENSE), D_MODEL ** -0.5),
        'ffn_w_up': nrm(ks[15], (N_DENSE_LAYERS, D_MODEL, D_FF_DENSE), D_MODEL ** -0.5),
        'ffn_w_down': nrm(ks[16], (N_DENSE_LAYERS, D_FF_DENSE, D_MODEL), BETA * D_FF_DENSE ** -0.5),
        'moe_router': nrm(ks[17], (N_MOE_LAYERS, D_MODEL, N_EXPERTS), D_MODEL ** -0.5),
        'moe_w_gate': nrm(ks[18], (N_MOE_LAYERS, N_EXPERTS, D_MODEL, D_FF_EXPERT), D_MODEL ** -0.5),
        'moe_w_up': nrm(ks[19], (N_MOE_LAYERS, N_EXPERTS, D_MODEL, D_FF_EXPERT), D_MODEL ** -0.5),
        'moe_w_down': nrm(ks[20], (N_MOE_LAYERS, N_EXPERTS, D_FF_EXPERT, D_MODEL), BETA * D_FF_EXPERT ** -0.5),
    }


def reference(x, c, rel_bias, w_ada, b_ada, w_in, w_branch, w_out, cmp_pe, cmp_w1, cmp_w2, swa_sinks,
              ln_g, ln_b, ffn_w_gate, ffn_w_up, ffn_w_down, moe_router, moe_w_gate, moe_w_up, moe_w_down):
    for layer in range(DEPTH):
        mod = jax.nn.silu(c) @ w_ada[layer] + b_ada[layer]
        sh1, sc1, g1, sh2, sc2, g2 = jnp.split(mod, 6, axis=-1)
        h = layer_norm(x) * (1.0 + sc1[:, None]) + sh1[:, None]
        y = mixer_sublayer(h, w_in[layer], w_branch[layer], w_out[layer], cmp_pe[layer], cmp_w1[layer],
                           cmp_w2[layer], swa_sinks[layer], rel_bias)
        x = layer_norm(ALPHA * x + g1[:, None] * y) * ln_g[layer, 0] + ln_b[layer, 0]
        h = layer_norm(x) * (1.0 + sc2[:, None]) + sh2[:, None]
        if layer % 2 == 0:
            i = layer // 2
            y = swiglu(h, ffn_w_gate[i], ffn_w_up[i], ffn_w_down[i])
        else:
            i = layer // 2
            y = moe_ffn(h, moe_router[i], moe_w_gate[i], moe_w_up[i], moe_w_down[i])
        x = layer_norm(ALPHA * x + g2[:, None] * y) * ln_g[layer, 1] + ln_b[layer, 1]
    return x
```

```cpp
#include <hip/hip_runtime.h>
#include <cstdio>
#include <cstdint>

namespace pg8 {
#define PG8_LAS __attribute__((address_space(3)))
typedef unsigned short bf16_t;
typedef short bf16x8 __attribute__((ext_vector_type(8)));
typedef float f32x4 __attribute__((ext_vector_type(4)));
typedef unsigned u32x4 __attribute__((ext_vector_type(4)));
constexpr int BM = 256, BK = 64, HALF = 128, HTB = HALF * BK * 2  , STAGE_BYTES = 8 * HTB, NXCD = 8, WGM = 8;

__host__ __device__ __forceinline__ int lds_byte(int r, int c) { const int st = (r >> 4) * 2 + (c >> 5), rr = r & 15, cc = c & 31, ob = rr * 64 + cc * 2; return st * 1024 + (ob ^ (((ob >> 9) & 1) << 5)); }
__host__ __device__ __forceinline__ void stage_rc(int b, int& R, int& C) { const int st = b / 1024, sb = b % 1024, swz = sb ^ (((sb >> 9) & 1) << 5); R = (st >> 1) * 16 + swz / 64; C = (st & 1) * 32 + (swz % 64) / 2; }
__host__ __device__ __forceinline__ int perm32(int rho) { const int n = rho >> 4, i = rho & 15; return 8 * (i >> 2) + 4 * n + (i & 3); }

struct Unit { int pm, pn, ko, kl; };
struct Gemm { const bf16_t* A; const bf16_t* Bt; int M, N, K; };

struct StaticOrder {
    int nM, nN, nwg, G, c, kl;
    __host__ __device__ void init(int M, int N, int G_, int c_, int kl_) { nM = M / BM; nN = N / BM; nwg = nM * nN; G = G_; c = c_; kl = kl_; }
    __host__ __device__ bool next(int i, Unit& u) const {
        const long L = (long)i * G + c; if (L >= nwg) return false;
        int wgid = (int)L; { const int q = nwg / NXCD, r = nwg % NXCD, xcd = wgid % NXCD, off = wgid / NXCD; wgid = (xcd < r ? xcd * (q + 1) : r * (q + 1) + (xcd - r) * q) + off; }
        const int nig = WGM * nN, gid = wgid / nig, fm = gid * WGM, gsz = (nM - fm) < WGM ? (nM - fm) : WGM;
        u.pm = fm + ((wgid % nig) % gsz); u.pn = (wgid % nig) / gsz; u.ko = 0; u.kl = kl; return true;
    }
    __device__ __forceinline__ void a_ready(const Unit&) const {}
    __device__ __forceinline__ void done(const Unit&) const {}
};

struct InProjOrder : StaticOrder {
    __device__ __forceinline__ bool next(int i, Unit& u) const { if (!StaticOrder::next(i, u)) return false; if (u.pn == 13) u.pn = 28; return true; }
};

__device__ __forceinline__ unsigned cvt_pk_bf16(float lo, float hi) { unsigned r; asm volatile("v_cvt_pk_bf16_f32 %0, %1, %2" : "=v"(r) : "v"(lo), "v"(hi)); return r; }
__device__ __forceinline__ int lane_now() { int l; asm volatile("v_mbcnt_lo_u32_b32 %0, -1, 0\n\tv_mbcnt_hi_u32_b32 %0, -1, %0" : "=v"(l)); return l; }
__device__ __forceinline__ float sigmoidf_(float v) { return __builtin_amdgcn_rcpf(1.f + __expf(-v)); }
__device__ __forceinline__ float bflo(unsigned u) { return __uint_as_float(u << 16); }
__device__ __forceinline__ float bfhi(unsigned u) { return __uint_as_float(u & 0xffff0000u); }

__device__ __forceinline__ void st16(void* ubase, unsigned voff, u32x4 w) { *(u32x4*)((char*)ubase + voff) = w; }
__device__ __forceinline__ u32x4 ld16(const void* ubase, unsigned voff) { return *(const u32x4*)((const char*)ubase + voff); }
__device__ __forceinline__ u32x4 pack8(const f32x4 v0, const f32x4 v1) { u32x4 w; w.x = cvt_pk_bf16(v0[0], v0[1]); w.y = cvt_pk_bf16(v0[2], v0[3]); w.z = cvt_pk_bf16(v1[0], v1[1]); w.w = cvt_pk_bf16(v1[2], v1[3]); return w; }
struct EpiBf16 {
    static constexpr bool PERM = true, AFTER_DRAIN = false;
    bf16_t* O; int ldc; int pn_mod; int klen; size_t kstride;
    __device__ __forceinline__ void operator()(const f32x4 (&acc)[2][2][4][2], const Unit& u, int wr, int wc, int, int) const {
        const int ln_ = lane_now(), fr = ln_ & 15, fq = ln_ >> 4;
        const unsigned voff = (unsigned)((wr * 64 + fr) * ldc + wc * 32 + 8 * fq) * 2u;
        char* tb = (char*)O + ((size_t)(u.ko / klen) * kstride + (size_t)u.pm * BM * ldc + (size_t)(u.pn % pn_mod) * BM) * 2;
#pragma unroll
        for (int ai = 0; ai < 2; ++ai)
#pragma unroll
            for (int m = 0; m < 4; ++m)
#pragma unroll
                for (int bj = 0; bj < 2; ++bj) st16(tb + ((size_t)(ai * HALF + m * 16) * ldc + bj * HALF) * 2, voff, pack8(acc[ai][bj][m][0], acc[ai][bj][m][1]));
    }
};
struct EpiSwiGLU {
    static constexpr bool PERM = true, AFTER_DRAIN = false;
    bf16_t* O; int ldc; int pn_mod;
    __device__ __forceinline__ void operator()(const f32x4 (&acc)[2][2][4][2], const Unit& u, int wr, int wc, int, int) const {
        const int ln_ = lane_now(), fr = ln_ & 15, fq = ln_ >> 4;
        const unsigned voff = (unsigned)((wr * 64 + fr) * ldc + wc * 32 + 8 * fq) * 2u;
        char* tb = (char*)O + ((size_t)u.pm * BM * ldc + (size_t)(u.pn % pn_mod) * HALF) * 2;
#pragma unroll
        for (int ai = 0; ai < 2; ++ai)
#pragma unroll
            for (int m = 0; m < 4; ++m) {
                f32x4 r0, r1;
#pragma unroll
                for (int j = 0; j < 4; ++j) { const float g0 = acc[ai][0][m][0][j], u0 = acc[ai][1][m][0][j], g1 = acc[ai][0][m][1][j], u1 = acc[ai][1][m][1][j];
                    r0[j] = g0 * sigmoidf_(g0) * u0; r1[j] = g1 * sigmoidf_(g1) * u1; }
                st16(tb + (size_t)(ai * HALF + m * 16) * ldc * 2, voff, pack8(r0, r1)); }
    }
};
struct EpiInProj {
    static constexpr bool PERM = true, AFTER_DRAIN = false;
    bf16_t* qkv; float* ng; size_t ht;
    __device__ __forceinline__ void operator()(const f32x4 (&acc)[2][2][4][2], const Unit& u, int wr, int wc, int, int) const {
        const int ln_ = lane_now(), fr = ln_ & 15, fq = ln_ >> 4;
        const int rl = wr * 64 + fr;
#pragma unroll
        for (int bj = 0; bj < 2; ++bj) {
            const int colblk = u.pn * BM + bj * HALF + wc * 32;
            const int hb = colblk >> 6, cin = (colblk & 63) + 8 * fq;
            if (hb < 50) {
                const bool vt = (hb == 7) | (hb == 9) | (hb == 16) | (hb == 17) | (hb >= 34 && hb < 38) | (hb >= 46);
                if (!vt) {
                    char* tb = (char*)qkv + ((size_t)hb * ht + (size_t)u.pm * BM * 64) * 2; const unsigned voff = (unsigned)(rl * 64 + cin) * 2u;
#pragma unroll
                    for (int ai = 0; ai < 2; ++ai)
#pragma unroll
                        for (int m = 0; m < 4; ++m) st16(tb + (size_t)(ai * HALF + m * 16) * 64 * 2, voff, pack8(acc[ai][bj][m][0], acc[ai][bj][m][1]));
                } else {
                    const int bb = u.pm >> 3, s0 = (u.pm & 7) * BM + rl;
                    char* tb = (char*)qkv + ((size_t)hb * ht + ((size_t)bb * 64 + (colblk & 63)) * 2048) * 2;
                    const bool dilv = (hb >= 34 && hb < 38);
                    char* t4 = (char*)qkv + ((size_t)(50 + (hb - 34) * 2) * ht + ((size_t)bb * 64 + (colblk & 63)) * 2048) * 2; char* t16 = t4 + ht * 2;
#pragma unroll
                    for (int ai = 0; ai < 2; ++ai)
#pragma unroll
                        for (int m = 0; m < 4; ++m) { const int s = s0 + ai * HALF + m * 16; const u32x4 w = pack8(acc[ai][bj][m][0], acc[ai][bj][m][1]);
                            {
                                const int j = fr & 7; u32x4 t = w;
#define PG8_SWZ(v, m) ((unsigned)__builtin_amdgcn_ds_swizzle((int)(v), ((m) << 10) | 0x1f))
                                { const unsigned s0 = (j & 4) ? t.x : t.z, s1 = (j & 4) ? t.y : t.w; const unsigned r0 = PG8_SWZ(s0, 4), r1 = PG8_SWZ(s1, 4);
                                  if (j & 4) { t.x = r0; t.y = r1; } else { t.z = r0; t.w = r1; } }
                                { const unsigned s0 = (j & 2) ? t.x : t.y, s1 = (j & 2) ? t.z : t.w; const unsigned r0 = PG8_SWZ(s0, 2), r1 = PG8_SWZ(s1, 2);
                                  if (j & 2) { t.x = r0; t.z = r1; } else { t.y = r0; t.w = r1; } }
                                { const unsigned p0 = PG8_SWZ(t.x, 1), p1 = PG8_SWZ(t.y, 1), p2 = PG8_SWZ(t.z, 1), p3 = PG8_SWZ(t.w, 1);
                                  if (j & 1) { t.x = (p0 >> 16) | (t.x & 0xffff0000u); t.y = (p1 >> 16) | (t.y & 0xffff0000u); t.z = (p2 >> 16) | (t.z & 0xffff0000u); t.w = (p3 >> 16) | (t.w & 0xffff0000u); }
                                  else       { t.x = (t.x & 0xffffu) | (p0 << 16); t.y = (t.y & 0xffffu) | (p1 << 16); t.z = (t.z & 0xffffu) | (p2 << 16); t.w = (t.w & 0xffffu) | (p3 << 16); } }
#undef PG8_SWZ
                                st16(tb, (unsigned)((8 * fq + j) * 2048 + (s - j)) * 2u, t);
                            }
                            if (dilv) {
                                const unsigned v4 = (unsigned)(8 * fq * 2048 + (s & 3) * 512 + (s >> 2)) * 2u, v16 = (unsigned)(8 * fq * 2048 + (s & 15) * 128 + (s >> 4)) * 2u;
                                *(unsigned short*)(t4 + v4) = (unsigned short)w.x; *(unsigned short*)(t4 + v4 + 4096) = (unsigned short)(w.x >> 16);
                                *(unsigned short*)(t4 + v4 + 2 * 4096) = (unsigned short)w.y; *(unsigned short*)(t4 + v4 + 3 * 4096) = (unsigned short)(w.y >> 16);
                                *(unsigned short*)(t4 + v4 + 4 * 4096) = (unsigned short)w.z; *(unsigned short*)(t4 + v4 + 5 * 4096) = (unsigned short)(w.z >> 16);
                                *(unsigned short*)(t4 + v4 + 6 * 4096) = (unsigned short)w.w; *(unsigned short*)(t4 + v4 + 7 * 4096) = (unsigned short)(w.w >> 16);
                                *(unsigned short*)(t16 + v16) = (unsigned short)w.x; *(unsigned short*)(t16 + v16 + 4096) = (unsigned short)(w.x >> 16);
                                *(unsigned short*)(t16 + v16 + 2 * 4096) = (unsigned short)w.y; *(unsigned short*)(t16 + v16 + 3 * 4096) = (unsigned short)(w.y >> 16);
                                *(unsigned short*)(t16 + v16 + 4 * 4096) = (unsigned short)w.z; *(unsigned short*)(t16 + v16 + 5 * 4096) = (unsigned short)(w.z >> 16);
                                *(unsigned short*)(t16 + v16 + 6 * 4096) = (unsigned short)w.w; *(unsigned short*)(t16 + v16 + 7 * 4096) = (unsigned short)(w.w >> 16);
                            } }
                }
            } else if (hb == 114) {
                if (cin < 16) {
                    char* tb = (char*)ng + (size_t)u.pm * BM * 16 * 4; const unsigned voff = (unsigned)(rl * 16 + cin) * 4u;
#pragma unroll
                    for (int ai = 0; ai < 2; ++ai)
#pragma unroll
                        for (int m = 0; m < 4; ++m) { char* p = tb + (size_t)(ai * HALF + m * 16) * 16 * 4;
                            *(f32x4*)(p + voff) = acc[ai][bj][m][0]; *(f32x4*)(p + 16 + voff) = acc[ai][bj][m][1]; }
                }
            }
        }
    }
};
struct MergeOrder {
    int ntile, G, c, pm_off, pn_off;
    __device__ __forceinline__ bool next(int i, Unit& u) const {
        const int tl = (i >> 3) * G + c, sub = i & 7, br = sub >> 1; if (tl >= ntile) return false;
        const int pml = tl >> 2, pnl = tl & 3;
        if (sub & 1) { u.pm = pml; u.pn = br * 4 + pnl; u.ko = 0; u.kl = 1024; }
        else         { u.pm = pm_off + pml; u.pn = pn_off + pnl; u.ko = br * 256; u.kl = 256; }
        return true;
    }
    __device__ __forceinline__ void a_ready(const Unit&) const {}
    __device__ __forceinline__ void done(const Unit&) const {}
};
struct EpiMerge {
    static constexpr bool PERM = true, AFTER_DRAIN = false;
    bf16_t* merged; bf16_t* scratch; int pm_off, pn_off;
    __device__ __forceinline__ void operator()(const f32x4 (&acc)[2][2][4][2], const Unit& u, int wr, int wc, int, int) const {
        const int ln_ = lane_now(), fr = ln_ & 15, fq = ln_ >> 4;
        const int rl = wr * 64 + fr, cl = wc * 32 + 8 * fq;
        const unsigned voffs = (unsigned)(rl * 256 + cl) * 2u;
        if (u.kl == 256) {
#pragma unroll
            for (int ai = 0; ai < 2; ++ai)
#pragma unroll
                for (int m = 0; m < 4; ++m)
#pragma unroll
                    for (int bj = 0; bj < 2; ++bj) st16((char*)scratch + ((size_t)(ai * HALF + m * 16) * 256 + bj * HALF) * 2, voffs, pack8(acc[ai][bj][m][0], acc[ai][bj][m][1]));
        } else {
            const int br = u.pn >> 2, pml = u.pm, pnl = u.pn & 3;
            const unsigned voffm = (unsigned)(rl * 1024 + cl) * 2u;
            char* tm = (char*)merged + ((size_t)pml * BM * 1024 + (size_t)pnl * BM) * 2;
#pragma unroll
            for (int ai = 0; ai < 2; ++ai) {
                u32x4 pz[4][2], om[4][2];
#pragma unroll
                for (int m = 0; m < 4; ++m)
#pragma unroll
                    for (int bj = 0; bj < 2; ++bj) { pz[m][bj] = ld16((const char*)scratch + ((size_t)(ai * HALF + m * 16) * 256 + bj * HALF) * 2, voffs);
                        om[m][bj] = ld16(tm + ((size_t)(ai * HALF + m * 16) * 1024 + bj * HALF) * 2, voffm); }
                __builtin_amdgcn_sched_barrier(0);
                const unsigned keep = (br != 0) ? 0xffffffffu : 0u;
#pragma unroll
                for (int m = 0; m < 4; ++m)
#pragma unroll
                    for (int bj = 0; bj < 2; ++bj) { const f32x4 v0 = acc[ai][bj][m][0], v1 = acc[ai][bj][m][1]; const u32x4 z = pz[m][bj]; u32x4 o = om[m][bj]; o.x &= keep; o.y &= keep; o.z &= keep; o.w &= keep;
                        f32x4 r0, r1;
                        r0[0] = bflo(z.x) * sigmoidf_(v0[0]) + bflo(o.x); r0[1] = bfhi(z.x) * sigmoidf_(v0[1]) + bfhi(o.x); r0[2] = bflo(z.y) * sigmoidf_(v0[2]) + bflo(o.y); r0[3] = bfhi(z.y) * sigmoidf_(v0[3]) + bfhi(o.y);
                        r1[0] = bflo(z.z) * sigmoidf_(v1[0]) + bflo(o.z); r1[1] = bfhi(z.z) * sigmoidf_(v1[1]) + bfhi(o.z); r1[2] = bflo(z.w) * sigmoidf_(v1[2]) + bflo(o.w); r1[3] = bfhi(z.w) * sigmoidf_(v1[3]) + bfhi(o.w);
                        st16(tm + ((size_t)(ai * HALF + m * 16) * 1024 + bj * HALF) * 2, voffm, pack8(r0, r1)); }
            }
        }
    }
};
struct GroupedOrder {
    int nt0, nt1, nt2, nt3, nt4, nt5, nt6, nt7; int ncol, G, c, ksplit, klen, tlo, thi;
    __device__ __forceinline__ bool next(int i, Unit& u) const {
        const int Lq = i * G + c; int L = Lq / ksplit; u.ko = (Lq - L * ksplit) * klen; u.kl = klen; int to = 0;
#define PG8_GO(e, nte) { const int a_ = to > tlo ? to : tlo, b_ = (to + (nte)) < thi ? (to + (nte)) : thi, ne_ = b_ - a_; if (ne_ > 0) { const int n = ne_ * ncol; if (L < n) { u.pn = (e) * ncol + L / ne_; u.pm = a_ + L % ne_; return true; } L -= n; } to += (nte); }
        PG8_GO(0, nt0) PG8_GO(1, nt1) PG8_GO(2, nt2) PG8_GO(3, nt3) PG8_GO(4, nt4) PG8_GO(5, nt5) PG8_GO(6, nt6) PG8_GO(7, nt7)
#undef PG8_GO
        return false;
    }
    __device__ __forceinline__ void a_ready(const Unit&) const {}
    __device__ __forceinline__ void done(const Unit&) const {}
};

template <class Epi, class Sched, bool ALIGN_EPI = false, bool SP2 = false>
__device__ __forceinline__ void gemm_phase(PG8_LAS unsigned char* lds, const Gemm g, const Sched& S, const Epi& E, const int wave_s  ) {
    const int tid_l = lane_now() + 64 * wave_s;
    const int tid = tid_l, wid = wave_s, lane = tid & 63, wr = wid >> 2, wc = wid & 3, fr = lane & 15, fq = lane >> 4;
    const int K = g.K;
    unsigned voffA[2], voffB[2];
#pragma unroll
    for (int i = 0; i < 2; ++i) { int R, C; stage_rc(tid * 16 + i * 8192, R, C); const int Rb = Epi::PERM ? ((R & ~31) + perm32(R & 31)) : R;
        voffA[i] = (unsigned)(R * K + C) * 2u; voffB[i] = (unsigned)(Rb * K + C) * 2u; }
    const size_t kstep = (size_t)(BK * 2);
    const size_t hstep = (size_t)HALF * K * 2;
    const size_t tstep = 2 * hstep;
    const unsigned ldsw = (unsigned)wid * 1024u;
    const int aoff = lds_byte(wr * 64 + fr, fq * 8), boff = lds_byte(wc * 32 + fr, fq * 8);
#define PG8_SA(b, h) (((b) * 2 + (h)) * HTB)
#define PG8_SB(b, h) ((4 + (b) * 2 + (h)) * HTB)
#define PG8_STAGE(bufoff, gbase, voff) do { _Pragma("unroll") for (int _i = 0; _i < 2; ++_i) \
        __builtin_amdgcn_global_load_lds((const unsigned*)((const char*)(gbase) + (voff)[_i]), (PG8_LAS unsigned*)(lds + (bufoff) + ldsw + _i * 8192), 16, 0, 0); } while (0)
#define PG8_LDA(dst, b, h) do { _Pragma("unroll") for (int m = 0; m < 4; ++m) _Pragma("unroll") for (int k = 0; k < 2; ++k) dst[m][k] = *(const PG8_LAS bf16x8*)(lds + PG8_SA(b, h) + aoff + m * 2048 + k * 1024); } while (0)
#define PG8_LDB(dst, b, h) do { _Pragma("unroll") for (int n = 0; n < 2; ++n) _Pragma("unroll") for (int k = 0; k < 2; ++k) dst[n][k] = *(const PG8_LAS bf16x8*)(lds + PG8_SB(b, h) + boff + n * 2048 + k * 1024); } while (0)
#define PG8_MMA(ai, bj, At, Bt) do { __builtin_amdgcn_s_setprio(1); _Pragma("unroll") for (int m = 0; m < 4; ++m) _Pragma("unroll") for (int n = 0; n < 2; ++n) _Pragma("unroll") for (int k = 0; k < 2; ++k) \
        acc[ai][bj][m][n] = __builtin_amdgcn_mfma_f32_16x16x32_bf16(Bt[n][k], At[m][k], acc[ai][bj][m][n], 0, 0, 0); __builtin_amdgcn_s_setprio(0); } while (0)
#define PG8_WAIT_V(n) asm volatile("s_waitcnt vmcnt(" #n ")" ::: "memory")
#define PG8_WAIT_L(n) asm volatile("s_waitcnt lgkmcnt(" #n ")" ::: "memory")
#define PG8_BAR __builtin_amdgcn_s_barrier()
#define PG8_SCHED __builtin_amdgcn_sched_barrier(0)
    Unit cur, nxt; int ui = 0;
    if (!S.next(0, cur)) return;
    f32x4 acc[2][2][4][2];
#pragma unroll
    for (int a = 0; a < 2; ++a)
#pragma unroll
        for (int b = 0; b < 2; ++b)
#pragma unroll
            for (int m = 0; m < 4; ++m)
#pragma unroll
                for (int n = 0; n < 2; ++n) acc[a][b][m][n] = (f32x4){0.f, 0.f, 0.f, 0.f};
    bf16x8 At[4][2], B0[2][2], B1[2][2];
    const char* cA = (const char*)g.A + (size_t)cur.pm * tstep + (size_t)cur.ko * 2; const char* cB = (const char*)g.Bt + (size_t)cur.pn * tstep + (size_t)cur.ko * 2;
    S.a_ready(cur);
    if constexpr (SP2) {
        PG8_STAGE(PG8_SB(0, 0), cB, voffB); PG8_STAGE(PG8_SB(0, 1), cB + hstep, voffB); PG8_STAGE(PG8_SA(0, 0), cA, voffA); PG8_STAGE(PG8_SA(0, 1), cA + hstep, voffA);
        if (wr == 1) PG8_BAR;
        PG8_WAIT_V(2); PG8_BAR;
        PG8_STAGE(PG8_SB(1, 0), cB + kstep, voffB); PG8_STAGE(PG8_SA(1, 0), cA + kstep, voffA); PG8_STAGE(PG8_SB(1, 1), cB + hstep + kstep, voffB);
        PG8_WAIT_V(6); PG8_BAR;
    } else {
        PG8_STAGE(PG8_SB(0, 0), cB, voffB); PG8_STAGE(PG8_SA(0, 0), cA, voffA); PG8_STAGE(PG8_SB(0, 1), cB + hstep, voffB); PG8_STAGE(PG8_SA(0, 1), cA + hstep, voffA);
        if (wr == 1) PG8_BAR;
        PG8_WAIT_V(4); PG8_BAR;
        PG8_STAGE(PG8_SB(1, 0), cB + kstep, voffB); PG8_STAGE(PG8_SA(1, 0), cA + kstep, voffA); PG8_STAGE(PG8_SB(1, 1), cB + hstep + kstep, voffB);
        PG8_WAIT_V(6); PG8_BAR;
    }
    for (;;) {
        const bool has_next = S.next(ui + 1, nxt);
        const char* nA = has_next ? (const char*)g.A + (size_t)nxt.pm * tstep + (size_t)nxt.ko * 2 : cA; const char* nB = has_next ? (const char*)g.Bt + (size_t)nxt.pn * tstep + (size_t)nxt.ko * 2 : cB;
        const int nt = cur.kl / BK;
        for (int t = 0; t < nt; t += 2) {
            const bool last = (t == nt - 2);
            const char* a1 = cA + (size_t)(t + 1) * kstep;
            const char* a2 = last ? nA : cA + (size_t)(t + 2) * kstep; const char* b2 = last ? nB : cB + (size_t)(t + 2) * kstep;
            const char* a3 = a2 + kstep; const char* b3 = b2 + kstep;
            if (last && has_next) S.a_ready(nxt);
            if constexpr (SP2) {
            PG8_LDB(B0, 0, 0); PG8_LDB(B1, 0, 1); PG8_SCHED; PG8_LDA(At, 0, 0); PG8_STAGE(PG8_SA(1, 1), a1 + hstep, voffA);
            PG8_WAIT_V(8); PG8_WAIT_L(0); PG8_BAR; PG8_MMA(0, 0, At, B0); PG8_MMA(0, 1, At, B1); PG8_BAR; PG8_SCHED;
            PG8_LDA(At, 0, 1); PG8_STAGE(PG8_SB(0, 0), b2, voffB); PG8_STAGE(PG8_SB(0, 1), b2 + hstep, voffB); PG8_STAGE(PG8_SA(0, 0), a2, voffA);
            PG8_WAIT_V(8); PG8_WAIT_L(0); PG8_BAR; PG8_MMA(1, 0, At, B0); PG8_MMA(1, 1, At, B1); PG8_BAR; PG8_SCHED;
            PG8_LDB(B0, 1, 0); PG8_LDB(B1, 1, 1); PG8_SCHED; PG8_LDA(At, 1, 0); PG8_STAGE(PG8_SA(0, 1), a2 + hstep, voffA);
            PG8_WAIT_V(8); PG8_WAIT_L(0); PG8_BAR; PG8_MMA(0, 0, At, B0); PG8_MMA(0, 1, At, B1); PG8_BAR; PG8_SCHED;
            PG8_LDA(At, 1, 1); PG8_STAGE(PG8_SB(1, 0), b3, voffB); PG8_STAGE(PG8_SB(1, 1), b3 + hstep, voffB); PG8_STAGE(PG8_SA(1, 0), a3, voffA);
            PG8_WAIT_V(8); PG8_WAIT_L(0); PG8_BAR; PG8_MMA(1, 0, At, B0); PG8_MMA(1, 1, At, B1); PG8_BAR; PG8_SCHED;
            } else {
            PG8_LDB(B0, 0, 0); PG8_SCHED; PG8_LDA(At, 0, 0); PG8_STAGE(PG8_SA(1, 1), a1 + hstep, voffA);
            PG8_WAIT_L(8); PG8_BAR; PG8_WAIT_L(0); PG8_MMA(0, 0, At, B0); PG8_BAR; PG8_SCHED;
            PG8_LDB(B1, 0, 1); PG8_STAGE(PG8_SB(0, 0), b2, voffB);
            PG8_BAR; PG8_WAIT_L(0); PG8_MMA(0, 1, At, B1); PG8_BAR;
            PG8_LDA(At, 0, 1); PG8_STAGE(PG8_SA(0, 0), a2, voffA);
            PG8_BAR; PG8_WAIT_L(0); PG8_MMA(1, 0, At, B0); PG8_BAR; PG8_SCHED;
            PG8_STAGE(PG8_SB(0, 1), b2 + hstep, voffB);
            PG8_WAIT_V(6); PG8_BAR; PG8_MMA(1, 1, At, B1); PG8_BAR;
            PG8_LDB(B0, 1, 0); PG8_SCHED; PG8_LDA(At, 1, 0); PG8_STAGE(PG8_SA(0, 1), a2 + hstep, voffA);
            PG8_WAIT_L(8); PG8_BAR; PG8_WAIT_L(0); PG8_MMA(0, 0, At, B0); PG8_BAR; PG8_SCHED;
            PG8_LDB(B1, 1, 1); PG8_STAGE(PG8_SB(1, 0), b3, voffB);
            PG8_BAR; PG8_WAIT_L(0); PG8_MMA(0, 1, At, B1); PG8_BAR;
            PG8_LDA(At, 1, 1); PG8_STAGE(PG8_SA(1, 0), a3, voffA);
            PG8_BAR; PG8_WAIT_L(0); PG8_MMA(1, 0, At, B0); PG8_BAR; PG8_SCHED;
            PG8_STAGE(PG8_SB(1, 1), b3 + hstep, voffB);
            PG8_WAIT_V(6); PG8_BAR; PG8_MMA(1, 1, At, B1); PG8_BAR;
            }
        }
        if constexpr (ALIGN_EPI) { if (wr == 0) PG8_BAR; }
        if constexpr (!Epi::AFTER_DRAIN) { E(acc, cur, wr, wc, fr, fq); S.done(cur); }
        if (!has_next) break;
#pragma unroll
        for (int a = 0; a < 2; ++a)
#pragma unroll
            for (int b = 0; b < 2; ++b)
#pragma unroll
                for (int m = 0; m < 4; ++m)
#pragma unroll
                    for (int n = 0; n < 2; ++n) acc[a][b][m][n] = (f32x4){0.f, 0.f, 0.f, 0.f};
        cur = nxt; cA = nA; cB = nB; ++ui;
        if constexpr (ALIGN_EPI) { if (wr == 1) PG8_BAR; }
    }
    PG8_WAIT_V(0);
    if constexpr (!ALIGN_EPI) { if (wr == 0) PG8_BAR; }
    PG8_BAR;
    if constexpr (Epi::AFTER_DRAIN) { E.fused(acc, cur, wr, wc, fr, fq, lds, wid, lane); S.done(cur); }
#undef PG8_SA
#undef PG8_SB
#undef PG8_STAGE
#undef PG8_LDA
#undef PG8_LDB
#undef PG8_MMA
#undef PG8_WAIT_V
#undef PG8_WAIT_L
#undef PG8_BAR
#undef PG8_SCHED
}
}

constexpr int NWAVES = 8;
constexpr int D = 1024, BATCH = 16, SEQ = 2048, T = BATCH * SEQ, NHALF = 1, TH = T / NHALF, BH = BATCH / NHALF;
constexpr int DIN = 7308, DINP = 7424;
constexpr int DFF = 2816, DFFE = 3584, NE = 8;
constexpr int MOE_ROWS = 2 * T + NE * 256;
constexpr int MOE_CT = 64, MOE_MAXCH = 5;
constexpr float ALPHA = 1.4142135623730951f, LN_EPS = 1e-5f;
constexpr int NBH = 20;
constexpr int HT_NSAQ = 0, HT_KCMP = 4, HT_VCMP = 5, HT_KSEL = 6, HT_VSEL = 7, HT_KWIN = 8, HT_VWIN = 9, HT_SWAQ = 10, HT_SWAK = 14, HT_SWAV = 16,
              HT_DILQ = 18, HT_DILK = 30, HT_DILV = 34, HT_SBQ = 38, HT_SBK = 42, HT_SBV = 46, NHT = 58;
constexpr size_t HT_ELEMS = (size_t)TH * 64;

constexpr size_t MiB = 1u << 20;
constexpr size_t WS_CTL = 0, CTL_ZERO_BYTES = 1 * MiB;
constexpr size_t WS_MOD = 1 * MiB;
constexpr size_t WS_BIAS = 2 * MiB;
constexpr size_t WS_ROUTE = 3 * MiB;
constexpr size_t WS_KC = 4 * MiB;
constexpr size_t WS_C1 = 5 * MiB;
constexpr size_t WS_NG = 6 * MiB;
constexpr size_t WS_W = 8 * MiB;
constexpr size_t TILE_B = (size_t)256 * D * 2;
constexpr size_t W_IN = 0, W_IN_L = 34 * TILE_B;
constexpr size_t W_GATE = (size_t)3200 * D * 2, W_BRC = W_GATE + 17 * TILE_B;
constexpr size_t W_OUT = W_IN + 2 * W_IN_L, W_OUT_L = (size_t)D * D * 2;
constexpr size_t W_GU = W_OUT + 2 * W_OUT_L;
constexpr size_t W_DN = W_GU + (size_t)2 * DFF * D * 2;
constexpr size_t W_END = W_DN + (size_t)D * DFF * 2;
static_assert(WS_W + W_END <= 64 * MiB, "weights");
constexpr size_t WS_ACT = 64 * MiB;
constexpr size_t A_H2 = WS_ACT;
constexpr size_t A_HY = WS_ACT + 64 * MiB;
constexpr size_t A_QKV = WS_ACT + 128 * MiB, A_MERGED = A_QKV;
constexpr size_t A_O4 = WS_ACT + 360 * MiB;
constexpr size_t A_DIL = WS_ACT + 424 * MiB;
constexpr size_t A_PS = WS_ACT + 474 * MiB;
constexpr size_t A_ACT = WS_ACT + 64 * MiB, A_Y2 = WS_ACT + 240 * MiB;
constexpr size_t A_MGU = WS_ACT + 196 * MiB, W_MGU_E = (size_t)2 * DFFE * D * 2;
constexpr size_t A_MDN = WS_ACT + 0 * MiB, W_MDN_E = (size_t)D * DFFE * 2;
constexpr size_t A_AS = WS_ACT + 64 * MiB, A_ACTE = WS_ACT + 308 * MiB, A_YP = WS_ACT + 420 * MiB;
constexpr size_t WS_END = WS_ACT + 556 * MiB;
static_assert((A_O4 - A_HY) % TILE_B == 0, "tile offsets");
static_assert(NHT * HT_ELEMS * 2 <= 232 * MiB && A_AS + (size_t)MOE_ROWS * D * 2 <= A_MGU && A_ACTE + (size_t)MOE_CT * 256 * DFFE * 2 <= A_YP && A_YP + (size_t)MOE_ROWS * D * 2 <= WS_END
              && A_DIL + (size_t)3 * TH * 256 * 2 + (size_t)3 * TH * 16 <= A_PS && A_MGU + NE * W_MGU_E <= A_ACTE && A_MDN + NE * W_MDN_E <= A_AS, "arena");
constexpr int CW_BAR = 4096, CW_CNT = 16384, CW_QUEUE = 20480, CW_CMPF = 24576;

constexpr int RING_BYTES = 131072, LDS_BYTES = 155648, MISC_OFF = LDS_BYTES - 512;

#define GAS __attribute__((address_space(1)))
#define LAS __attribute__((address_space(3)))
typedef unsigned short bf16;
typedef unsigned v4u __attribute__((ext_vector_type(4)));
typedef float f32x4 __attribute__((ext_vector_type(4)));
#define LDS_WAIT() asm volatile("s_waitcnt lgkmcnt(0)" ::: "memory")
__device__ __forceinline__ unsigned f2bf(float f) { unsigned u = __builtin_bit_cast(unsigned, f); return (u + 0x7fffu + ((u >> 16) & 1u)) >> 16; }
__device__ __forceinline__ unsigned pk2(float lo, float hi) { return f2bf(lo) | (f2bf(hi) << 16); }
__device__ __forceinline__ float bflo(unsigned u) { return __uint_as_float(u << 16); }
__device__ __forceinline__ float bfhi(unsigned u) { return __uint_as_float(u & 0xffff0000u); }
__device__ __forceinline__ float sigm(float v) { return 1.f / (1.f + __expf(-v)); }

__device__ __forceinline__ int lane_id_l() { return pg8::lane_now(); }
#define XB_TMO      128
#define XB_XCNT(j)  (256  + 64 * (j))
#define XB_XSUB(j)  (1280 + 64 * (j))
#define XB_XGEN(j)  (2304 + 64 * (j))
#define XB_TOP      3328
#define XB_TOPGEN   3392
#define XCD_BAR_WORDS 3456
#define XB_SPIN_CAP (1u << 18)
__device__ __forceinline__ unsigned xb_ld(unsigned* p)              { return __hip_atomic_load(p, __ATOMIC_RELAXED, __HIP_MEMORY_SCOPE_AGENT); }
__device__ __forceinline__ unsigned xb_add(unsigned* p, unsigned v) { return __hip_atomic_fetch_add(p, v, __ATOMIC_RELAXED, __HIP_MEMORY_SCOPE_AGENT); }
__device__ __forceinline__ unsigned xb_xcc_id() { return (unsigned)__builtin_amdgcn_s_getreg((3 << 11) | 20) & 0xFu; }
#define XB_SPIN(cond, bar) do { unsigned _sp = 0; while (cond) { __builtin_amdgcn_s_sleep(1); \
    if ((++_sp & 255u) == 0u) { if (xb_ld(&(bar)[XB_TMO])) break; if (_sp > XB_SPIN_CAP) { atomicAdd(&(bar)[XB_TMO], 1u); break; } } } } while (0)
struct XcdBarrier { unsigned* bar; unsigned x; volatile LAS unsigned* st; };
__device__ __forceinline__ XcdBarrier xcd_barrier_post(unsigned* bar, volatile LAS unsigned* st) {
    XcdBarrier b; b.bar = bar; b.x = xb_xcc_id(); b.st = st;
    if (threadIdx.x == 0) (void)xb_add(&bar[XB_XCNT(b.x)], 1u);
    return b;
}
__device__ __forceinline__ void xcd_barrier_complete(unsigned* bar, unsigned x, unsigned& nloc, unsigned& nx) {
    const unsigned G = gridDim.x * gridDim.y * gridDim.z;
    unsigned sum, cnt, mine, sp = 0u;
    for (;;) {
        sum = 0u; cnt = 0u; mine = 0u;
#pragma unroll
        for (unsigned j = 0; j < 16; ++j) { const unsigned c = xb_ld(&bar[XB_XCNT(j)]); sum += c; cnt += (c > 0u) ? 1u : 0u; }
        mine = xb_ld(&bar[XB_XCNT(x)]);
        if (sum == G) break;
        __builtin_amdgcn_s_sleep(1);
        if ((++sp & 255u) == 0u) { if (xb_ld(&bar[XB_TMO])) break; if (sp > XB_SPIN_CAP) { atomicAdd(&bar[XB_TMO], 1u); break; } }
    }
    nloc = mine > 0u ? mine : 1u; nx = cnt > 0u ? cnt : 1u;
}
__device__ __forceinline__ void xcd_barrier(const XcdBarrier& b, const int wave_s) {
    asm volatile("s_waitcnt vmcnt(0)" ::: "memory");
    __syncthreads();
    if (wave_s == 0 && lane_id_l() == 0) {
        unsigned* bar = b.bar; asm volatile("" : "+s"(bar));
        __builtin_amdgcn_s_waitcnt(0);
        unsigned nloc = b.st[0], nx = b.st[1];
        if (nloc == 0u) { xcd_barrier_complete(bar, b.x, nloc, nx); b.st[0] = nloc; b.st[1] = nx; }
        const unsigned old = xb_add(&bar[XB_XSUB(b.x)], 1u);
        const unsigned gen = old / nloc;
        if (old + 1u == (gen + 1u) * nloc) {
            __builtin_amdgcn_fence(__ATOMIC_RELEASE, "agent");
            asm volatile("s_waitcnt vmcnt(0)" ::: "memory");
            const unsigned og = xb_add(&bar[XB_TOP], 1u);
            const unsigned tg = og / nx;
            if (og + 1u == (tg + 1u) * nx) xb_add(&bar[XB_TOPGEN], 1u);
            else XB_SPIN(xb_ld(&bar[XB_TOPGEN]) == tg, bar);
            __builtin_amdgcn_fence(__ATOMIC_ACQUIRE, "agent");
            xb_add(&bar[XB_XGEN(b.x)], 1u);
            asm volatile("s_waitcnt vmcnt(0)" ::: "memory");
        } else {
            XB_SPIN(xb_ld(&bar[XB_XGEN(b.x)]) == gen, bar);
            __builtin_amdgcn_fence(__ATOMIC_ACQUIRE, "agent");
            asm volatile("s_waitcnt vmcnt(0)" ::: "memory");
        }
    }
    __syncthreads();
}

struct Args { const float* in[21]; float* out; unsigned char* ws; int ph_lo, ph_hi; };
typedef __attribute__((address_space(4))) const Args CArgs;
__device__ __forceinline__ CArgs* get_args() { CArgs* p = (CArgs*)__builtin_amdgcn_kernarg_segment_ptr(); asm volatile("" : "+s"(p)); return p; }
enum { IN_X = 0, IN_C, IN_RELB, IN_WADA, IN_BADA, IN_WIN, IN_WBR, IN_WOUT, IN_CPE, IN_CW1, IN_CW2, IN_SINK, IN_LNG, IN_LNB, IN_FG, IN_FU, IN_FD, IN_MR, IN_MG, IN_MU, IN_MD };

#define DPPF(v, ctrl) __int_as_float(__builtin_amdgcn_update_dpp(0, __float_as_int(v), (ctrl), 0xF, 0xF, true))
__device__ __forceinline__ float row_sum16(float v) { v += DPPF(v, 0xB1); v += DPPF(v, 0x4E); v += DPPF(v, 0x141); v += DPPF(v, 0x140); return v; }
__device__ __forceinline__ float rows_total(float v) {
    const int i = __float_as_int(v);
    return (__int_as_float(__builtin_amdgcn_readlane(i, 0)) + __int_as_float(__builtin_amdgcn_readlane(i, 16))) + (__int_as_float(__builtin_amdgcn_readlane(i, 32)) + __int_as_float(__builtin_amdgcn_readlane(i, 48)));
}
__device__ __forceinline__ float wave_sum(float v, int) { return rows_total(row_sum16(v)); }
__device__ __forceinline__ unsigned shfl_xor_u(unsigned v, int m, int lane) { return (unsigned)__builtin_amdgcn_ds_bpermute((lane ^ m) << 2, (int)v); }
__device__ __forceinline__ float shfl_f(float v, int src) { return __int_as_float(__builtin_amdgcn_ds_bpermute(src << 2, __float_as_int(v))); }

__device__ __forceinline__ void transpose_item(int mode, const float* src0, const float* src1, int Nsrc, int ldw  , int nblk, bf16* WT, LAS float* scr, int item, int lane) {
    const int kb = item / nblk, nb = item % nblk, k0 = 64 * kb, n0 = 32 * nb;
    const int n = n0 + (lane & 31);
    const float* cb;
    if (mode == 0) cb = src0 + n;
    else if (mode == 1) cb = (n < 640) ? src0 + n : (n < 7296) ? src0 + n + 12 : (n < 7308) ? src0 + (n - 7296 + 640) : nullptr;
    else { const int g = n >> 8, w = n & 255; cb = (w < 128) ? src0 + 128 * g + w : src1 + 128 * g + (w - 128); }
    float tv[32];
#pragma unroll
    for (int i = 0; i < 32; ++i) { const int kk = 2 * i + (lane >> 5); tv[i] = cb ? cb[(size_t)(k0 + kk) * Nsrc] : 0.f; }
#pragma unroll
    for (int i = 0; i < 32; ++i) { const int kk = 2 * i + (lane >> 5); scr[kk * 33 + (lane & 31)] = tv[i]; }
    LDS_WAIT(); asm volatile("" ::: "memory");
    const int c = lane & 7;
#pragma unroll
    for (int j = 0; j < 4; ++j) { const int nn = (lane >> 3) + 8 * j; const LAS float* s = scr + (8 * c) * 33 + nn;
        v4u o; o.x = pk2(s[0 * 33], s[1 * 33]); o.y = pk2(s[2 * 33], s[3 * 33]); o.z = pk2(s[4 * 33], s[5 * 33]); o.w = pk2(s[6 * 33], s[7 * 33]);
        *(GAS v4u*)(WT + (size_t)(n0 + nn) * ldw + k0 + 8 * c) = o; }
    LDS_WAIT(); asm volatile("" ::: "memory");
}

__device__ __forceinline__ int t5_bucket(int d) {
    if (d < 16) return d;
    int b = 16;
    b += (d >= 22); b += (d >= 30); b += (d >= 40); b += (d >= 54); b += (d >= 73); b += (d >= 99); b += (d >= 134); b += (d >= 182);
    b += (d >= 246); b += (d >= 332); b += (d >= 450); b += (d >= 609); b += (d >= 825); b += (d >= 1117); b += (d >= 1513);
    return b;
}

template <int MOE_ONLY>
__device__ __forceinline__ void p0_prologue(CArgs* a, LAS unsigned char* lds, int G, int c, const int wave) {
    const int lane = lane_id_l(), tid = wave * 64 + lane;
    unsigned char* ws = a->ws; bf16* W = (bf16*)(ws + WS_W);
    LAS float* scr = (LAS float*)(lds + wave * 16384);
    const int gw = c * NWAVES + wave, NGW = G * NWAVES;
    constexpr int I_WIN = 16 * (DINP / 32), I_WBR = 4 * 32, I_WOUT = 16 * 32, I_GU = 16 * (2 * DFF / 32), I_DN = (DFF / 64) * 32, I_MGU = 16 * (2 * DFFE / 32), I_MDN = (DFFE / 64) * 32;
    constexpr int I_C1 = (2048 / 64) * 2;
    constexpr int NITEMS = MOE_ONLY == 1 ? NE * I_MGU : MOE_ONLY == 2 ? NE * I_MDN : (2 * I_WIN + 8 * I_WBR + 2 * I_WOUT + I_GU + I_DN + 4 * I_C1);
    for (int it = gw; it < NITEMS; it += NGW) {
        int r = it, mode = 0, Nsrc, K, nblk; const float* s0; const float* s1 = nullptr; bf16* dst;
        if (MOE_ONLY) {
            if (MOE_ONLY == 1) { const int e = r / I_MGU; r -= e * I_MGU; mode = 2; s0 = a->in[IN_MG] + (size_t)e * D * DFFE; s1 = a->in[IN_MU] + (size_t)e * D * DFFE; Nsrc = DFFE; K = D; nblk = 2 * DFFE / 32; dst = (bf16*)(ws + A_MGU + e * W_MGU_E); }
            else { const int e = r / I_MDN; r -= e * I_MDN; s0 = a->in[IN_MD] + (size_t)e * DFFE * D; Nsrc = D; K = DFFE; nblk = 32; dst = (bf16*)(ws + A_MDN + e * W_MDN_E); }
        } else {
        if (r < 2 * I_WIN) { const int l = r / I_WIN; r -= l * I_WIN; mode = 1; s0 = a->in[IN_WIN] + (size_t)l * D * DIN; Nsrc = DIN; K = D; nblk = DINP / 32; dst = (bf16*)((char*)W + W_IN + l * W_IN_L); }
        else { r -= 2 * I_WIN;
        if (r < 8 * I_WBR) { const int j = r / I_WBR; r -= j * I_WBR; s0 = a->in[IN_WBR] + (size_t)j * 256 * D; Nsrc = D; K = D; nblk = 32; dst = (bf16*)((char*)W + W_IN + (j >> 2) * W_IN_L + W_BRC) + (j & 3) * 256; }
        else { r -= 8 * I_WBR;
        if (r < 2 * I_WOUT) { const int l = r / I_WOUT; r -= l * I_WOUT; s0 = a->in[IN_WOUT] + (size_t)l * D * D; Nsrc = D; K = D; nblk = 32; dst = (bf16*)((char*)W + W_OUT + l * W_OUT_L); }
        else { r -= 2 * I_WOUT;
        if (r < I_GU) { mode = 2; s0 = a->in[IN_FG]; s1 = a->in[IN_FU]; Nsrc = DFF; K = D; nblk = 2 * DFF / 32; dst = (bf16*)((char*)W + W_GU); }
        else { r -= I_GU;
        if (r < I_DN) { s0 = a->in[IN_FD]; Nsrc = D; K = DFF; nblk = 32; dst = (bf16*)((char*)W + W_DN); }
        else { r -= I_DN; const int j = r / I_C1; r -= j * I_C1; s0 = a->in[IN_CW1] + (size_t)j * 2048 * 64; Nsrc = 64; K = 2048; nblk = 2; dst = (bf16*)(ws + WS_C1) + (size_t)j * 64 * 2048; }
        }}}}
        }
        transpose_item(mode, s0, s1, Nsrc, K, nblk, dst, scr, r, lane);
    }
    __syncthreads();
    if (MOE_ONLY) return;
    if (c < 192) {
        LAS float* sc = (LAS float*)lds;
        LAS float* part = (LAS float*)(lds + 65536);
        for (int i = tid; i < 16 * D; i += 512) { const float v = a->in[IN_C][i]; sc[i] = v * sigm(v); }
        __syncthreads();
        const int l = c / 96, j0 = (c % 96) * 64;
        const float* wa = a->in[IN_WADA] + (size_t)l * D * 6144 + j0 + lane;
        float acc[16];
#pragma unroll
        for (int b = 0; b < 16; ++b) acc[b] = 0.f;
#pragma unroll 1
        for (int k8 = wave * 128; k8 < wave * 128 + 128; k8 += 8) { float wv[8];
#pragma unroll
            for (int e = 0; e < 8; ++e) wv[e] = wa[(size_t)(k8 + e) * 6144];
#pragma unroll
            for (int e = 0; e < 8; ++e) {
#pragma unroll
                for (int b = 0; b < 16; ++b) acc[b] = fmaf(sc[b * D + k8 + e], wv[e], acc[b]);
                asm volatile("" ::: "memory"); } }
#pragma unroll
        for (int b = 0; b < 16; ++b) part[(wave * 16 + b) * 64 + lane] = acc[b];
        __syncthreads();
        float* mod = (float*)(ws + WS_MOD);
        for (int o = tid; o < 16 * 64; o += 512) { const int b = o >> 6, j = o & 63; float s = a->in[IN_BADA][l * 6144 + j0 + j];
#pragma unroll
            for (int w = 0; w < 8; ++w) s += part[(w * 16 + b) * 64 + j];
            mod[((size_t)l * 16 + b) * 6144 + j0 + j] = s; }
        __syncthreads();
    } else {
        float* bt = (float*)(ws + WS_BIAS);
        for (int i = (c - 192) * 512 + tid; i < NBH * 2048; i += (G - 192) * 512) { const int h = i >> 11, d = i & 2047; bt[i] = a->in[IN_RELB][t5_bucket(d) * NBH + h]; }
    }
}

__device__ __forceinline__ void ln_stats(const f32x4 (&v)[4], float& mean, float& rstd, int) {
    float s = 0.f, s2 = 0.f;
#pragma unroll
    for (int j = 0; j < 4; ++j) { s += (v[j].x + v[j].y) + (v[j].z + v[j].w); s2 += (v[j].x * v[j].x + v[j].y * v[j].y) + (v[j].z * v[j].z + v[j].w * v[j].w); }
    s = row_sum16(s); s2 = row_sum16(s2);
    mean = rows_total(s) * (1.f / D);
    const float var = fmaxf(rows_total(s2) * (1.f / D) - mean * mean, 0.f);
    rstd = 1.f / sqrtf(var + LN_EPS);
}
__device__ __forceinline__ void store_bf16_row(bf16* orow, const f32x4 (&v)[4], int lane) {
    GAS unsigned long long* o8 = (GAS unsigned long long*)orow + lane;
#pragma unroll
    for (int j = 0; j < 4; ++j) o8[64 * j] = (unsigned long long)pk2(v[j].x, v[j].y) | ((unsigned long long)pk2(v[j].z, v[j].w) << 32);
}
__device__ __forceinline__ void ln_mod_phase(const float* xsrc, const float* mod_l, bf16* H, int half, int G, int c, int wave, int lane, LAS unsigned char* lds) {
    const int rpb = TH / G, rpw = rpb / NWAVES, rbase = c * rpb, b = (half * TH + rbase) >> 11;
    LAS f32x4* Lsh = (LAS f32x4*)lds; LAS f32x4* Lsc = Lsh + 256;
    { const int tid = wave * 64 + lane; const GAS f32x4* src = (const GAS f32x4*)(mod_l + (size_t)b * 6144); if (tid < 256) Lsh[tid] = src[tid]; else Lsc[tid - 256] = src[tid] + 1.f; }
    __syncthreads();
    const int r0 = rbase + wave * rpw;
    for (int rr = 0; rr < rpw; rr += 4) {
        f32x4 xx[4][4];
#pragma unroll
        for (int q = 0; q < 4; ++q) { const GAS f32x4* xr = (const GAS f32x4*)(xsrc + (size_t)(half * TH + r0 + rr + q) * D) + lane;
#pragma unroll
            for (int j = 0; j < 4; ++j) xx[q][j] = xr[64 * j]; }
#pragma unroll
        for (int q = 0; q < 4; ++q) { const int r = r0 + rr + q;
            f32x4 v[4];
#pragma unroll
            for (int j = 0; j < 4; ++j) v[j] = xx[q][j];
            float mean, rstd; ln_stats(v, mean, rstd, lane);
#pragma unroll
            for (int j = 0; j < 4; ++j) v[j] = (v[j] - mean) * rstd * Lsc[lane + 64 * j] + Lsh[lane + 64 * j];
            store_bf16_row(H + (size_t)r * D, v, lane); }
    }
    __syncthreads();
}
template <int YMODE, bool WRITE_H2, bool ROUTE>
__device__ __forceinline__ void post_norm_phase(CArgs* a, const float* xsrc, float* xdst, const bf16* Y, size_t yrow_off, const float* gvec_l  , const float* lng, const float* lnb,
                                                const float* modh  , bf16* H2, int row_lo, int nrows, int G, int c, int wave, int lane, int cbase, LAS unsigned char* lds) {
    unsigned char* ws = a->ws; unsigned* ctl = (unsigned*)(ws + WS_CTL); unsigned* route = (unsigned*)(ws + WS_ROUTE);
    const int rpb = nrows / G, rpw = rpb / NWAVES, rfirst = c * rpb + wave * rpw, bb = (row_lo + c * rpb) >> 11;
    LAS f32x4* Lg = (LAS f32x4*)lds; LAS f32x4* Llg = Lg + 256; LAS f32x4* Llb = Lg + 512; LAS f32x4* Lsh = Lg + 768; LAS f32x4* Lsc = Lg + 1024;
    { const int tid = wave * 64 + lane;
      for (int i = tid; i < 1280; i += 512) { const int wv = i >> 8, k = i & 255; f32x4 val;
          if (wv == 0) val = ((const GAS f32x4*)(gvec_l + (size_t)bb * 6144))[k]; else if (wv == 1) val = ((const GAS f32x4*)lng)[k]; else if (wv == 2) val = ((const GAS f32x4*)lnb)[k];
          else if (wv == 3) val = ((const GAS f32x4*)(modh + (size_t)bb * 6144))[k]; else val = ((const GAS f32x4*)(modh + (size_t)bb * 6144 + 1024))[k] + 1.f;
          Lg[i] = val; } }
    LAS f32x4* Lwr = Lg + 1280;
    if (ROUTE) { const int tid = wave * 64 + lane; const GAS f32x4* wsrc = (const GAS f32x4*)a->in[IN_MR]; for (int i = tid; i < 2048; i += 512) Lwr[i] = wsrc[i]; }
    __syncthreads();
    const int gw = rfirst, NGW = 1; (void)NGW;
    f32x4 nx[4]; unsigned long long ny[4];
    if (YMODE == 0 && rpw > 0) { const GAS f32x4* xr0 = (const GAS f32x4*)(xsrc + (size_t)(row_lo + gw) * D) + lane; const GAS unsigned long long* y0 = (const GAS unsigned long long*)(Y + ((size_t)(row_lo + gw) - yrow_off) * D) + lane;
#pragma unroll
        for (int j = 0; j < 4; ++j) { nx[j] = xr0[64 * j]; ny[j] = y0[64 * j]; } }
    for (int r = gw; r < rfirst + rpw; ++r) { const int row = row_lo + r, b = row >> 11; (void)b;
        const GAS f32x4* xr = (const GAS f32x4*)(xsrc + (size_t)row * D) + lane;
        f32x4 v[4];
        if (YMODE == 0) {
#pragma unroll
            for (int j = 0; j < 4; ++j) { const unsigned long long yy = ny[j]; const unsigned lo = (unsigned)yy, hi = (unsigned)(yy >> 32);
                const f32x4 yv = {bflo(lo), bfhi(lo), bflo(hi), bfhi(hi)}; v[j] = nx[j] * ALPHA + Lg[lane + 64 * j] * yv; }
            if (r + 1 < rfirst + rpw) { const GAS f32x4* xr1 = (const GAS f32x4*)(xsrc + (size_t)(row + 1) * D) + lane; const GAS unsigned long long* y1 = (const GAS unsigned long long*)(Y + ((size_t)(row + 1) - yrow_off) * D) + lane;
#pragma unroll
                for (int j = 0; j < 4; ++j) { nx[j] = xr1[64 * j]; ny[j] = y1[64 * j]; } }
        } else {
            const unsigned* rt = route + (size_t)row * 8;
            const unsigned e1 = rt[0], e2 = rt[1], s1 = rt[2], s2 = rt[3]; const float w1 = __uint_as_float(rt[4]), w2 = __uint_as_float(rt[5]);
            int off1 = 0, off2 = 0;
#pragma unroll
            for (int e = 0; e < NE; ++e) { const int cnt = (int)ctl[cbase + e]; const int pad = (cnt + 255) & ~255; off1 += (e < (int)e1) ? pad : 0; off2 += (e < (int)e2) ? pad : 0; }
            const GAS unsigned long long* ya = (const GAS unsigned long long*)(Y + (size_t)(off1 + (int)s1) * D) + lane;
            const GAS unsigned long long* yb = (const GAS unsigned long long*)(Y + (size_t)(off2 + (int)s2) * D) + lane;
            unsigned long long yq1[4], yq2[4]; f32x4 xq[4];
#pragma unroll
            for (int j = 0; j < 4; ++j) { yq1[j] = ya[64 * j]; yq2[j] = yb[64 * j]; }
#pragma unroll
            for (int j = 0; j < 4; ++j) xq[j] = xr[64 * j];
            __builtin_amdgcn_sched_barrier(0);
#pragma unroll
            for (int j = 0; j < 4; ++j) { const unsigned long long y1 = yq1[j], y2 = yq2[j];
                const unsigned l1 = (unsigned)y1, h1 = (unsigned)(y1 >> 32), l2 = (unsigned)y2, h2 = (unsigned)(y2 >> 32);
                const f32x4 s1v = {bflo(l1), bfhi(l1), bflo(h1), bfhi(h1)}, s2v = {bflo(l2), bfhi(l2), bflo(h2), bfhi(h2)};
                v[j] = xq[j] * ALPHA + Lg[lane + 64 * j] * (s1v * w1 + s2v * w2); }
        }
        float mean, rstd; ln_stats(v, mean, rstd, lane);
#pragma unroll
        for (int j = 0; j < 4; ++j) v[j] = (v[j] - mean) * rstd * Llg[lane + 64 * j] + Llb[lane + 64 * j];
        GAS f32x4* xo = (GAS f32x4*)(xdst + (size_t)row * D) + lane;
#pragma unroll
        for (int j = 0; j < 4; ++j) xo[64 * j] = v[j];
        if (WRITE_H2) {
            ln_stats(v, mean, rstd, lane);
#pragma unroll
            for (int j = 0; j < 4; ++j) v[j] = (v[j] - mean) * rstd * Lsc[lane + 64 * j] + Lsh[lane + 64 * j];
            store_bf16_row(H2 + (size_t)row * D, v, lane);
            if (ROUTE) {
                float lg[8];
#pragma unroll
                for (int e = 0; e < 8; ++e) lg[e] = 0.f;
#pragma unroll
                for (int j = 0; j < 4; ++j)
#pragma unroll
                    for (int q = 0; q < 4; ++q) { const int k = 4 * lane + 256 * j + q; const f32x4 wa = Lwr[2 * k], wb = Lwr[2 * k + 1]; const float hv = v[j][q];
                        lg[0] = fmaf(hv, wa.x, lg[0]); lg[1] = fmaf(hv, wa.y, lg[1]); lg[2] = fmaf(hv, wa.z, lg[2]); lg[3] = fmaf(hv, wa.w, lg[3]);
                        lg[4] = fmaf(hv, wb.x, lg[4]); lg[5] = fmaf(hv, wb.y, lg[5]); lg[6] = fmaf(hv, wb.z, lg[6]); lg[7] = fmaf(hv, wb.w, lg[7]); if (q == 3) asm volatile("" ::: "memory"); }
#pragma unroll
                for (int e = 0; e < 8; ++e) lg[e] = wave_sum(lg[e], lane);
                int e1 = 0; float v1 = lg[0];
#pragma unroll
                for (int e = 1; e < 8; ++e) if (lg[e] > v1) { v1 = lg[e]; e1 = e; }
                int e2 = -1; float v2 = -3.0e38f;
#pragma unroll
                for (int e = 0; e < 8; ++e) if (e != e1 && lg[e] > v2) { v2 = lg[e]; e2 = e; }
                if (e2 < 0) e2 = (e1 == 0) ? 1 : 0;
                const float p2 = __expf(v2 - v1), w1 = 1.f / (1.f + p2), w2 = p2 / (1.f + p2);
                if (lane == 0) {
                    const unsigned s1 = atomicAdd(&ctl[cbase + e1], 1u), s2 = atomicAdd(&ctl[cbase + e2], 1u);
                    unsigned* rt = route + (size_t)row * 8; rt[0] = (unsigned)e1; rt[1] = (unsigned)e2; rt[2] = s1; rt[3] = s2; rt[4] = __float_as_uint(w1); rt[5] = __float_as_uint(w2); }
            }
        }
    }
    __syncthreads();
}
__device__ __forceinline__ void moe_sort_phase(CArgs* a, const bf16* H2, bf16* AS, int gw, int NGW, int lane, int cbase) {
    unsigned* ctl = (unsigned*)(a->ws + WS_CTL); const unsigned* route = (const unsigned*)(a->ws + WS_ROUTE);
    for (int row = gw; row < T; row += NGW) {
        const unsigned* rt = route + (size_t)row * 8; const unsigned e1 = rt[0], e2 = rt[1], s1 = rt[2], s2 = rt[3];
        int off1 = 0, off2 = 0;
#pragma unroll
        for (int e = 0; e < NE; ++e) { const int cnt = (int)ctl[cbase + e]; const int pad = (cnt + 255) & ~255; off1 += (e < (int)e1) ? pad : 0; off2 += (e < (int)e2) ? pad : 0; }
        const GAS v4u* src = (const GAS v4u*)(H2 + (size_t)row * D) + lane;
        const v4u x0 = src[0], x1 = src[64];
        GAS v4u* d1 = (GAS v4u*)(AS + (size_t)(off1 + (int)s1) * D) + lane; GAS v4u* d2 = (GAS v4u*)(AS + (size_t)(off2 + (int)s2) * D) + lane;
        d1[0] = x0; d1[64] = x1; d2[0] = x0; d2[64] = x1; }
}

typedef short bf16x8 __attribute__((ext_vector_type(8)));
typedef float f32x16 __attribute__((ext_vector_type(16)));
typedef __bf16 bf16x2_t __attribute__((ext_vector_type(2)));
typedef float f32x2_t __attribute__((ext_vector_type(2)));
#define MFMA32(a, b, c) __builtin_amdgcn_mfma_f32_32x32x16_bf16((a), (b), (c), 0, 0, 0)
#define KOFF(r) (((r) & 7) + 16 * ((r) >> 3))
#define PI32(i) (((i) & ~12) | (((i) & 4) << 1) | (((i) & 8) >> 1))
__device__ __forceinline__ unsigned cvtpk(float lo, float hi) { f32x2_t v = {lo, hi}; bf16x2_t b = __builtin_convertvector(v, bf16x2_t); return __builtin_bit_cast(unsigned, b); }
__device__ __forceinline__ float xhalf(float v, int xaddr) { return __int_as_float(__builtin_amdgcn_ds_bpermute(xaddr, __float_as_int(v))); }

constexpr int KV_ROWB = 144, KV_VOFF = 64 * KV_ROWB, KV_BUF = 2 * 64 * KV_ROWB;
struct Stage { v4u k, v; };
__device__ __forceinline__ void stage_load(Stage& st, int tid, const bf16* Kb, size_t kstride, const bf16* Vt, int vstride, int k0) {
    const int row = tid >> 3, c = tid & 7;
    st.k = *(const GAS v4u*)(Kb + (size_t)(k0 + row) * kstride + c * 8);
    st.v = *(const GAS v4u*)(Vt + (size_t)row * vstride + k0 + c * 8);
}
__device__ __forceinline__ void stage_store(const Stage& st, int tid, LAS unsigned char* buf) {
    const int row = tid >> 3, c = tid & 7;
    *(LAS v4u*)(buf + row * KV_ROWB + c * 16) = st.k; *(LAS v4u*)(buf + KV_VOFF + row * KV_ROWB + c * 16) = st.v;
}
struct KVFrag { bf16x8 k[4]; bf16x8 v[4]; };
__device__ __forceinline__ void frag_read(KVFrag& f, const LAS unsigned char* buf, int sub, int ql, int h2) {
    const LAS unsigned char* kp = buf + (32 * sub + PI32(ql)) * KV_ROWB + 16 * h2;
#pragma unroll
    for (int s = 0; s < 4; ++s) f.k[s] = *(const LAS bf16x8*)(kp + 32 * s);
    const LAS unsigned char* vp = buf + KV_VOFF + ql * KV_ROWB + 64 * sub + 16 * h2;
#pragma unroll
    for (int dt = 0; dt < 2; ++dt)
#pragma unroll
        for (int s2 = 0; s2 < 2; ++s2) f.v[dt * 2 + s2] = *(const LAS bf16x8*)(vp + dt * 32 * KV_ROWB + 32 * s2);
}
__device__ __forceinline__ void load_qfrag(bf16x8 (&q)[4], const bf16* qrow, int h2) {
#pragma unroll
    for (int s = 0; s < 4; ++s) q[s] = *(const GAS bf16x8*)(qrow + 16 * s + 8 * h2);
}
__device__ __forceinline__ f32x16 zero16() { f32x16 z;
#pragma unroll
    for (int i = 0; i < 16; ++i) z[i] = 0.f;
    return z; }
__device__ __forceinline__ f32x16 qk_tile(const bf16x8 (&q)[4], const bf16x8 (&k)[4]) {
    f32x16 S = zero16();
#pragma unroll
    for (int s = 0; s < 4; ++s) S = MFMA32(k[s], q[s], S);
    return S;
}
__device__ __forceinline__ void pv_tile(f32x16& O0, f32x16& O1, const float (&p)[16], const bf16x8 (&v)[4]) {
    v4u w0, w1;
    w0.x = cvtpk(p[0], p[1]); w0.y = cvtpk(p[2], p[3]); w0.z = cvtpk(p[4], p[5]); w0.w = cvtpk(p[6], p[7]);
    w1.x = cvtpk(p[8], p[9]); w1.y = cvtpk(p[10], p[11]); w1.z = cvtpk(p[12], p[13]); w1.w = cvtpk(p[14], p[15]);
    const bf16x8 p0 = __builtin_bit_cast(bf16x8, w0), p1 = __builtin_bit_cast(bf16x8, w1);
    O0 = MFMA32(v[0], p0, O0); O0 = MFMA32(v[1], p1, O0);
    O1 = MFMA32(v[2], p0, O1); O1 = MFMA32(v[3], p1, O1);
}
struct AttnAcc { float m, l; f32x16 O0, O1; };
__device__ __forceinline__ void acc_init(AttnAcc& A) { A.m = -1e30f; A.l = 0.f; A.O0 = zero16(); A.O1 = zero16(); }
__device__ __forceinline__ void sm_update(AttnAcc& A, const float (&t)[16], const bf16x8 (&v)[4], int xaddr) {
    float mx = t[0];
#pragma unroll
    for (int r = 1; r < 16; ++r) mx = fmaxf(mx, t[r]);
    mx = fmaxf(mx, xhalf(mx, xaddr));
    const float mnew = fmaxf(A.m, mx);
    if (__any(mnew > A.m)) { const float corr = __expf(A.m - mnew); A.l *= corr; A.O0 = A.O0 * corr; A.O1 = A.O1 * corr; A.m = mnew; }
    float p[16]; float ls = 0.f;
#pragma unroll
    for (int r = 0; r < 16; ++r) { p[r] = (t[r] > -1e29f) ? __expf(t[r] - A.m) : 0.f; ls += p[r]; }
    A.l += ls;
    pv_tile(A.O0, A.O1, p, v);
}
__device__ __forceinline__ void store_ot(bf16* orow, const f32x16& O0, const f32x16& O1, float scale, int h2) {
#pragma unroll
    for (int g = 0; g < 4; ++g) {
        unsigned long long a = (unsigned long long)cvtpk(O0[4 * g] * scale, O0[4 * g + 1] * scale) | ((unsigned long long)cvtpk(O0[4 * g + 2] * scale, O0[4 * g + 3] * scale) << 32);
        unsigned long long b = (unsigned long long)cvtpk(O1[4 * g] * scale, O1[4 * g + 1] * scale) | ((unsigned long long)cvtpk(O1[4 * g + 2] * scale, O1[4 * g + 3] * scale) << 32);
        *(GAS unsigned long long*)(orow + 8 * g + 4 * h2) = a; *(GAS unsigned long long*)(orow + 32 + 8 * g + 4 * h2) = b; }
}
__device__ __forceinline__ void band_subtile(AttnAcc& A, const bf16x8 (&q)[4], const KVFrag& f, int qpos, int k0, int nback, const LAS float* tab, int h2, int xaddr) {
    const f32x16 S = qk_tile(q, f.k);
    const int base = qpos - k0 - 8 * h2;
    float t[16];
#pragma unroll
    for (int r = 0; r < 16; ++r) { const int dd = base - KOFF(r); const float bv = tab[dd]; t[r] = (dd >= 0 && dd <= nback) ? S[r] * 0.125f + bv : -1e30f; }
    sm_update(A, t, f.v, xaddr);
}
__device__ __forceinline__ void band_block(AttnAcc& A, const bf16x8 (&q)[4], LAS unsigned char* kvbuf, int tid, const bf16* Kb, size_t kstride, const bf16* Vt, int vstride,
                                           int q0w, int nback, int kmin, int kmax, const LAS float* tab, int ql, int h2, int xaddr) {
    Stage st; stage_load(st, tid, Kb, kstride, Vt, vstride, kmin); stage_store(st, tid, kvbuf); __syncthreads();
    const int klo = (q0w - nback) & ~31;
    int par = 0;
    for (int k0 = kmin; k0 <= kmax; k0 += 64, par ^= 1) {
        const bool more = k0 + 64 <= kmax;
        if (more) stage_load(st, tid, Kb, kstride, Vt, vstride, k0 + 64);
        const LAS unsigned char* buf = kvbuf + par * KV_BUF;
#pragma unroll
        for (int sub = 0; sub < 2; ++sub) { const int ks = k0 + 32 * sub;
            if (ks >= klo && ks <= q0w) { KVFrag f; frag_read(f, buf, sub, ql, h2); band_subtile(A, q, f, q0w + ql, ks, nback, tab, h2, xaddr); } }
        if (more) stage_store(st, tid, kvbuf + (par ^ 1) * KV_BUF);
        __syncthreads();
    }
}

constexpr int L_BLKA = 2 * KV_BUF + 2048, L_BLKB = L_BLKA + 32768, L_SCK = L_BLKA, L_MASK = L_BLKB + 32768, L_BT = L_MASK + 512, BT_STRIDE = 2176;
static_assert(L_BT + 4 * BT_STRIDE * 4 <= MISC_OFF, "NSA LDS map");
__device__ __forceinline__ void nsa_tables(CArgs* a, LAS unsigned char* lds, int wave) {
    const float* biasT = (const float*)(a->ws + WS_BIAS); LAS float* BT = (LAS float*)(lds + L_BT);
    const int lane = lane_id_l(), tid = wave * 64 + lane;
    for (int i = tid; i < 4 * BT_STRIDE; i += 512) { const int hh = i / BT_STRIDE, e = i - hh * BT_STRIDE; int dist = e - 64; dist = dist < 0 ? 0 : (dist > 2047 ? 2047 : dist); BT[i] = biasT[hh * 2048 + dist]; }
}
__device__ __forceinline__ void nsa_unit(CArgs* a, LAS unsigned char* lds, const int wave, const int b, const int tile, const int lane, const int tid, const int ql, const int h2, const int xaddr) {
    unsigned char* ws = a->ws; const bf16* QKV = (const bf16*)(ws + A_QKV); bf16* O4 = (bf16*)(ws + A_O4);
    const float* NG = (const float*)(ws + WS_NG); const bf16* KCB = (const bf16*)(ws + WS_KC); const bf16* VCT = KCB + (size_t)BH * 128 * 64;
    const int h = wave & 3, qh = wave >> 2;
    LAS float* BLKA = (LAS float*)(lds + L_BLKA); LAS float* BLKB = (LAS float*)(lds + L_BLKB);
    LAS unsigned* SCK = (LAS unsigned*)(lds + L_SCK); LAS unsigned* MASK = (LAS unsigned*)(lds + L_MASK);
    LAS float* BT = (LAS float*)(lds + L_BT);
        const int t0 = tile * 64, qpos0 = t0 + 32 * qh, qpos = qpos0 + ql; const size_t rowb = (size_t)b * SEQ, row = rowb + qpos;
        const int qi = 32 * qh + ql;
        bf16x8 q[4]; load_qfrag(q, QKV + (HT_NSAQ + h) * HT_ELEMS + row * 64, h2);
        const float g0 = sigm(NG[row * 16 + h * 3 + 0]), g1 = sigm(NG[row * 16 + h * 3 + 1]), g2 = sigm(NG[row * 16 + h * 3 + 2]);
        f32x16 T0, T1;
        {
            const bf16* Kb = KCB + (size_t)b * 128 * 64; const bf16* Vt = VCT + (size_t)b * 64 * 128;
            Stage s0, s1; stage_load(s0, tid, Kb, 64, Vt, 128, 0); stage_load(s1, tid, Kb, 64, Vt, 128, 64);
            stage_store(s0, tid, lds); stage_store(s1, tid, lds + KV_BUF);
            __syncthreads();
            const int imax = (qpos >= 31) ? ((qpos - 31) >> 4) : -1;
            const int ntile = (min(qpos0 >> 4, 126) >> 5) + 1;
            float m = -1e30f, l = 0.f;
            for (int kt = 0; kt < ntile; ++kt) { KVFrag f; frag_read(f, lds + (kt >> 1) * KV_BUF, kt & 1, ql, h2);
                const f32x16 S = qk_tile(q, f.k); float mx = -1e30f; float t[16];
#pragma unroll
                for (int r = 0; r < 16; ++r) { const int i = kt * 32 + KOFF(r) + 8 * h2; t[r] = (i <= imax) ? S[r] * 0.125f : -1e30f; mx = fmaxf(mx, t[r]); }
                mx = fmaxf(mx, xhalf(mx, xaddr)); const float mn = fmaxf(m, mx); l *= __expf(m - mn); m = mn;
#pragma unroll
                for (int r = 0; r < 16; ++r) l += (t[r] > -1e29f) ? __expf(t[r] - m) : 0.f; }
            l += xhalf(l, xaddr);
            const float inv = 1.f / fmaxf(l, 1e-30f);
            f32x16 C0 = zero16(), C1 = zero16();
            for (int kt = 0; kt < 4; ++kt) {
                float p[16];
                if (kt < ntile) { KVFrag f; frag_read(f, lds + (kt >> 1) * KV_BUF, kt & 1, ql, h2);
                    const f32x16 S = qk_tile(q, f.k);
#pragma unroll
                    for (int r = 0; r < 16; ++r) { const int i = kt * 32 + KOFF(r) + 8 * h2; p[r] = (i <= imax) ? __expf(S[r] * 0.125f - m) * inv : 0.f; }
                    pv_tile(C0, C1, p, f.v);
                } else {
#pragma unroll
                    for (int r = 0; r < 16; ++r) p[r] = 0.f;
                }
#pragma unroll
                for (int gq = 0; gq < 4; ++gq) { const int j = (32 * kt + KOFF(4 * gq) + 8 * h2) >> 2;
                    BLKA[(h * 32 + j) * 64 + qi] = (p[4 * gq] + p[4 * gq + 1]) + (p[4 * gq + 2] + p[4 * gq + 3]);
                    if (j + 1 < 32) BLKB[(h * 32 + j + 1) * 64 + qi] = p[4 * gq + 3]; }
            }
            if (h2 == 0) BLKB[(h * 32 + 0) * 64 + qi] = 0.f;
            T0 = C0 * g0; T1 = C1 * g0;
        }
        __syncthreads();
        float ssc[4];
        {
            const int sq = tid >> 3, jg = tid & 7;
#pragma unroll
            for (int jj = 0; jj < 4; ++jj) { const int j = jg * 4 + jj; float s = 0.f;
#pragma unroll
                for (int hh = 0; hh < 4; ++hh) s += BLKA[(hh * 32 + j) * 64 + sq] + BLKB[(hh * 32 + j) * 64 + sq];
                if (j == 0 || j == tile || j == tile - 1) s = 1e4f; else if (j > tile) s = -1e30f;
                ssc[jj] = s; }
        }
        __syncthreads();
        {
            const int sq = tid >> 3, jg = tid & 7;
#pragma unroll
            for (int jj = 0; jj < 4; ++jj) { const int j = jg * 4 + jj; const unsigned ub = __float_as_uint(ssc[jj]); const unsigned ord = (ub & 0x80000000u) ? ~ub : (ub | 0x80000000u);
                SCK[sq * 33 + j] = (ord & ~31u) | (unsigned)(31 - j); }
            if (tid == 0) MASK[64] = 0u;
        }
        __syncthreads();
        {
            const int sq = tid >> 3, jg = tid & 7; unsigned bits = 0u;
            const unsigned k0 = SCK[sq * 33 + jg * 4 + 0], k1 = SCK[sq * 33 + jg * 4 + 1], k2 = SCK[sq * 33 + jg * 4 + 2], k3 = SCK[sq * 33 + jg * 4 + 3];
            int r0 = 0, r1 = 0, r2 = 0, r3 = 0;
#pragma unroll 1
            for (int j2 = 0; j2 < 32; ++j2) { const unsigned kk = SCK[sq * 33 + j2]; r0 += (kk > k0) ? 1 : 0; r1 += (kk > k1) ? 1 : 0; r2 += (kk > k2) ? 1 : 0; r3 += (kk > k3) ? 1 : 0; }
            bits = ((r0 < 16) ? 1u : 0u) | ((r1 < 16) ? 2u : 0u) | ((r2 < 16) ? 4u : 0u) | ((r3 < 16) ? 8u : 0u);
            bits <<= (jg * 4);
            bits |= shfl_xor_u(bits, 1, lane); bits |= shfl_xor_u(bits, 2, lane); bits |= shfl_xor_u(bits, 4, lane);
            if (jg == 0) { MASK[sq] = bits; atomicOr((unsigned*)&MASK[64], bits); }
        }
        __syncthreads();
        {
            const unsigned msk = MASK[qi]; unsigned un = MASK[64] & ((tile >= 31) ? 0xffffffffu : ((2u << tile) - 1u));
            const bf16* Kb = QKV + (size_t)HT_KSEL * HT_ELEMS + rowb * 64; const bf16* Vt = QKV + (size_t)HT_VSEL * HT_ELEMS + (size_t)b * 64 * SEQ;
            const LAS float* tab = BT + h * BT_STRIDE + 64;
            AttnAcc A; acc_init(A);
            int j = __builtin_ctz(un); un &= un - 1;
            Stage st; stage_load(st, tid, Kb, 64, Vt, SEQ, 64 * j); stage_store(st, tid, lds); __syncthreads();
            int par = 0;
            for (;;) {
                const bool more = un != 0u; const int jn = more ? __builtin_ctz(un) : 0; un &= un - 1;
                if (more) stage_load(st, tid, Kb, 64, Vt, SEQ, 64 * jn);
                const LAS unsigned char* buf = lds + par * KV_BUF;
                const bool selj = (msk >> j) & 1u;
                if (__any(selj)) {
#pragma unroll
                    for (int sub = 0; sub < 2; ++sub) { const int ks = 64 * j + 32 * sub;
                        if (ks <= qpos0) { KVFrag f; frag_read(f, buf, sub, ql, h2);
                            const f32x16 S = qk_tile(q, f.k);
                            const int base = qpos - ks - 8 * h2;
                            float t[16];
#pragma unroll
                            for (int r = 0; r < 16; ++r) { const int dd = base - KOFF(r); const float bv = tab[dd]; t[r] = (selj && dd >= 0) ? S[r] * 0.125f + bv : -1e30f; }
                            sm_update(A, t, f.v, xaddr); } }
                }
                if (more) stage_store(st, tid, lds + (par ^ 1) * KV_BUF);
                __syncthreads();
                if (!more) break;
                j = jn; par ^= 1;
            }
            const float lt = A.l + xhalf(A.l, xaddr); const float sc = g1 / lt;
            T0 = T0 + A.O0 * sc; T1 = T1 + A.O1 * sc;
        }
        {
            AttnAcc A; acc_init(A);
            int kmin = (t0 - 511) & ~63; if (kmin < 0) kmin = 0;
            band_block(A, q, lds, tid, QKV + (size_t)HT_KWIN * HT_ELEMS + rowb * 64, 64, QKV + (size_t)HT_VWIN * HT_ELEMS + (size_t)b * 64 * SEQ, SEQ, qpos0, 511, kmin, t0, BT + h * BT_STRIDE + 64, ql, h2, xaddr);
            const float lt = A.l + xhalf(A.l, xaddr); const float sc = g2 / lt;
            T0 = T0 + A.O0 * sc; T1 = T1 + A.O1 * sc;
        }
        store_ot(O4 + row * 1024 + 0 * 256 + h * 64, T0, T1, 1.f, h2);
        __syncthreads();
}

constexpr size_t DILO_OFF = 0, DILL_OFF = (size_t)3 * TH * 256 * 2;
constexpr int U_SB = BH * 4 * 8, U_NSA = BH * 32, U_DIL = 3 * BH * 4 * 8, U_SWA = BH * 4 * 8, U_CMP = BH, U_ALL = U_CMP + U_SB + U_NSA + U_DIL + U_SWA;
constexpr int LQ_OFF = 2 * KV_BUF, LTAB_OFF = LQ_OFF + 64;
__device__ __forceinline__ void attn_queue_phase(CArgs* a, int layer, int inst, LAS unsigned char* lds, int wave) {
    unsigned char* ws = a->ws; const bf16* QKV = (const bf16*)(ws + A_QKV); bf16* O4 = (bf16*)(ws + A_O4); const float* biasT = (const float*)(ws + WS_BIAS);
    bf16* DILO = (bf16*)(ws + A_DIL + DILO_OFF); float* DILL = (float*)(ws + A_DIL + DILL_OFF);
    unsigned* qctr = (unsigned*)(ws + WS_CTL) + CW_QUEUE + inst * 64;
    LAS unsigned* LQ = (LAS unsigned*)(lds + LQ_OFF); LAS float* tabw = (LAS float*)(lds + LTAB_OFF);
    unsigned* cflag = (unsigned*)(ws + WS_CTL) + CW_CMPF + inst * 64;
    nsa_tables(a, lds, wave);
    if (wave == 0 && lane_id_l() == 0) LQ[0] = atomicAdd(qctr, 1u);
    __syncthreads();
    for (;;) {
        const int lane = lane_id_l(), tid = wave * 64 + lane, ql = lane & 31, h2 = lane >> 5, xaddr = (lane ^ 32) << 2;
        const int u = (int)LQ[0];
        __syncthreads();
        if (u >= U_ALL) break;
        unsigned nxt_u = 0u; if (tid == 0) nxt_u = atomicAdd(qctr, 1u);
        const int uu = u - U_CMP;
        if (uu >= 0 && uu < U_SB) {
            const int bh = uu % (4 * BH), h = bh & 3, b = bh >> 2, Qb = 7 - uu / (4 * BH);
            const int q0w = Qb * 256 + 32 * wave; const size_t rowb = (size_t)b * SEQ;
            bf16x8 q[4]; load_qfrag(q, QKV + (HT_SBQ + h) * HT_ELEMS + (rowb + q0w + ql) * 64, h2);
            const bf16* Kb = QKV + (HT_SBK + h) * HT_ELEMS + rowb * 64;
            const bf16* Vt = QKV + (HT_SBV + h) * HT_ELEMS + (size_t)b * 64 * SEQ;
            f32x16 O0 = zero16(), O1 = zero16(); float R = 0.f;
            const int ktop = Qb * 256 + 192;
            Stage st; stage_load(st, tid, Kb, 64, Vt, SEQ, ktop); stage_store(st, tid, lds); __syncthreads();
            int par = 0;
            for (int k0 = ktop; k0 >= 0; k0 -= 64, par ^= 1) {
                const bool more = k0 >= 64;
                if (more) stage_load(st, tid, Kb, 64, Vt, SEQ, k0 - 64);
                const LAS unsigned char* buf = lds + par * KV_BUF;
#pragma unroll
                for (int sub = 1; sub >= 0; --sub) { const int ks = k0 + 32 * sub;
                    if (ks <= q0w) { KVFrag f; frag_read(f, buf, sub, ql, h2);
                        const f32x16 S = qk_tile(q, f.k);
                        float ls[16], lf[16];
                        if (ks == q0w) {
                            const int base = ql - 8 * h2;
#pragma unroll
                            for (int r = 0; r < 16; ++r) { const float z2 = S[r] * (0.125f * 1.4426950408889634f); const bool valid = (base - KOFF(r)) >= 1;
                                const float L2 = __builtin_amdgcn_logf(1.f + __builtin_amdgcn_exp2f(-fabsf(z2)));
                                ls[r] = valid ? fminf(z2, 0.f) - L2 : -1e30f; lf[r] = valid ? -fmaxf(z2, 0.f) - L2 : 0.f; }
                        } else {
#pragma unroll
                            for (int r = 0; r < 16; ++r) { const float z2 = S[r] * (0.125f * 1.4426950408889634f);
                                const float L2 = __builtin_amdgcn_logf(1.f + __builtin_amdgcn_exp2f(-fabsf(z2)));
                                ls[r] = fminf(z2, 0.f) - L2; lf[r] = -fmaxf(z2, 0.f) - L2; }
                        }
                        float G0 = 0.f, G1 = 0.f;
#pragma unroll
                        for (int r = 0; r < 8; ++r) { G0 += lf[r]; G1 += lf[8 + r]; }
                        const float P0 = xhalf(G0, xaddr), P1 = xhalf(G1, xaddr);
                        const float aft0 = (h2 == 0) ? (P0 + G1 + P1) : (P1 + G1), aft1 = (h2 == 0) ? P1 : 0.f;
                        float p[16]; float w = aft0 + R;
#pragma unroll
                        for (int r = 7; r >= 0; --r) { p[r] = __builtin_amdgcn_exp2f(ls[r] + w); w += lf[r]; }
                        w = aft1 + R;
#pragma unroll
                        for (int r = 15; r >= 8; --r) { p[r] = __builtin_amdgcn_exp2f(ls[r] + w); w += lf[r]; }
                        R += (G0 + P0) + (G1 + P1);
                        pv_tile(O0, O1, p, f.v); } }
                if (more) stage_store(st, tid, lds + (par ^ 1) * KV_BUF);
                __syncthreads();
            }
            store_ot(O4 + (rowb + q0w + ql) * 1024 + 3 * 256 + h * 64, O0, O1, 1.f, h2);
        } else if (uu >= U_SB && uu < U_SB + U_NSA) {
            const int un = uu - U_SB, b = un % BH, tile = 31 - un / BH;
            if (tid == 0) { unsigned sp = 0;
                while (__hip_atomic_load(cflag + b, __ATOMIC_RELAXED, __HIP_MEMORY_SCOPE_AGENT) == 0u) { __builtin_amdgcn_s_sleep(2); if (++sp > (1u << 22)) break; }
                __builtin_amdgcn_fence(__ATOMIC_ACQUIRE, "agent"); asm volatile("s_waitcnt vmcnt(0)" ::: "memory"); }
            __syncthreads();
            nsa_unit(a, lds, wave, b, tile, lane, tid, ql, h2, xaddr);
        } else if (uu >= U_SB + U_NSA && uu < U_SB + U_NSA + U_DIL) {
            const int r0 = uu - U_SB - U_NSA; const int h = r0 & 3, b = (r0 >> 2) % BH, pb = (r0 / (4 * BH)) & 7, g = r0 / (32 * BH);
            const int dil = (g == 0) ? 1 : (g == 1) ? 4 : 16, L = SEQ / dil;
            const int p0 = pb * 256 + 32 * wave, res = p0 / L, i0 = p0 - res * L;
            const size_t rowb = (size_t)b * SEQ;
            const float* bsrc = biasT + (8 + g * 4 + h) * 2048;
            for (int e = tid; e < 320; e += 512) { const int dd = e - 32; int dist = dd * dil; dist = dist < 0 ? 0 : (dist > 2047 ? 2047 : dist); tabw[e] = bsrc[dist]; }
            const int tq = (i0 + ql) * dil + res;
            bf16x8 q[4]; load_qfrag(q, QKV + (HT_DILQ + g * 4 + h) * HT_ELEMS + (rowb + tq) * 64, h2);
            const int vslot = (g == 0) ? (HT_DILV + h) : (50 + h * 2 + (g - 1));
            AttnAcc A; acc_init(A);
            if (L >= 256) {
                const int res_b = (pb * 256) / L, ib = pb * 256 - res_b * L;
                const bf16* Kb = QKV + (HT_DILK + h) * HT_ELEMS + (rowb + res_b) * 64; const bf16* Vt = QKV + (size_t)vslot * HT_ELEMS + (size_t)b * 64 * SEQ + res_b * L;
                int kmin = (ib - 128) & ~63; if (kmin < 0) kmin = 0;
                band_block(A, q, lds, tid, Kb, (size_t)dil * 64, Vt, SEQ, i0, 128, kmin, ib + 192, tabw + 32, ql, h2, xaddr);
            } else {
#pragma unroll 1
                for (int half = 0; half < 2; ++half) { const int res_b = 2 * pb + half;
                    const bf16* Kb = QKV + (HT_DILK + h) * HT_ELEMS + (rowb + res_b) * 64; const bf16* Vt = QKV + (size_t)vslot * HT_ELEMS + (size_t)b * 64 * SEQ + res_b * L;
                    const bool mine = (wave >> 2) == half;
                    band_block(A, q, lds, tid, Kb, (size_t)dil * 64, Vt, SEQ, mine ? i0 : -4096, 128, 0, 64, tabw + 32, ql, h2, xaddr); }
            }
            const float lt = A.l + xhalf(A.l, xaddr);
            store_ot(DILO + ((size_t)g * TH + rowb + tq) * 256 + h * 64, A.O0, A.O1, 1.f / lt, h2);
            if (h2 == 0) DILL[((size_t)g * TH + rowb + tq) * 4 + h] = A.m + __logf(lt);
        } else if (uu >= U_SB + U_NSA + U_DIL) {
            const int r0 = uu - U_SB - U_NSA - U_DIL; const int h = r0 & 3, b = (r0 >> 2) % BH, Qb = r0 / (4 * BH);
            const int q0w = Qb * 256 + 32 * wave; const size_t rowb = (size_t)b * SEQ;
            const float* bsrc = biasT + (4 + h) * 2048;
            for (int e = tid; e < 320; e += 512) { int dist = e - 32; dist = dist < 0 ? 0 : dist; tabw[e] = bsrc[dist]; }
            bf16x8 q[4]; load_qfrag(q, QKV + (HT_SWAQ + h) * HT_ELEMS + (rowb + q0w + ql) * 64, h2);
            AttnAcc A; acc_init(A);
            int kmin = (Qb * 256 - 127) & ~63; if (kmin < 0) kmin = 0;
            band_block(A, q, lds, tid, QKV + (HT_SWAK + (h >> 1)) * HT_ELEMS + rowb * 64, 64, QKV + (HT_SWAV + (h >> 1)) * HT_ELEMS + (size_t)b * 64 * SEQ, SEQ, q0w, 127, kmin, Qb * 256 + 192, tabw + 32, ql, h2, xaddr);
            const float lt = A.l + xhalf(A.l, xaddr);
            const float sk = a->in[IN_SINK][layer * 4 + h]; const float mf = fmaxf(A.m, sk); const float c0 = __expf(A.m - mf); const float den = lt * c0 + __expf(sk - mf);
            store_ot(O4 + (rowb + q0w + ql) * 1024 + 1 * 256 + h * 64, A.O0, A.O1, c0 / den, h2);
        } else {
            const int it = u * 8 + wave; const int rt = it & 3, which = (it >> 2) & 1, b = it >> 3;
            bf16* kcb = (bf16*)(ws + WS_KC); bf16* vct = kcb + (size_t)BH * 128 * 64;
            const int i = rt * 32 + ql, ic = i > 126 ? 126 : i;
            const bf16* src = QKV + (HT_KCMP + which) * HT_ELEMS + ((size_t)b * SEQ + 16 * ic) * 64;
            const float* pe = a->in[IN_CPE] + ((size_t)layer * 2 + which) * 32 * 64;
            const bf16* w1t = (const bf16*)(ws + WS_C1) + ((size_t)layer * 2 + which) * 64 * 2048 + (size_t)ql * 2048;
            f32x16 H0 = zero16(), H1 = zero16();
#pragma unroll 1
            for (int ks0 = 0; ks0 < 128; ks0 += 4) {
                v4u xa[4]; f32x4 pa[4], pb2[4]; bf16x8 a0[4], a1[4];
#pragma unroll
                for (int e = 0; e < 4; ++e) { const int k = 16 * (ks0 + e) + 8 * h2;
                    xa[e] = *(const GAS v4u*)(src + k); pa[e] = *(const GAS f32x4*)(pe + k); pb2[e] = *(const GAS f32x4*)(pe + k + 4);
                    a0[e] = *(const GAS bf16x8*)(w1t + k); a1[e] = *(const GAS bf16x8*)(w1t + 32 * 2048 + k); }
                __builtin_amdgcn_sched_barrier(0);
#pragma unroll
                for (int e = 0; e < 4; ++e) {
                    v4u xb; xb.x = cvtpk(bflo(xa[e].x) + pa[e].x, bfhi(xa[e].x) + pa[e].y); xb.y = cvtpk(bflo(xa[e].y) + pa[e].z, bfhi(xa[e].y) + pa[e].w);
                    xb.z = cvtpk(bflo(xa[e].z) + pb2[e].x, bfhi(xa[e].z) + pb2[e].y); xb.w = cvtpk(bflo(xa[e].w) + pb2[e].z, bfhi(xa[e].w) + pb2[e].w);
                    const bf16x8 bfr = __builtin_bit_cast(bf16x8, xb);
                    H0 = MFMA32(a0[e], bfr, H0); H1 = MFMA32(a1[e], bfr, H1); }
            }
            float g[32];
#pragma unroll
            for (int r = 0; r < 16; ++r) { const float x0 = H0[r], x1 = H1[r];
                g[r] = 0.5f * x0 * (1.f + tanhf(0.7978845608028654f * (x0 + 0.044715f * x0 * x0 * x0))); g[16 + r] = 0.5f * x1 * (1.f + tanhf(0.7978845608028654f * (x1 + 0.044715f * x1 * x1 * x1))); }
            const float* w2 = a->in[IN_CW2] + ((size_t)layer * 2 + which) * 64 * 64;
            f32x16 E0 = zero16(), E1 = zero16();
#pragma unroll
            for (int s = 0; s < 4; ++s) { v4u gw_; gw_.x = cvtpk(g[8 * s], g[8 * s + 1]); gw_.y = cvtpk(g[8 * s + 2], g[8 * s + 3]); gw_.z = cvtpk(g[8 * s + 4], g[8 * s + 5]); gw_.w = cvtpk(g[8 * s + 6], g[8 * s + 7]);
                const bf16x8 gb = __builtin_bit_cast(bf16x8, gw_);
                float wa[8], wb[8];
#pragma unroll
                for (int j = 0; j < 8; ++j) { const int n = 16 * s + 8 * (j >> 2) + 4 * h2 + (j & 3); wa[j] = w2[(size_t)n * 64 + ql]; wb[j] = w2[(size_t)n * 64 + 32 + ql]; }
                v4u ua, ub; ua.x = cvtpk(wa[0], wa[1]); ua.y = cvtpk(wa[2], wa[3]); ua.z = cvtpk(wa[4], wa[5]); ua.w = cvtpk(wa[6], wa[7]);
                ub.x = cvtpk(wb[0], wb[1]); ub.y = cvtpk(wb[2], wb[3]); ub.z = cvtpk(wb[4], wb[5]); ub.w = cvtpk(wb[6], wb[7]);
                E0 = MFMA32(__builtin_bit_cast(bf16x8, ua), gb, E0); E1 = MFMA32(__builtin_bit_cast(bf16x8, ub), gb, E1); }
            const float zs = (i > 126) ? 0.f : 1.f;
            if (which == 0) store_ot(kcb + ((size_t)b * 128 + i) * 64, E0, E1, zs, h2);
            else {
#pragma unroll
                for (int r = 0; r < 16; ++r) { const int m = (r & 3) + 8 * (r >> 2) + 4 * h2;
                    vct[((size_t)b * 64 + m) * 128 + i] = (bf16)f2bf(E0[r] * zs); vct[((size_t)b * 64 + 32 + m) * 128 + i] = (bf16)f2bf(E1[r] * zs); } }
        }
        if (u < U_CMP) {
            asm volatile("s_waitcnt vmcnt(0)" ::: "memory"); __syncthreads();
            if (tid == 0) { __builtin_amdgcn_fence(__ATOMIC_RELEASE, "agent"); asm volatile("s_waitcnt vmcnt(0)" ::: "memory"); __hip_atomic_store(cflag + u, 1u, __ATOMIC_RELAXED, __HIP_MEMORY_SCOPE_AGENT); } }
        if (tid == 0) LQ[0] = nxt_u;
        __syncthreads();
    }
}


__device__ __forceinline__ void dil_merge_phase(CArgs* a, int G, int c, const int wave) {
    unsigned char* ws = a->ws; bf16* O4 = (bf16*)(ws + A_O4);
    {
        const bf16* DILO = (const bf16*)(ws + A_DIL + DILO_OFF); const float* DILL = (const float*)(ws + A_DIL + DILL_OFF);
        const int lane = lane_id_l(), gw = c * NWAVES + wave, NGW = G * NWAVES, hh = lane >> 4;
        for (int r = gw; r < TH; r += NGW) {
            const float l0 = DILL[((size_t)0 * TH + r) * 4 + hh], l1 = DILL[((size_t)1 * TH + r) * 4 + hh], l2 = DILL[((size_t)2 * TH + r) * 4 + hh];
            const float mx = fmaxf(l0, fmaxf(l1, l2)); const float e0 = __expf(l0 - mx), e1 = __expf(l1 - mx), e2 = __expf(l2 - mx); const float inv = 1.f / (e0 + e1 + e2);
            const unsigned long long y0 = *((const GAS unsigned long long*)(DILO + ((size_t)0 * TH + r) * 256) + lane), y1 = *((const GAS unsigned long long*)(DILO + ((size_t)1 * TH + r) * 256) + lane),
                                     y2 = *((const GAS unsigned long long*)(DILO + ((size_t)2 * TH + r) * 256) + lane);
            const float w0 = e0 * inv, w1 = e1 * inv, w2 = e2 * inv;
            const unsigned a0 = (unsigned)y0, b0 = (unsigned)(y0 >> 32), a1 = (unsigned)y1, b1 = (unsigned)(y1 >> 32), a2 = (unsigned)y2, b2 = (unsigned)(y2 >> 32);
            const unsigned o_lo = pk2(w0 * bflo(a0) + w1 * bflo(a1) + w2 * bflo(a2), w0 * bfhi(a0) + w1 * bfhi(a1) + w2 * bfhi(a2));
            const unsigned o_hi = pk2(w0 * bflo(b0) + w1 * bflo(b1) + w2 * bflo(b2), w0 * bfhi(b0) + w1 * bfhi(b1) + w2 * bfhi(b2));
            *((GAS unsigned long long*)(O4 + (size_t)r * 1024 + 2 * 256) + lane) = (unsigned long long)o_lo | ((unsigned long long)o_hi << 32);
        }
    }
}

#ifndef PROBE_REP
#define PROBE_REP 0
#endif
#define NREP(k) ((PROBE_REP == (k) || (PROBE_REP == 20 && (k) == 20)) ? 2 : 1)
#ifndef PROBE_SKIP
#define PROBE_SKIP 0
#endif
#define SKIP(k) (PROBE_REP == 20 && PROBE_SKIP == (k) && pass_ == 0)
constexpr int PH_PER_LAYER = 27, PH_END = 1 + 2 * PH_PER_LAYER;
__global__ void __launch_bounds__(NWAVES * 64, 2) fwd(Args args_unused) {
    extern __shared__ __attribute__((aligned(16))) unsigned char lds_raw[];
    LAS unsigned char* lds = (LAS unsigned char*)lds_raw;
    volatile LAS unsigned* MISC = (volatile LAS unsigned*)(lds + MISC_OFF);
    const int GK = gridDim.x, cK = blockIdx.x;
    const int wave_s = __builtin_amdgcn_readfirstlane(threadIdx.x >> 6);
    for (int u = threadIdx.x; u < (LDS_BYTES - MISC_OFF) / 4; u += NWAVES * 64) ((LAS unsigned*)(lds + MISC_OFF))[u] = 0u;
    __syncthreads();
    int lo, hi;
    XcdBarrier bar;
    { CArgs* a = get_args(); lo = a->ph_lo; hi = a->ph_hi; unsigned* ctl0 = (unsigned*)(a->ws + WS_CTL);
      bar.bar = ctl0 + CW_BAR; bar.x = 0; bar.st = MISC + 8;
      if (hi - lo > 1) bar = xcd_barrier_post(ctl0 + CW_BAR, MISC + 8); }
#define IN(k) ({ int l_ = lo, h_ = hi; asm volatile("" : "+s"(l_), "+s"(h_)); (l_ <= (k)) && ((k) < h_); })
#define SEAM(k) do { int h_ = hi; asm volatile("" : "+s"(h_)); if ((k) + 1 < h_) { xcd_barrier(bar, wave_s); if (PROBE_REP == 10) xcd_barrier(bar, wave_s); } } while (0)
#define PHASE_VARS CArgs* a = get_args(); unsigned char* ws = a->ws; int G = GK, c = cK; asm volatile("" : "+s"(G), "+s"(c)); \
    const int NGW = G * NWAVES, lane = lane_id_l(), wave = wave_s, tid = wave_s * 64 + lane, gw = c * NWAVES + wave; (void)lane; (void)gw; (void)ws; (void)tid; (void)NGW;
#define SKIPSEAM(k, id) if (SKIP(k) && IN(id)) { SEAM(id); }
#define WPTR(off) ((const bf16*)(ws + WS_W + (off)))

    if (IN(0)) { _Pragma("unroll") for (int rep_ = 0; rep_ < NREP(1); ++rep_) { PHASE_VARS p0_prologue<0>(a, lds, G, c, wave_s); } SEAM(0); }

    for (int pass_ = 0; pass_ < NREP(20); ++pass_)
    for (int layer = 0; layer < 2; ++layer) {
        const int pb = 1 + layer * PH_PER_LAYER;
        for (int hf = 0; hf < NHALF; ++hf) {
            const int p = pb + 7 * hf;
            if (layer == 0 && IN(p + 0) && !SKIP(11)) { _Pragma("unroll") for (int rep_ = 0; rep_ < NREP(11); ++rep_) { PHASE_VARS
                ln_mod_phase((layer == 0) ? a->in[IN_X] : a->out, (const float*)(ws + WS_MOD) + (size_t)layer * 16 * 6144, (bf16*)(ws + A_HY), hf, G, c, wave, lane, lds); } SEAM(p + 0); }
            if (layer == 0) { SKIPSEAM(11, p + 0) }
            if (IN(p + 1) && !SKIP(4)) { _Pragma("unroll") for (int rep_ = 0; rep_ < NREP(4); ++rep_) { PHASE_VARS
                pg8::Gemm g{(const bf16*)(ws + A_HY), WPTR(W_IN + layer * W_IN_L), TH, D, D}; pg8::InProjOrder S; S.init(TH, 14 * 256, G, c, D);
                pg8::EpiInProj E{(bf16*)(ws + A_QKV), (float*)(ws + WS_NG), HT_ELEMS};
                pg8::gemm_phase<pg8::EpiInProj, pg8::InProjOrder, true, true>(lds, g, S, E, wave_s); }
                SEAM(p + 1);
            }
            SKIPSEAM(4, p + 1)
            if (IN(p + 2) && !SKIP(2)) { _Pragma("unroll") for (int rep_ = 0; rep_ < NREP(2); ++rep_) { PHASE_VARS attn_queue_phase(a, layer, layer + 4 * rep_ + 8 * pass_, lds, wave_s); } SEAM(p + 2); }
            SKIPSEAM(2, p + 2)
            if (IN(p + 3) && !SKIP(3)) { _Pragma("unroll") for (int rep_ = 0; rep_ < NREP(3); ++rep_) { PHASE_VARS dil_merge_phase(a, G, c, wave_s); } SEAM(p + 3); }
            SKIPSEAM(3, p + 3)
            if (IN(p + 4) && !SKIP(5)) { _Pragma("unroll") for (int rep_ = 0; rep_ < NREP(5); ++rep_) { PHASE_VARS
                pg8::Gemm g{(const bf16*)(ws + A_HY), WPTR(W_IN + layer * W_IN_L + W_GATE), TH, D, D};
                const int vc = (G % 8 == 0) ? (c % 8) * (G / 8) + c / 8 : c;
                pg8::MergeOrder S{(TH / 256) * 4, G, vc, (int)((A_O4 - A_HY) / TILE_B), 17};
                pg8::EpiMerge E{(bf16*)(ws + A_MERGED), (bf16*)(ws + A_PS) + (size_t)c * 65536, (int)((A_O4 - A_HY) / TILE_B), 17};
                pg8::gemm_phase<pg8::EpiMerge, pg8::MergeOrder, true, true>(lds, g, S, E, wave_s); }
                SEAM(p + 4);
            }
            SKIPSEAM(5, p + 4)
            if (IN(p + 5) && !SKIP(6)) { _Pragma("unroll") for (int rep_ = 0; rep_ < NREP(6); ++rep_) { PHASE_VARS
                pg8::Gemm g{(const bf16*)(ws + A_MERGED), WPTR(W_OUT + layer * W_OUT_L), TH, D, D}; pg8::StaticOrder S; S.init(TH, D, G, c, D);
                pg8::EpiBf16 E{(bf16*)(ws + A_HY), D, 1 << 20, 1 << 30, 0};
                pg8::gemm_phase<pg8::EpiBf16, pg8::StaticOrder, true, true>(lds, g, S, E, wave_s); }
                SEAM(p + 5);
            }
            SKIPSEAM(6, p + 5)
            if (IN(p + 6) && !(SKIP(12) && layer == 0)) { PHASE_VARS
                const float* mod_l = (const float*)(ws + WS_MOD) + (size_t)layer * 16 * 6144;
                const float* lng = a->in[IN_LNG] + (size_t)(layer * 2 + 0) * D; const float* lnb = a->in[IN_LNB] + (size_t)(layer * 2 + 0) * D;
                if (layer == 0) post_norm_phase<0, true, false>(a, a->in[IN_X], a->out, (const bf16*)(ws + A_HY), (size_t)hf * TH, mod_l + 2048, lng, lnb, mod_l + 3072, (bf16*)(ws + A_H2), hf * TH, TH, G, c, wave, lane, CW_CNT + 32 * pass_, lds);
                else            post_norm_phase<0, true, true >(a, a->out, a->out, (const bf16*)(ws + A_HY), (size_t)hf * TH, mod_l + 2048, lng, lnb, mod_l + 3072, (bf16*)(ws + A_H2), hf * TH, TH, G, c, wave, lane, CW_CNT + 32 * pass_, lds);
                SEAM(p + 6);
            }
            if (SKIP(12) && layer == 0 && IN(p + 6)) { SEAM(p + 6); }
        }
        const int pf = pb + 14;
        if (layer == 0) {
            if (IN(pf + 0) && !SKIP(7)) { _Pragma("unroll") for (int rep_ = 0; rep_ < NREP(7); ++rep_) { PHASE_VARS
                pg8::Gemm g{(const bf16*)(ws + A_H2), WPTR(W_GU), T, D, D}; pg8::StaticOrder S; S.init(T, 2 * DFF, G, c, D);
                pg8::EpiSwiGLU E{(bf16*)(ws + A_ACT), DFF, 1 << 20};
                pg8::gemm_phase<pg8::EpiSwiGLU, pg8::StaticOrder, true, true>(lds, g, S, E, wave_s); }
                SEAM(pf + 0);
            }
            SKIPSEAM(7, pf + 0)
            if (IN(pf + 1) && !SKIP(7)) { _Pragma("unroll") for (int rep_ = 0; rep_ < NREP(7); ++rep_) { PHASE_VARS
                pg8::Gemm g{(const bf16*)(ws + A_ACT), WPTR(W_DN), T, DFF, DFF}; pg8::StaticOrder S; S.init(T, D, G, c, DFF);
                pg8::EpiBf16 E{(bf16*)(ws + A_Y2), D, 1 << 20, 1 << 30, 0};
                pg8::gemm_phase<pg8::EpiBf16, pg8::StaticOrder, true, true>(lds, g, S, E, wave_s); }
                SEAM(pf + 1);
            }
            SKIPSEAM(7, pf + 1)
            if (IN(pf + 2) && !SKIP(13)) { PHASE_VARS
                const float* mod_l = (const float*)(ws + WS_MOD) + (size_t)layer * 16 * 6144;
                const float* lng = a->in[IN_LNG] + (size_t)(layer * 2 + 1) * D; const float* lnb = a->in[IN_LNB] + (size_t)(layer * 2 + 1) * D;
                post_norm_phase<0, true, false>(a, a->out, a->out, (const bf16*)(ws + A_Y2), 0, mod_l + 5120, lng, lnb, mod_l + 16 * 6144  , (bf16*)(ws + A_HY), 0, T, G, c, wave, lane, CW_CNT + 32 * pass_, lds);
                SEAM(pf + 2);
            }
            SKIPSEAM(13, pf + 2)
        } else {
            if (IN(pf + 0) && !SKIP(13)) { PHASE_VARS p0_prologue<1>(a, lds, G, c, wave_s); moe_sort_phase(a, (const bf16*)(ws + A_H2), (bf16*)(ws + A_AS), gw, NGW, lane, CW_CNT + 32 * pass_); SEAM(pf + 0); }
            SKIPSEAM(13, pf + 0)
#define LOAD_NT int nt[8], NT = 0; { const unsigned* cnt = (const unsigned*)(ws + WS_CTL) + CW_CNT + 32 * pass_; _Pragma("unroll") for (int e = 0; e < 8; ++e) { nt[e] = ((int)__builtin_amdgcn_readfirstlane(cnt[e]) + 255) >> 8; NT += nt[e]; } } \
                const int nch = (NT + MOE_CT - 1) / MOE_CT, cs = (NT + nch - 1) / nch, tlo = ch * cs, thi = (tlo + cs < NT) ? tlo + cs : NT;
            for (int ch = 0; ch < MOE_MAXCH; ++ch) {
                const int pc = pf + 1 + 2 * ch;
                if (IN(pc + 0) && !SKIP(8)) { _Pragma("unroll") for (int rep_ = 0; rep_ < NREP(8); ++rep_) { PHASE_VARS LOAD_NT
                    if (tlo < NT) {
                    if (ch == 0) p0_prologue<2>(a, lds, G, c, wave_s);
                    pg8::Gemm g{(const bf16*)(ws + A_AS), (const bf16*)(ws + A_MGU), MOE_ROWS, D, D};
                    pg8::GroupedOrder S{nt[0], nt[1], nt[2], nt[3], nt[4], nt[5], nt[6], nt[7], 2 * DFFE / 256, G, (G % 8 == 0) ? (c % 8) * (G / 8) + c / 8 : c, 1, D, tlo, thi};
                    pg8::EpiSwiGLU E{(bf16*)(ws + A_ACTE) - (size_t)tlo * 256 * DFFE, DFFE, 2 * DFFE / 256};
                    pg8::gemm_phase<pg8::EpiSwiGLU, pg8::GroupedOrder, true, true>(lds, g, S, E, wave_s); } }
                    { PHASE_VARS LOAD_NT if (tlo < NT) { SEAM(pc + 0); } }
                }
                SKIPSEAM(8, pc + 0)
                if (IN(pc + 1) && !SKIP(9)) { _Pragma("unroll") for (int rep_ = 0; rep_ < NREP(9); ++rep_) { PHASE_VARS LOAD_NT
                    if (tlo < NT) {
                    pg8::Gemm g{(const bf16*)(ws + A_ACTE) - (size_t)tlo * 256 * DFFE, (const bf16*)(ws + A_MDN), MOE_ROWS, DFFE, DFFE};
                    pg8::GroupedOrder S{nt[0], nt[1], nt[2], nt[3], nt[4], nt[5], nt[6], nt[7], D / 256, G, (G % 8 == 0) ? (c % 8) * (G / 8) + c / 8 : c, 1, DFFE, tlo, thi};
                    pg8::EpiBf16 E{(bf16*)(ws + A_YP), D, D / 256, 1 << 30, 0};
                    pg8::gemm_phase<pg8::EpiBf16, pg8::GroupedOrder, true, true>(lds, g, S, E, wave_s); } }
                    { PHASE_VARS LOAD_NT if (tlo < NT) { SEAM(pc + 1); } }
                }
                SKIPSEAM(9, pc + 1)
            }
            if (IN(pf + 11) && !SKIP(13)) { PHASE_VARS
                const float* mod_l = (const float*)(ws + WS_MOD) + (size_t)layer * 16 * 6144;
                const float* lng = a->in[IN_LNG] + (size_t)(layer * 2 + 1) * D; const float* lnb = a->in[IN_LNB] + (size_t)(layer * 2 + 1) * D;
                post_norm_phase<1, false, false>(a, a->out, a->out, (const bf16*)(ws + A_YP), 0, mod_l + 5120, lng, lnb, mod_l, nullptr, 0, T, G, c, wave, lane, CW_CNT + 32 * pass_, lds);
            }
        }
    }
#undef IN
#undef SEAM
}

#ifndef MK_PER_PHASE
#define MK_PER_PHASE 0
#endif
extern "C" void kernel_launch(void* const* d_in, const int* in_sizes, int n_in, void* d_out, int out_size, void* d_ws, size_t ws_size, hipStream_t stream) {
    static int grid = 0;
    if (grid == 0) {
        if (n_in != 21 || out_size != T * D || ws_size < WS_END) { fprintf(stderr, "kernel_launch: unexpected shapes (n_in %d out %d ws %zu need %zu)\n", n_in, out_size, ws_size, (size_t)WS_END); grid = -1; return; }
        int dev = 0, cus = 0, per_cu = 0;
        if (hipGetDevice(&dev) != hipSuccess || hipDeviceGetAttribute(&cus, hipDeviceAttributeMultiprocessorCount, dev) != hipSuccess) { grid = -1; return; }
        if (hipFuncSetAttribute((const void*)fwd, hipFuncAttributeMaxDynamicSharedMemorySize, LDS_BYTES) != hipSuccess) { fprintf(stderr, "kernel_launch: hipFuncSetAttribute failed\n"); grid = -1; return; }
        if (hipOccupancyMaxActiveBlocksPerMultiprocessor(&per_cu, (const void*)fwd, NWAVES * 64, LDS_BYTES) != hipSuccess || per_cu < 1) fprintf(stderr, "kernel_launch: occupancy query reports %d\n", per_cu);
        (void)hipGetLastError();
        grid = cus;
    }
    if (grid < 0) return;
    if (hipMemsetAsync((char*)d_ws + WS_CTL, 0, CTL_ZERO_BYTES, stream) != hipSuccess) return;
    Args a{};
    for (int i = 0; i < 21; ++i) a.in[i] = (const float*)d_in[i];
    a.out = (float*)d_out; a.ws = (unsigned char*)d_ws;
#if MK_PER_PHASE
    for (int ph = 0; ph < PH_END; ++ph) {
        const int k = (ph - 1) % PH_PER_LAYER, layer = (ph - 1) / PH_PER_LAYER;
        if (ph > 0 && layer == 0 && k > 16) continue;
        a.ph_lo = ph; a.ph_hi = ph + 1;
        hipLaunchKernelGGL(fwd, dim3(grid), dim3(NWAVES * 64), LDS_BYTES, stream, a);
    }
#else
    a.ph_lo = 0; a.ph_hi = PH_END;
    hipLaunchKernelGGL(fwd, dim3(grid), dim3(NWAVES * 64), LDS_BYTES, stream, a);
#endif
}
```

```cpp
#include <hip/hip_runtime.h>
#include <cstdio>
#include <cstdint>

namespace pg8 {
#define PG8_LAS __attribute__((address_space(3)))
typedef unsigned short bf16_t;
typedef short bf16x8 __attribute__((ext_vector_type(8)));
typedef float f32x4 __attribute__((ext_vector_type(4)));
typedef unsigned u32x4 __attribute__((ext_vector_type(4)));
constexpr int BM = 256, BK = 64, HALF = 128, HTB = HALF * BK * 2  , STAGE_BYTES = 8 * HTB, NXCD = 8, WGM = 8;

__host__ __device__ __forceinline__ int lds_byte(int r, int c) { const int st = (r >> 4) * 2 + (c >> 5), rr = r & 15, cc = c & 31, ob = rr * 64 + cc * 2; return st * 1024 + (ob ^ (((ob >> 9) & 1) << 5)); }
__host__ __device__ __forceinline__ void stage_rc(int b, int& R, int& C) { const int st = b / 1024, sb = b % 1024, swz = sb ^ (((sb >> 9) & 1) << 5); R = (st >> 1) * 16 + swz / 64; C = (st & 1) * 32 + (swz % 64) / 2; }
__host__ __device__ __forceinline__ int perm32(int rho) { const int n = rho >> 4, i = rho & 15; return 8 * (i >> 2) + 4 * n + (i & 3); }

struct Unit { int pm, pn, ko, kl; };
struct Gemm { const bf16_t* A; const bf16_t* Bt; int M, N, K; };

struct StaticOrder {
    int nM, nN, nwg, G, c, kl;
    __host__ __device__ void init(int M, int N, int G_, int c_, int kl_) { nM = M / BM; nN = N / BM; nwg = nM * nN; G = G_; c = c_; kl = kl_; }
    __host__ __device__ bool next(int i, Unit& u) const {
        const long L = (long)i * G + c; if (L >= nwg) return false;
        int wgid = (int)L; { const int q = nwg / NXCD, r = nwg % NXCD, xcd = wgid % NXCD, off = wgid / NXCD; wgid = (xcd < r ? xcd * (q + 1) : r * (q + 1) + (xcd - r) * q) + off; }
        const int nig = WGM * nN, gid = wgid / nig, fm = gid * WGM, gsz = (nM - fm) < WGM ? (nM - fm) : WGM;
        u.pm = fm + ((wgid % nig) % gsz); u.pn = (wgid % nig) / gsz; u.ko = 0; u.kl = kl; return true;
    }
    __device__ __forceinline__ void a_ready(const Unit&) const {}
    __device__ __forceinline__ void done(const Unit&) const {}
};

struct InProjOrder : StaticOrder {
    __device__ __forceinline__ bool next(int i, Unit& u) const { if (!StaticOrder::next(i, u)) return false; if (u.pn == 13) u.pn = 28; return true; }
};

__device__ __forceinline__ unsigned cvt_pk_bf16(float lo, float hi) { unsigned r; asm volatile("v_cvt_pk_bf16_f32 %0, %1, %2" : "=v"(r) : "v"(lo), "v"(hi)); return r; }
__device__ __forceinline__ int lane_now() { int l; asm volatile("v_mbcnt_lo_u32_b32 %0, -1, 0\n\tv_mbcnt_hi_u32_b32 %0, -1, %0" : "=v"(l)); return l; }
__device__ __forceinline__ float sigmoidf_(float v) { return __builtin_amdgcn_rcpf(1.f + __expf(-v)); }
__device__ __forceinline__ float bflo(unsigned u) { return __uint_as_float(u << 16); }
__device__ __forceinline__ float bfhi(unsigned u) { return __uint_as_float(u & 0xffff0000u); }

__device__ __forceinline__ void st16(void* ubase, unsigned voff, u32x4 w) { *(u32x4*)((char*)ubase + voff) = w; }
__device__ __forceinline__ u32x4 ld16(const void* ubase, unsigned voff) { return *(const u32x4*)((const char*)ubase + voff); }
__device__ __forceinline__ u32x4 pack8(const f32x4 v0, const f32x4 v1) { u32x4 w; w.x = cvt_pk_bf16(v0[0], v0[1]); w.y = cvt_pk_bf16(v0[2], v0[3]); w.z = cvt_pk_bf16(v1[0], v1[1]); w.w = cvt_pk_bf16(v1[2], v1[3]); return w; }
struct EpiBf16 {
    static constexpr bool PERM = true, AFTER_DRAIN = false;
    bf16_t* O; int ldc; int pn_mod; int klen; size_t kstride;
    __device__ __forceinline__ void operator()(const f32x4 (&acc)[2][2][4][2], const Unit& u, int wr, int wc, int, int) const {
        const int ln_ = lane_now(), fr = ln_ & 15, fq = ln_ >> 4;
        const unsigned voff = (unsigned)((wr * 64 + fr) * ldc + wc * 32 + 8 * fq) * 2u;
        char* tb = (char*)O + ((size_t)(u.ko / klen) * kstride + (size_t)u.pm * BM * ldc + (size_t)(u.pn % pn_mod) * BM) * 2;
#pragma unroll
        for (int ai = 0; ai < 2; ++ai)
#pragma unroll
            for (int m = 0; m < 4; ++m)
#pragma unroll
                for (int bj = 0; bj < 2; ++bj) st16(tb + ((size_t)(ai * HALF + m * 16) * ldc + bj * HALF) * 2, voff, pack8(acc[ai][bj][m][0], acc[ai][bj][m][1]));
    }
};
struct EpiSwiGLU {
    static constexpr bool PERM = true, AFTER_DRAIN = false;
    bf16_t* O; int ldc; int pn_mod;
    __device__ __forceinline__ void operator()(const f32x4 (&acc)[2][2][4][2], const Unit& u, int wr, int wc, int, int) const {
        const int ln_ = lane_now(), fr = ln_ & 15, fq = ln_ >> 4;
        const unsigned voff = (unsigned)((wr * 64 + fr) * ldc + wc * 32 + 8 * fq) * 2u;
        char* tb = (char*)O + ((size_t)u.pm * BM * ldc + (size_t)(u.pn % pn_mod) * HALF) * 2;
#pragma unroll
        for (int ai = 0; ai < 2; ++ai)
#pragma unroll
            for (int m = 0; m < 4; ++m) {
                f32x4 r0, r1;
#pragma unroll
                for (int j = 0; j < 4; ++j) { const float g0 = acc[ai][0][m][0][j], u0 = acc[ai][1][m][0][j], g1 = acc[ai][0][m][1][j], u1 = acc[ai][1][m][1][j];
                    r0[j] = g0 * sigmoidf_(g0) * u0; r1[j] = g1 * sigmoidf_(g1) * u1; }
                st16(tb + (size_t)(ai * HALF + m * 16) * ldc * 2, voff, pack8(r0, r1)); }
    }
};
struct EpiInProj {
    static constexpr bool PERM = true, AFTER_DRAIN = false;
    bf16_t* qkv; float* ng; size_t ht;
    __device__ __forceinline__ void operator()(const f32x4 (&acc)[2][2][4][2], const Unit& u, int wr, int wc, int, int) const {
        const int ln_ = lane_now(), fr = ln_ & 15, fq = ln_ >> 4;
        const int rl = wr * 64 + fr;
#pragma unroll
        for (int bj = 0; bj < 2; ++bj) {
            const int colblk = u.pn * BM + bj * HALF + wc * 32;
            const int hb = colblk >> 6, cin = (colblk & 63) + 8 * fq;
            if (hb < 50) {
                const bool vt = (hb == 7) | (hb == 9) | (hb == 16) | (hb == 17) | (hb >= 34 && hb < 38) | (hb >= 46);
                if (!vt) {
                    char* tb = (char*)qkv + ((size_t)hb * ht + (size_t)u.pm * BM * 64) * 2; const unsigned voff = (unsigned)(rl * 64 + cin) * 2u;
#pragma unroll
                    for (int ai = 0; ai < 2; ++ai)
#pragma unroll
                        for (int m = 0; m < 4; ++m) st16(tb + (size_t)(ai * HALF + m * 16) * 64 * 2, voff, pack8(acc[ai][bj][m][0], acc[ai][bj][m][1]));
                } else {
                    const int bb = u.pm >> 3, s0 = (u.pm & 7) * BM + rl;
                    char* tb = (char*)qkv + ((size_t)hb * ht + ((size_t)bb * 64 + (colblk & 63)) * 2048) * 2;
                    const bool dilv = (hb >= 34 && hb < 38);
                    char* t4 = (char*)qkv + ((size_t)(50 + (hb - 34) * 2) * ht + ((size_t)bb * 64 + (colblk & 63)) * 2048) * 2; char* t16 = t4 + ht * 2;
#pragma unroll
                    for (int ai = 0; ai < 2; ++ai)
#pragma unroll
                        for (int m = 0; m < 4; ++m) { const int s = s0 + ai * HALF + m * 16; const u32x4 w = pack8(acc[ai][bj][m][0], acc[ai][bj][m][1]);
                            {
                                const int j = fr & 7; u32x4 t = w;
#define PG8_SWZ(v, m) ((unsigned)__builtin_amdgcn_ds_swizzle((int)(v), ((m) << 10) | 0x1f))
                                { const unsigned s0 = (j & 4) ? t.x : t.z, s1 = (j & 4) ? t.y : t.w; const unsigned r0 = PG8_SWZ(s0, 4), r1 = PG8_SWZ(s1, 4);
                                  if (j & 4) { t.x = r0; t.y = r1; } else { t.z = r0; t.w = r1; } }
                                { const unsigned s0 = (j & 2) ? t.x : t.y, s1 = (j & 2) ? t.z : t.w; const unsigned r0 = PG8_SWZ(s0, 2), r1 = PG8_SWZ(s1, 2);
                                  if (j & 2) { t.x = r0; t.z = r1; } else { t.y = r0; t.w = r1; } }
                                { const unsigned p0 = PG8_SWZ(t.x, 1), p1 = PG8_SWZ(t.y, 1), p2 = PG8_SWZ(t.z, 1), p3 = PG8_SWZ(t.w, 1);
                                  if (j & 1) { t.x = (p0 >> 16) | (t.x & 0xffff0000u); t.y = (p1 >> 16) | (t.y & 0xffff0000u); t.z = (p2 >> 16) | (t.z & 0xffff0000u); t.w = (p3 >> 16) | (t.w & 0xffff0000u); }
                                  else       { t.x = (t.x & 0xffffu) | (p0 << 16); t.y = (t.y & 0xffffu) | (p1 << 16); t.z = (t.z & 0xffffu) | (p2 << 16); t.w = (t.w & 0xffffu) | (p3 << 16); } }
#undef PG8_SWZ
                                st16(tb, (unsigned)((8 * fq + j) * 2048 + (s - j)) * 2u, t);
                            }
                            if (dilv) {
                                const unsigned v4 = (unsigned)(8 * fq * 2048 + (s & 3) * 512 + (s >> 2)) * 2u, v16 = (unsigned)(8 * fq * 2048 + (s & 15) * 128 + (s >> 4)) * 2u;
                                *(unsigned short*)(t4 + v4) = (unsigned short)w.x; *(unsigned short*)(t4 + v4 + 4096) = (unsigned short)(w.x >> 16);
                                *(unsigned short*)(t4 + v4 + 2 * 4096) = (unsigned short)w.y; *(unsigned short*)(t4 + v4 + 3 * 4096) = (unsigned short)(w.y >> 16);
                                *(unsigned short*)(t4 + v4 + 4 * 4096) = (unsigned short)w.z; *(unsigned short*)(t4 + v4 + 5 * 4096) = (unsigned short)(w.z >> 16);
                                *(unsigned short*)(t4 + v4 + 6 * 4096) = (unsigned short)w.w; *(unsigned short*)(t4 + v4 + 7 * 4096) = (unsigned short)(w.w >> 16);
                                *(unsigned short*)(t16 + v16) = (unsigned short)w.x; *(unsigned short*)(t16 + v16 + 4096) = (unsigned short)(w.x >> 16);
                                *(unsigned short*)(t16 + v16 + 2 * 4096) = (unsigned short)w.y; *(unsigned short*)(t16 + v16 + 3 * 4096) = (unsigned short)(w.y >> 16);
                                *(unsigned short*)(t16 + v16 + 4 * 4096) = (unsigned short)w.z; *(unsigned short*)(t16 + v16 + 5 * 4096) = (unsigned short)(w.z >> 16);
                                *(unsigned short*)(t16 + v16 + 6 * 4096) = (unsigned short)w.w; *(unsigned short*)(t16 + v16 + 7 * 4096) = (unsigned short)(w.w >> 16);
                            } }
                }
            } else if (hb == 114) {
                if (cin < 16) {
                    char* tb = (char*)ng + (size_t)u.pm * BM * 16 * 4; const unsigned voff = (unsigned)(rl * 16 + cin) * 4u;
#pragma unroll
                    for (int ai = 0; ai < 2; ++ai)
#pragma unroll
                        for (int m = 0; m < 4; ++m) { char* p = tb + (size_t)(ai * HALF + m * 16) * 16 * 4;
                            *(f32x4*)(p + voff) = acc[ai][bj][m][0]; *(f32x4*)(p + 16 + voff) = acc[ai][bj][m][1]; }
                }
            }
        }
    }
};
struct MergeOrder {
    int ntile, G, c, pm_off, pn_off;
    __device__ __forceinline__ bool next(int i, Unit& u) const {
        const int tl = (i >> 3) * G + c, sub = i & 7, br = sub >> 1; if (tl >= ntile) return false;
        const int pml = tl >> 2, pnl = tl & 3;
        if (sub & 1) { u.pm = pml; u.pn = br * 4 + pnl; u.ko = 0; u.kl = 1024; }
        else         { u.pm = pm_off + pml; u.pn = pn_off + pnl; u.ko = br * 256; u.kl = 256; }
        return true;
    }
    __device__ __forceinline__ void a_ready(const Unit&) const {}
    __device__ __forceinline__ void done(const Unit&) const {}
};
struct EpiMerge {
    static constexpr bool PERM = true, AFTER_DRAIN = false;
    bf16_t* merged; bf16_t* scratch; int pm_off, pn_off;
    __device__ __forceinline__ void operator()(const f32x4 (&acc)[2][2][4][2], const Unit& u, int wr, int wc, int, int) const {
        const int ln_ = lane_now(), fr = ln_ & 15, fq = ln_ >> 4;
        const int rl = wr * 64 + fr, cl = wc * 32 + 8 * fq;
        const unsigned voffs = (unsigned)(rl * 256 + cl) * 2u;
        if (u.kl == 256) {
#pragma unroll
            for (int ai = 0; ai < 2; ++ai)
#pragma unroll
                for (int m = 0; m < 4; ++m)
#pragma unroll
                    for (int bj = 0; bj < 2; ++bj) st16((char*)scratch + ((size_t)(ai * HALF + m * 16) * 256 + bj * HALF) * 2, voffs, pack8(acc[ai][bj][m][0], acc[ai][bj][m][1]));
        } else {
            const int br = u.pn >> 2, pml = u.pm, pnl = u.pn & 3;
            const unsigned voffm = (unsigned)(rl * 1024 + cl) * 2u;
            char* tm = (char*)merged + ((size_t)pml * BM * 1024 + (size_t)pnl * BM) * 2;
#pragma unroll
            for (int ai = 0; ai < 2; ++ai) {
                u32x4 pz[4][2], om[4][2];
#pragma unroll
                for (int m = 0; m < 4; ++m)
#pragma unroll
                    for (int bj = 0; bj < 2; ++bj) { pz[m][bj] = ld16((const char*)scratch + ((size_t)(ai * HALF + m * 16) * 256 + bj * HALF) * 2, voffs);
                        om[m][bj] = ld16(tm + ((size_t)(ai * HALF + m * 16) * 1024 + bj * HALF) * 2, voffm); }
                __builtin_amdgcn_sched_barrier(0);
                const unsigned keep = (br != 0) ? 0xffffffffu : 0u;
#pragma unroll
                for (int m = 0; m < 4; ++m)
#pragma unroll
                    for (int bj = 0; bj < 2; ++bj) { const f32x4 v0 = acc[ai][bj][m][0], v1 = acc[ai][bj][m][1]; const u32x4 z = pz[m][bj]; u32x4 o = om[m][bj]; o.x &= keep; o.y &= keep; o.z &= keep; o.w &= keep;
                        f32x4 r0, r1;
                        r0[0] = bflo(z.x) * sigmoidf_(v0[0]) + bflo(o.x); r0[1] = bfhi(z.x) * sigmoidf_(v0[1]) + bfhi(o.x); r0[2] = bflo(z.y) * sigmoidf_(v0[2]) + bflo(o.y); r0[3] = bfhi(z.y) * sigmoidf_(v0[3]) + bfhi(o.y);
                        r1[0] = bflo(z.z) * sigmoidf_(v1[0]) + bflo(o.z); r1[1] = bfhi(z.z) * sigmoidf_(v1[1]) + bfhi(o.z); r1[2] = bflo(z.w) * sigmoidf_(v1[2]) + bflo(o.w); r1[3] = bfhi(z.w) * sigmoidf_(v1[3]) + bfhi(o.w);
                        st16(tm + ((size_t)(ai * HALF + m * 16) * 1024 + bj * HALF) * 2, voffm, pack8(r0, r1)); }
            }
        }
    }
};
struct GroupedOrder {
    int nt0, nt1, nt2, nt3, nt4, nt5, nt6, nt7; int ncol, G, c, ksplit, klen, tlo, thi;
    __device__ __forceinline__ bool next(int i, Unit& u) const {
        int L = i * G + c; u.kl = klen; int to = 0;
#define PG8_GO(e, nte) { const int a_ = to > tlo ? to : tlo, b_ = (to + (nte)) < thi ? (to + (nte)) : thi, ne_ = b_ - a_; if (ne_ > 0) { const int n = ne_ * ncol * ksplit; if (L < n) { \
            const int bw = 8 * ncol * ksplit, band = L / bw, Lb = L - band * bw, nb = (ne_ - 8 * band) < 8 ? (ne_ - 8 * band) : 8, ks = Lb / (nb * ncol), r = Lb - ks * nb * ncol, pnl = r / nb; \
            u.ko = ks * klen; u.pn = (e) * ncol + pnl; u.pm = a_ + 8 * band + (r - pnl * nb); return true; } L -= n; } to += (nte); }
        PG8_GO(0, nt0) PG8_GO(1, nt1) PG8_GO(2, nt2) PG8_GO(3, nt3) PG8_GO(4, nt4) PG8_GO(5, nt5) PG8_GO(6, nt6) PG8_GO(7, nt7)
#undef PG8_GO
        return false;
    }
    __device__ __forceinline__ void a_ready(const Unit&) const {}
    __device__ __forceinline__ void done(const Unit&) const {}
};

template <class Epi, class Sched, bool ALIGN_EPI = false, bool SP2 = false>
__device__ __forceinline__ void gemm_phase(PG8_LAS unsigned char* lds, const Gemm g, const Sched& S, const Epi& E, const int wave_s  ) {
    const int tid_l = lane_now() + 64 * wave_s;
    const int tid = tid_l, wid = wave_s, lane = tid & 63, wr = wid >> 2, wc = wid & 3, fr = lane & 15, fq = lane >> 4;
    const int K = g.K;
    unsigned voffA[2], voffB[2];
#pragma unroll
    for (int i = 0; i < 2; ++i) { int R, C; stage_rc(tid * 16 + i * 8192, R, C); const int Rb = Epi::PERM ? ((R & ~31) + perm32(R & 31)) : R;
        voffA[i] = (unsigned)(R * K + C) * 2u; voffB[i] = (unsigned)(Rb * K + C) * 2u; }
    const size_t kstep = (size_t)(BK * 2);
    const size_t hstep = (size_t)HALF * K * 2;
    const size_t tstep = 2 * hstep;
    const unsigned ldsw = (unsigned)wid * 1024u;
    const int aoff = lds_byte(wr * 64 + fr, fq * 8), boff = lds_byte(wc * 32 + fr, fq * 8);
#define PG8_SA(b, h) (((b) * 2 + (h)) * HTB)
#define PG8_SB(b, h) ((4 + (b) * 2 + (h)) * HTB)
#define PG8_STAGE(bufoff, gbase, voff) do { _Pragma("unroll") for (int _i = 0; _i < 2; ++_i) \
        __builtin_amdgcn_global_load_lds((const unsigned*)((const char*)(gbase) + (voff)[_i]), (PG8_LAS unsigned*)(lds + (bufoff) + ldsw + _i * 8192), 16, 0, 0); } while (0)
#define PG8_LDA(dst, b, h) do { _Pragma("unroll") for (int m = 0; m < 4; ++m) _Pragma("unroll") for (int k = 0; k < 2; ++k) dst[m][k] = *(const PG8_LAS bf16x8*)(lds + PG8_SA(b, h) + aoff + m * 2048 + k * 1024); } while (0)
#define PG8_LDB(dst, b, h) do { _Pragma("unroll") for (int n = 0; n < 2; ++n) _Pragma("unroll") for (int k = 0; k < 2; ++k) dst[n][k] = *(const PG8_LAS bf16x8*)(lds + PG8_SB(b, h) + boff + n * 2048 + k * 1024); } while (0)
#define PG8_MMA(ai, bj, At, Bt) do { __builtin_amdgcn_s_setprio(1); _Pragma("unroll") for (int m = 0; m < 4; ++m) _Pragma("unroll") for (int n = 0; n < 2; ++n) _Pragma("unroll") for (int k = 0; k < 2; ++k) \
        acc[ai][bj][m][n] = __builtin_amdgcn_mfma_f32_16x16x32_bf16(Bt[n][k], At[m][k], acc[ai][bj][m][n], 0, 0, 0); __builtin_amdgcn_s_setprio(0); } while (0)
#define PG8_WAIT_V(n) asm volatile("s_waitcnt vmcnt(" #n ")" ::: "memory")
#define PG8_WAIT_L(n) asm volatile("s_waitcnt lgkmcnt(" #n ")" ::: "memory")
#define PG8_BAR __builtin_amdgcn_s_barrier()
#define PG8_SCHED __builtin_amdgcn_sched_barrier(0)
    Unit cur, nxt; int ui = 0;
    if (!S.next(0, cur)) return;
    f32x4 acc[2][2][4][2];
#pragma unroll
    for (int a = 0; a < 2; ++a)
#pragma unroll
        for (int b = 0; b < 2; ++b)
#pragma unroll
            for (int m = 0; m < 4; ++m)
#pragma unroll
                for (int n = 0; n < 2; ++n) acc[a][b][m][n] = (f32x4){0.f, 0.f, 0.f, 0.f};
    bf16x8 At[4][2], B0[2][2], B1[2][2];
    const char* cA = (const char*)g.A + (size_t)cur.pm * tstep + (size_t)cur.ko * 2; const char* cB = (const char*)g.Bt + (size_t)cur.pn * tstep + (size_t)cur.ko * 2;
    S.a_ready(cur);
    if constexpr (SP2) {
        PG8_STAGE(PG8_SB(0, 0), cB, voffB); PG8_STAGE(PG8_SB(0, 1), cB + hstep, voffB); PG8_STAGE(PG8_SA(0, 0), cA, voffA); PG8_STAGE(PG8_SA(0, 1), cA + hstep, voffA);
        if (wr == 1) PG8_BAR;
        PG8_WAIT_V(2); PG8_BAR;
        PG8_STAGE(PG8_SB(1, 0), cB + kstep, voffB); PG8_STAGE(PG8_SA(1, 0), cA + kstep, voffA); PG8_STAGE(PG8_SB(1, 1), cB + hstep + kstep, voffB);
        PG8_WAIT_V(6); PG8_BAR;
    } else {
        PG8_STAGE(PG8_SB(0, 0), cB, voffB); PG8_STAGE(PG8_SA(0, 0), cA, voffA); PG8_STAGE(PG8_SB(0, 1), cB + hstep, voffB); PG8_STAGE(PG8_SA(0, 1), cA + hstep, voffA);
        if (wr == 1) PG8_BAR;
        PG8_WAIT_V(4); PG8_BAR;
        PG8_STAGE(PG8_SB(1, 0), cB + kstep, voffB); PG8_STAGE(PG8_SA(1, 0), cA + kstep, voffA); PG8_STAGE(PG8_SB(1, 1), cB + hstep + kstep, voffB);
        PG8_WAIT_V(6); PG8_BAR;
    }
    for (;;) {
        const bool has_next = S.next(ui + 1, nxt);
        const char* nA = has_next ? (const char*)g.A + (size_t)nxt.pm * tstep + (size_t)nxt.ko * 2 : cA; const char* nB = has_next ? (const char*)g.Bt + (size_t)nxt.pn * tstep + (size_t)nxt.ko * 2 : cB;
        const int nt = cur.kl / BK;
        for (int t = 0; t < nt; t += 2) {
            const bool last = (t == nt - 2);
            const char* a1 = cA + (size_t)(t + 1) * kstep;
            const char* a2 = last ? nA : cA + (size_t)(t + 2) * kstep; const char* b2 = last ? nB : cB + (size_t)(t + 2) * kstep;
            const char* a3 = a2 + kstep; const char* b3 = b2 + kstep;
            if (last && has_next) S.a_ready(nxt);
            if constexpr (SP2) {
            PG8_LDB(B0, 0, 0); PG8_LDB(B1, 0, 1); PG8_SCHED; PG8_LDA(At, 0, 0); PG8_STAGE(PG8_SA(1, 1), a1 + hstep, voffA);
            PG8_WAIT_V(8); PG8_WAIT_L(0); PG8_BAR; PG8_MMA(0, 0, At, B0); PG8_MMA(0, 1, At, B1); PG8_BAR; PG8_SCHED;
            PG8_LDA(At, 0, 1); PG8_STAGE(PG8_SB(0, 0), b2, voffB); PG8_STAGE(PG8_SB(0, 1), b2 + hstep, voffB); PG8_STAGE(PG8_SA(0, 0), a2, voffA);
            PG8_WAIT_V(8); PG8_WAIT_L(0); PG8_BAR; PG8_MMA(1, 0, At, B0); PG8_MMA(1, 1, At, B1); PG8_BAR; PG8_SCHED;
            PG8_LDB(B0, 1, 0); PG8_LDB(B1, 1, 1); PG8_SCHED; PG8_LDA(At, 1, 0); PG8_STAGE(PG8_SA(0, 1), a2 + hstep, voffA);
            PG8_WAIT_V(8); PG8_WAIT_L(0); PG8_BAR; PG8_MMA(0, 0, At, B0); PG8_MMA(0, 1, At, B1); PG8_BAR; PG8_SCHED;
            PG8_LDA(At, 1, 1); PG8_STAGE(PG8_SB(1, 0), b3, voffB); PG8_STAGE(PG8_SB(1, 1), b3 + hstep, voffB); PG8_STAGE(PG8_SA(1, 0), a3, voffA);
            PG8_WAIT_V(8); PG8_WAIT_L(0); PG8_BAR; PG8_MMA(1, 0, At, B0); PG8_MMA(1, 1, At, B1); PG8_BAR; PG8_SCHED;
            } else {
            PG8_LDB(B0, 0, 0); PG8_SCHED; PG8_LDA(At, 0, 0); PG8_STAGE(PG8_SA(1, 1), a1 + hstep, voffA);
            PG8_WAIT_L(8); PG8_BAR; PG8_WAIT_L(0); PG8_MMA(0, 0, At, B0); PG8_BAR; PG8_SCHED;
            PG8_LDB(B1, 0, 1); PG8_STAGE(PG8_SB(0, 0), b2, voffB);
            PG8_BAR; PG8_WAIT_L(0); PG8_MMA(0, 1, At, B1); PG8_BAR;
            PG8_LDA(At, 0, 1); PG8_STAGE(PG8_SA(0, 0), a2, voffA);
            PG8_BAR; PG8_WAIT_L(0); PG8_MMA(1, 0, At, B0); PG8_BAR; PG8_SCHED;
            PG8_STAGE(PG8_SB(0, 1), b2 + hstep, voffB);
            PG8_WAIT_V(6); PG8_BAR; PG8_MMA(1, 1, At, B1); PG8_BAR;
            PG8_LDB(B0, 1, 0); PG8_SCHED; PG8_LDA(At, 1, 0); PG8_STAGE(PG8_SA(0, 1), a2 + hstep, voffA);
            PG8_WAIT_L(8); PG8_BAR; PG8_WAIT_L(0); PG8_MMA(0, 0, At, B0); PG8_BAR; PG8_SCHED;
            PG8_LDB(B1, 1, 1); PG8_STAGE(PG8_SB(1, 0), b3, voffB);
            PG8_BAR; PG8_WAIT_L(0); PG8_MMA(0, 1, At, B1); PG8_BAR;
            PG8_LDA(At, 1, 1); PG8_STAGE(PG8_SA(1, 0), a3, voffA);
            PG8_BAR; PG8_WAIT_L(0); PG8_MMA(1, 0, At, B0); PG8_BAR; PG8_SCHED;
            PG8_STAGE(PG8_SB(1, 1), b3 + hstep, voffB);
            PG8_WAIT_V(6); PG8_BAR; PG8_MMA(1, 1, At, B1); PG8_BAR;
            }
        }
        if constexpr (ALIGN_EPI) { if (wr == 0) PG8_BAR; }
        if constexpr (!Epi::AFTER_DRAIN) { E(acc, cur, wr, wc, fr, fq); S.done(cur); }
        if (!has_next) break;
#pragma unroll
        for (int a = 0; a < 2; ++a)
#pragma unroll
            for (int b = 0; b < 2; ++b)
#pragma unroll
                for (int m = 0; m < 4; ++m)
#pragma unroll
                    for (int n = 0; n < 2; ++n) acc[a][b][m][n] = (f32x4){0.f, 0.f, 0.f, 0.f};
        cur = nxt; cA = nA; cB = nB; ++ui;
        if constexpr (ALIGN_EPI) { if (wr == 1) PG8_BAR; }
    }
    PG8_WAIT_V(0);
    if constexpr (!ALIGN_EPI) { if (wr == 0) PG8_BAR; }
    PG8_BAR;
    if constexpr (Epi::AFTER_DRAIN) { E.fused(acc, cur, wr, wc, fr, fq, lds, wid, lane); S.done(cur); }
#undef PG8_SA
#undef PG8_SB
#undef PG8_STAGE
#undef PG8_LDA
#undef PG8_LDB
#undef PG8_MMA
#undef PG8_WAIT_V
#undef PG8_WAIT_L
#undef PG8_BAR
#undef PG8_SCHED
}
}

constexpr int NWAVES = 8;
constexpr int D = 1024, BATCH = 16, SEQ = 2048, T = BATCH * SEQ, NHALF = 1, TH = T / NHALF, BH = BATCH / NHALF;
constexpr int DIN = 7308, DINP = 7424;
constexpr int DFF = 2816, DFFE = 3584, NE = 8;
constexpr int MOE_ROWS = 2 * T + NE * 256;
constexpr int MOE_CT = 64, MOE_MAXCH = 5;
constexpr float ALPHA = 1.4142135623730951f, LN_EPS = 1e-5f;
constexpr int NBH = 20;
constexpr int HT_NSAQ = 0, HT_KCMP = 4, HT_VCMP = 5, HT_KSEL = 6, HT_VSEL = 7, HT_KWIN = 8, HT_VWIN = 9, HT_SWAQ = 10, HT_SWAK = 14, HT_SWAV = 16,
              HT_DILQ = 18, HT_DILK = 30, HT_DILV = 34, HT_SBQ = 38, HT_SBK = 42, HT_SBV = 46, NHT = 58;
constexpr size_t HT_ELEMS = (size_t)TH * 64;

constexpr size_t MiB = 1u << 20;
constexpr size_t WS_CTL = 0, CTL_ZERO_BYTES = 1 * MiB;
constexpr size_t WS_MOD = 1 * MiB;
constexpr size_t WS_BIAS = 2 * MiB;
constexpr size_t WS_ROUTE = 3 * MiB;
constexpr size_t WS_KC = 4 * MiB;
constexpr size_t WS_C1 = 5 * MiB;
constexpr size_t WS_NG = 6 * MiB;
constexpr size_t WS_W = 8 * MiB;
constexpr size_t TILE_B = (size_t)256 * D * 2;
constexpr size_t W_IN = 0, W_IN_L = 34 * TILE_B;
constexpr size_t W_GATE = (size_t)3200 * D * 2, W_BRC = W_GATE + 17 * TILE_B;
constexpr size_t W_OUT = W_IN + 2 * W_IN_L, W_OUT_L = (size_t)D * D * 2;
constexpr size_t W_GU = W_OUT + 2 * W_OUT_L;
constexpr size_t W_DN = W_GU + (size_t)2 * DFF * D * 2;
constexpr size_t W_END = W_DN + (size_t)D * DFF * 2;
static_assert(WS_W + W_END <= 64 * MiB, "weights");
constexpr size_t WS_ACT = 64 * MiB;
constexpr size_t A_H2 = WS_ACT;
constexpr size_t A_HY = WS_ACT + 64 * MiB;
constexpr size_t A_QKV = WS_ACT + 128 * MiB, A_MERGED = A_QKV;
constexpr size_t A_O4 = WS_ACT + 360 * MiB;
constexpr size_t A_DIL = WS_ACT + 424 * MiB;
constexpr size_t A_PS = WS_ACT + 474 * MiB;
constexpr size_t A_ACT = WS_ACT + 64 * MiB, A_Y2 = WS_ACT + 240 * MiB;
constexpr size_t A_MGU = WS_ACT + 196 * MiB, W_MGU_E = (size_t)2 * DFFE * D * 2;
constexpr size_t A_MDN = WS_ACT + 0 * MiB, W_MDN_E = (size_t)D * DFFE * 2;
constexpr size_t A_AS = WS_ACT + 64 * MiB, A_ACTE = WS_ACT + 308 * MiB, A_YP = WS_ACT + 420 * MiB;
constexpr size_t WS_END = WS_ACT + 556 * MiB;
static_assert((A_O4 - A_HY) % TILE_B == 0, "tile offsets");
static_assert(NHT * HT_ELEMS * 2 <= 232 * MiB && A_AS + (size_t)MOE_ROWS * D * 2 <= A_MGU && A_ACTE + (size_t)MOE_CT * 256 * DFFE * 2 <= A_YP && A_YP + (size_t)MOE_ROWS * D * 2 <= WS_END
              && A_DIL + (size_t)3 * TH * 256 * 2 + (size_t)3 * TH * 16 <= A_PS && A_MGU + NE * W_MGU_E <= A_ACTE && A_MDN + NE * W_MDN_E <= A_AS, "arena");
constexpr int CW_BAR = 4096, CW_CNT = 16384, CW_QUEUE = 20480, CW_CMPF = 24576;

constexpr int RING_BYTES = 131072, LDS_BYTES = 155648, MISC_OFF = LDS_BYTES - 512;

#define GAS __attribute__((address_space(1)))
#define LAS __attribute__((address_space(3)))
typedef unsigned short bf16;
typedef unsigned v4u __attribute__((ext_vector_type(4)));
typedef float f32x4 __attribute__((ext_vector_type(4)));
#define LDS_WAIT() asm volatile("s_waitcnt lgkmcnt(0)" ::: "memory")
__device__ __forceinline__ unsigned f2bf(float f) { unsigned u = __builtin_bit_cast(unsigned, f); return (u + 0x7fffu + ((u >> 16) & 1u)) >> 16; }
__device__ __forceinline__ unsigned pk2(float lo, float hi) { return f2bf(lo) | (f2bf(hi) << 16); }
__device__ __forceinline__ float bflo(unsigned u) { return __uint_as_float(u << 16); }
__device__ __forceinline__ float bfhi(unsigned u) { return __uint_as_float(u & 0xffff0000u); }
__device__ __forceinline__ float sigm(float v) { return 1.f / (1.f + __expf(-v)); }

__device__ __forceinline__ int lane_id_l() { return pg8::lane_now(); }
#define XB_TMO      128
#define XB_XCNT(j)  (256  + 64 * (j))
#define XB_XSUB(j)  (1280 + 64 * (j))
#define XB_XGEN(j)  (2304 + 64 * (j))
#define XB_TOP      3328
#define XB_TOPGEN   3392
#define XCD_BAR_WORDS 3456
#define XB_SPIN_CAP (1u << 18)
__device__ __forceinline__ unsigned xb_ld(unsigned* p)              { return __hip_atomic_load(p, __ATOMIC_RELAXED, __HIP_MEMORY_SCOPE_AGENT); }
__device__ __forceinline__ unsigned xb_add(unsigned* p, unsigned v) { return __hip_atomic_fetch_add(p, v, __ATOMIC_RELAXED, __HIP_MEMORY_SCOPE_AGENT); }
__device__ __forceinline__ unsigned xb_xcc_id() { return (unsigned)__builtin_amdgcn_s_getreg((3 << 11) | 20) & 0xFu; }
#define XB_SPIN(cond, bar) do { unsigned _sp = 0; while (cond) { __builtin_amdgcn_s_sleep(1); \
    if ((++_sp & 255u) == 0u) { if (xb_ld(&(bar)[XB_TMO])) break; if (_sp > XB_SPIN_CAP) { atomicAdd(&(bar)[XB_TMO], 1u); break; } } } } while (0)
struct XcdBarrier { unsigned* bar; unsigned x; volatile LAS unsigned* st; };
__device__ __forceinline__ XcdBarrier xcd_barrier_post(unsigned* bar, volatile LAS unsigned* st) {
    XcdBarrier b; b.bar = bar; b.x = xb_xcc_id(); b.st = st;
    if (threadIdx.x == 0) (void)xb_add(&bar[XB_XCNT(b.x)], 1u);
    return b;
}
__device__ __forceinline__ void xcd_barrier_complete(unsigned* bar, unsigned x, unsigned& nloc, unsigned& nx) {
    const unsigned G = gridDim.x * gridDim.y * gridDim.z;
    unsigned sum, cnt, mine, sp = 0u;
    for (;;) {
        sum = 0u; cnt = 0u; mine = 0u;
#pragma unroll
        for (unsigned j = 0; j < 16; ++j) { const unsigned c = xb_ld(&bar[XB_XCNT(j)]); sum += c; cnt += (c > 0u) ? 1u : 0u; }
        mine = xb_ld(&bar[XB_XCNT(x)]);
        if (sum == G) break;
        __builtin_amdgcn_s_sleep(1);
        if ((++sp & 255u) == 0u) { if (xb_ld(&bar[XB_TMO])) break; if (sp > XB_SPIN_CAP) { atomicAdd(&bar[XB_TMO], 1u); break; } }
    }
    nloc = mine > 0u ? mine : 1u; nx = cnt > 0u ? cnt : 1u;
}
__device__ __forceinline__ void xcd_barrier(const XcdBarrier& b, const int wave_s) {
    asm volatile("s_waitcnt vmcnt(0)" ::: "memory");
    __syncthreads();
    if (wave_s == 0 && lane_id_l() == 0) {
        unsigned* bar = b.bar; asm volatile("" : "+s"(bar));
        __builtin_amdgcn_s_waitcnt(0);
        unsigned nloc = b.st[0], nx = b.st[1];
        if (nloc == 0u) { xcd_barrier_complete(bar, b.x, nloc, nx); b.st[0] = nloc; b.st[1] = nx; }
        const unsigned old = xb_add(&bar[XB_XSUB(b.x)], 1u);
        const unsigned gen = old / nloc;
        if (old + 1u == (gen + 1u) * nloc) {
            __builtin_amdgcn_fence(__ATOMIC_RELEASE, "agent");
            asm volatile("s_waitcnt vmcnt(0)" ::: "memory");
            const unsigned og = xb_add(&bar[XB_TOP], 1u);
            const unsigned tg = og / nx;
            if (og + 1u == (tg + 1u) * nx) xb_add(&bar[XB_TOPGEN], 1u);
            else XB_SPIN(xb_ld(&bar[XB_TOPGEN]) == tg, bar);
            __builtin_amdgcn_fence(__ATOMIC_ACQUIRE, "agent");
            xb_add(&bar[XB_XGEN(b.x)], 1u);
            asm volatile("s_waitcnt vmcnt(0)" ::: "memory");
        } else {
            XB_SPIN(xb_ld(&bar[XB_XGEN(b.x)]) == gen, bar);
            __builtin_amdgcn_fence(__ATOMIC_ACQUIRE, "agent");
            asm volatile("s_waitcnt vmcnt(0)" ::: "memory");
        }
    }
    __syncthreads();
}

struct Args { const float* in[21]; float* out; unsigned char* ws; int ph_lo, ph_hi; };
typedef __attribute__((address_space(4))) const Args CArgs;
__device__ __forceinline__ CArgs* get_args() { CArgs* p = (CArgs*)__builtin_amdgcn_kernarg_segment_ptr(); asm volatile("" : "+s"(p)); return p; }
enum { IN_X = 0, IN_C, IN_RELB, IN_WADA, IN_BADA, IN_WIN, IN_WBR, IN_WOUT, IN_CPE, IN_CW1, IN_CW2, IN_SINK, IN_LNG, IN_LNB, IN_FG, IN_FU, IN_FD, IN_MR, IN_MG, IN_MU, IN_MD };

#define DPPF(v, ctrl) __int_as_float(__builtin_amdgcn_update_dpp(0, __float_as_int(v), (ctrl), 0xF, 0xF, true))
__device__ __forceinline__ float row_sum16(float v) { v += DPPF(v, 0xB1); v += DPPF(v, 0x4E); v += DPPF(v, 0x141); v += DPPF(v, 0x140); return v; }
__device__ __forceinline__ float rows_total(float v) {
    const int i = __float_as_int(v);
    return (__int_as_float(__builtin_amdgcn_readlane(i, 0)) + __int_as_float(__builtin_amdgcn_readlane(i, 16))) + (__int_as_float(__builtin_amdgcn_readlane(i, 32)) + __int_as_float(__builtin_amdgcn_readlane(i, 48)));
}
__device__ __forceinline__ float wave_sum(float v, int) { return rows_total(row_sum16(v)); }
__device__ __forceinline__ unsigned shfl_xor_u(unsigned v, int m, int lane) { return (unsigned)__builtin_amdgcn_ds_bpermute((lane ^ m) << 2, (int)v); }
__device__ __forceinline__ float shfl_f(float v, int src) { return __int_as_float(__builtin_amdgcn_ds_bpermute(src << 2, __float_as_int(v))); }

__device__ __forceinline__ void transpose_item(int mode, const float* src0, const float* src1, int Nsrc, int ldw  , int nblk, bf16* WT, LAS float* scr, int item, int lane) {
    const int kb = item / nblk, nb = item % nblk, k0 = 64 * kb, n0 = 32 * nb;
    const int n = n0 + (lane & 31);
    const float* cb;
    if (mode == 0) cb = src0 + n;
    else if (mode == 1) cb = (n < 640) ? src0 + n : (n < 7296) ? src0 + n + 12 : (n < 7308) ? src0 + (n - 7296 + 640) : nullptr;
    else { const int g = n >> 8, w = n & 255; cb = (w < 128) ? src0 + 128 * g + w : src1 + 128 * g + (w - 128); }
    float tv[32];
#pragma unroll
    for (int i = 0; i < 32; ++i) { const int kk = 2 * i + (lane >> 5); tv[i] = cb ? cb[(size_t)(k0 + kk) * Nsrc] : 0.f; }
#pragma unroll
    for (int i = 0; i < 32; ++i) { const int kk = 2 * i + (lane >> 5); scr[kk * 33 + (lane & 31)] = tv[i]; }
    LDS_WAIT(); asm volatile("" ::: "memory");
    const int c = lane & 7;
#pragma unroll
    for (int j = 0; j < 4; ++j) { const int nn = (lane >> 3) + 8 * j; const LAS float* s = scr + (8 * c) * 33 + nn;
        v4u o; o.x = pk2(s[0 * 33], s[1 * 33]); o.y = pk2(s[2 * 33], s[3 * 33]); o.z = pk2(s[4 * 33], s[5 * 33]); o.w = pk2(s[6 * 33], s[7 * 33]);
        *(GAS v4u*)(WT + (size_t)(n0 + nn) * ldw + k0 + 8 * c) = o; }
    LDS_WAIT(); asm volatile("" ::: "memory");
}

__device__ __forceinline__ int t5_bucket(int d) {
    if (d < 16) return d;
    int b = 16;
    b += (d >= 22); b += (d >= 30); b += (d >= 40); b += (d >= 54); b += (d >= 73); b += (d >= 99); b += (d >= 134); b += (d >= 182);
    b += (d >= 246); b += (d >= 332); b += (d >= 450); b += (d >= 609); b += (d >= 825); b += (d >= 1117); b += (d >= 1513);
    return b;
}

template <int MOE_ONLY>
__device__ __forceinline__ void p0_prologue(CArgs* a, LAS unsigned char* lds, int G, int c, const int wave) {
    const int lane = lane_id_l(), tid = wave * 64 + lane;
    unsigned char* ws = a->ws; bf16* W = (bf16*)(ws + WS_W);
    LAS float* scr = (LAS float*)(lds + wave * 16384);
    const int gw = c * NWAVES + wave, NGW = G * NWAVES;
    constexpr int I_WIN = 16 * (DINP / 32), I_WBR = 4 * 32, I_WOUT = 16 * 32, I_GU = 16 * (2 * DFF / 32), I_DN = (DFF / 64) * 32, I_MGU = 16 * (2 * DFFE / 32), I_MDN = (DFFE / 64) * 32;
    constexpr int I_C1 = (2048 / 64) * 2;
    constexpr int NITEMS = MOE_ONLY == 1 ? NE * I_MGU : MOE_ONLY == 2 ? NE * I_MDN : (2 * I_WIN + 8 * I_WBR + 2 * I_WOUT + I_GU + I_DN + 4 * I_C1);
    for (int it = gw; it < NITEMS; it += NGW) {
        int r = it, mode = 0, Nsrc, K, nblk; const float* s0; const float* s1 = nullptr; bf16* dst;
        if (MOE_ONLY) {
            if (MOE_ONLY == 1) { const int e = r / I_MGU; r -= e * I_MGU; mode = 2; s0 = a->in[IN_MG] + (size_t)e * D * DFFE; s1 = a->in[IN_MU] + (size_t)e * D * DFFE; Nsrc = DFFE; K = D; nblk = 2 * DFFE / 32; dst = (bf16*)(ws + A_MGU + e * W_MGU_E); }
            else { const int e = r / I_MDN; r -= e * I_MDN; s0 = a->in[IN_MD] + (size_t)e * DFFE * D; Nsrc = D; K = DFFE; nblk = 32; dst = (bf16*)(ws + A_MDN + e * W_MDN_E); }
        } else {
        if (r < 2 * I_WIN) { const int l = r / I_WIN; r -= l * I_WIN; mode = 1; s0 = a->in[IN_WIN] + (size_t)l * D * DIN; Nsrc = DIN; K = D; nblk = DINP / 32; dst = (bf16*)((char*)W + W_IN + l * W_IN_L); }
        else { r -= 2 * I_WIN;
        if (r < 8 * I_WBR) { const int j = r / I_WBR; r -= j * I_WBR; s0 = a->in[IN_WBR] + (size_t)j * 256 * D; Nsrc = D; K = D; nblk = 32; dst = (bf16*)((char*)W + W_IN + (j >> 2) * W_IN_L + W_BRC) + (j & 3) * 256; }
        else { r -= 8 * I_WBR;
        if (r < 2 * I_WOUT) { const int l = r / I_WOUT; r -= l * I_WOUT; s0 = a->in[IN_WOUT] + (size_t)l * D * D; Nsrc = D; K = D; nblk = 32; dst = (bf16*)((char*)W + W_OUT + l * W_OUT_L); }
        else { r -= 2 * I_WOUT;
        if (r < I_GU) { mode = 2; s0 = a->in[IN_FG]; s1 = a->in[IN_FU]; Nsrc = DFF; K = D; nblk = 2 * DFF / 32; dst = (bf16*)((char*)W + W_GU); }
        else { r -= I_GU;
        if (r < I_DN) { s0 = a->in[IN_FD]; Nsrc = D; K = DFF; nblk = 32; dst = (bf16*)((char*)W + W_DN); }
        else { r -= I_DN; const int j = r / I_C1; r -= j * I_C1; s0 = a->in[IN_CW1] + (size_t)j * 2048 * 64; Nsrc = 64; K = 2048; nblk = 2; dst = (bf16*)(ws + WS_C1) + (size_t)j * 64 * 2048; }
        }}}}
        }
        transpose_item(mode, s0, s1, Nsrc, K, nblk, dst, scr, r, lane);
    }
    __syncthreads();
    if (MOE_ONLY) return;
    if (c < 192) {
        LAS float* sc = (LAS float*)lds;
        LAS float* part = (LAS float*)(lds + 65536);
        for (int i = tid; i < 16 * D; i += 512) { const float v = a->in[IN_C][i]; sc[i] = v * sigm(v); }
        __syncthreads();
        const int l = c / 96, j0 = (c % 96) * 64;
        const float* wa = a->in[IN_WADA] + (size_t)l * D * 6144 + j0 + lane;
        float acc[16];
#pragma unroll
        for (int b = 0; b < 16; ++b) acc[b] = 0.f;
#pragma unroll 1
        for (int k8 = wave * 128; k8 < wave * 128 + 128; k8 += 8) { float wv[8];
#pragma unroll
            for (int e = 0; e < 8; ++e) wv[e] = wa[(size_t)(k8 + e) * 6144];
#pragma unroll
            for (int e = 0; e < 8; ++e) {
#pragma unroll
                for (int b = 0; b < 16; ++b) acc[b] = fmaf(sc[b * D + k8 + e], wv[e], acc[b]);
                asm volatile("" ::: "memory"); } }
#pragma unroll
        for (int b = 0; b < 16; ++b) part[(wave * 16 + b) * 64 + lane] = acc[b];
        __syncthreads();
        float* mod = (float*)(ws + WS_MOD);
        for (int o = tid; o < 16 * 64; o += 512) { const int b = o >> 6, j = o & 63; float s = a->in[IN_BADA][l * 6144 + j0 + j];
#pragma unroll
            for (int w = 0; w < 8; ++w) s += part[(w * 16 + b) * 64 + j];
            mod[((size_t)l * 16 + b) * 6144 + j0 + j] = s; }
        __syncthreads();
    } else {
        float* bt = (float*)(ws + WS_BIAS);
        for (int i = (c - 192) * 512 + tid; i < NBH * 2048; i += (G - 192) * 512) { const int h = i >> 11, d = i & 2047; bt[i] = a->in[IN_RELB][t5_bucket(d) * NBH + h]; }
    }
}

__device__ __forceinline__ void ln_stats(const f32x4 (&v)[4], float& mean, float& rstd, int) {
    float s = 0.f, s2 = 0.f;
#pragma unroll
    for (int j = 0; j < 4; ++j) { s += (v[j].x + v[j].y) + (v[j].z + v[j].w); s2 += (v[j].x * v[j].x + v[j].y * v[j].y) + (v[j].z * v[j].z + v[j].w * v[j].w); }
    s = row_sum16(s); s2 = row_sum16(s2);
    mean = rows_total(s) * (1.f / D);
    const float var = fmaxf(rows_total(s2) * (1.f / D) - mean * mean, 0.f);
    rstd = 1.f / sqrtf(var + LN_EPS);
}
__device__ __forceinline__ void store_bf16_row(bf16* orow, const f32x4 (&v)[4], int lane) {
    GAS unsigned long long* o8 = (GAS unsigned long long*)orow + lane;
#pragma unroll
    for (int j = 0; j < 4; ++j) o8[64 * j] = (unsigned long long)pk2(v[j].x, v[j].y) | ((unsigned long long)pk2(v[j].z, v[j].w) << 32);
}
__device__ __forceinline__ void ln_mod_phase(const float* xsrc, const float* mod_l, bf16* H, int half, int G, int c, int wave, int lane, LAS unsigned char* lds) {
    const int rpb = TH / G, rpw = rpb / NWAVES, rbase = c * rpb, b = (half * TH + rbase) >> 11;
    LAS f32x4* Lsh = (LAS f32x4*)lds; LAS f32x4* Lsc = Lsh + 256;
    { const int tid = wave * 64 + lane; const GAS f32x4* src = (const GAS f32x4*)(mod_l + (size_t)b * 6144); if (tid < 256) Lsh[tid] = src[tid]; else Lsc[tid - 256] = src[tid] + 1.f; }
    __syncthreads();
    const int r0 = rbase + wave * rpw;
    for (int rr = 0; rr < rpw; rr += 4) {
        f32x4 xx[4][4];
#pragma unroll
        for (int q = 0; q < 4; ++q) { const GAS f32x4* xr = (const GAS f32x4*)(xsrc + (size_t)(half * TH + r0 + rr + q) * D) + lane;
#pragma unroll
            for (int j = 0; j < 4; ++j) xx[q][j] = xr[64 * j]; }
#pragma unroll
        for (int q = 0; q < 4; ++q) { const int r = r0 + rr + q;
            f32x4 v[4];
#pragma unroll
            for (int j = 0; j < 4; ++j) v[j] = xx[q][j];
            float mean, rstd; ln_stats(v, mean, rstd, lane);
#pragma unroll
            for (int j = 0; j < 4; ++j) v[j] = (v[j] - mean) * rstd * Lsc[lane + 64 * j] + Lsh[lane + 64 * j];
            store_bf16_row(H + (size_t)r * D, v, lane); }
    }
    __syncthreads();
}
template <int YMODE, bool WRITE_H2, bool ROUTE>
__device__ __forceinline__ void post_norm_phase(CArgs* a, const float* xsrc, float* xdst, const bf16* Y, size_t yrow_off, const float* gvec_l  , const float* lng, const float* lnb,
                                                const float* modh  , bf16* H2, int row_lo, int nrows, int G, int c, int wave, int lane, int cbase, LAS unsigned char* lds) {
    unsigned char* ws = a->ws; unsigned* ctl = (unsigned*)(ws + WS_CTL); unsigned* route = (unsigned*)(ws + WS_ROUTE);
    const int rpb = nrows / G, rpw = rpb / NWAVES, rfirst = c * rpb + wave * rpw, bb = (row_lo + c * rpb) >> 11;
    LAS f32x4* Lg = (LAS f32x4*)lds; LAS f32x4* Llg = Lg + 256; LAS f32x4* Llb = Lg + 512; LAS f32x4* Lsh = Lg + 768; LAS f32x4* Lsc = Lg + 1024;
    { const int tid = wave * 64 + lane;
      for (int i = tid; i < 1280; i += 512) { const int wv = i >> 8, k = i & 255; f32x4 val;
          if (wv == 0) val = ((const GAS f32x4*)(gvec_l + (size_t)bb * 6144))[k]; else if (wv == 1) val = ((const GAS f32x4*)lng)[k]; else if (wv == 2) val = ((const GAS f32x4*)lnb)[k];
          else if (wv == 3) val = ((const GAS f32x4*)(modh + (size_t)bb * 6144))[k]; else val = ((const GAS f32x4*)(modh + (size_t)bb * 6144 + 1024))[k] + 1.f;
          Lg[i] = val; } }
    LAS f32x4* Lwr = Lg + 1280;
    if (ROUTE) { const int tid = wave * 64 + lane; const GAS f32x4* wsrc = (const GAS f32x4*)a->in[IN_MR]; for (int i = tid; i < 2048; i += 512) Lwr[i] = wsrc[i]; }
    __syncthreads();
    const int gw = rfirst, NGW = 1; (void)NGW;
    f32x4 nx[4]; unsigned long long ny[4];
    if (YMODE == 0 && rpw > 0) { const GAS f32x4* xr0 = (const GAS f32x4*)(xsrc + (size_t)(row_lo + gw) * D) + lane; const GAS unsigned long long* y0 = (const GAS unsigned long long*)(Y + ((size_t)(row_lo + gw) - yrow_off) * D) + lane;
#pragma unroll
        for (int j = 0; j < 4; ++j) { nx[j] = xr0[64 * j]; ny[j] = y0[64 * j]; } }
    for (int r = gw; r < rfirst + rpw; ++r) { const int row = row_lo + r, b = row >> 11; (void)b;
        const GAS f32x4* xr = (const GAS f32x4*)(xsrc + (size_t)row * D) + lane;
        f32x4 v[4];
        if (YMODE == 0) {
#pragma unroll
            for (int j = 0; j < 4; ++j) { const unsigned long long yy = ny[j]; const unsigned lo = (unsigned)yy, hi = (unsigned)(yy >> 32);
                const f32x4 yv = {bflo(lo), bfhi(lo), bflo(hi), bfhi(hi)}; v[j] = nx[j] * ALPHA + Lg[lane + 64 * j] * yv; }
            if (r + 1 < rfirst + rpw) { const GAS f32x4* xr1 = (const GAS f32x4*)(xsrc + (size_t)(row + 1) * D) + lane; const GAS unsigned long long* y1 = (const GAS unsigned long long*)(Y + ((size_t)(row + 1) - yrow_off) * D) + lane;
#pragma unroll
                for (int j = 0; j < 4; ++j) { nx[j] = xr1[64 * j]; ny[j] = y1[64 * j]; } }
        } else {
            const unsigned* rt = route + (size_t)row * 8;
            const unsigned e1 = rt[0], e2 = rt[1], s1 = rt[2], s2 = rt[3]; const float w1 = __uint_as_float(rt[4]), w2 = __uint_as_float(rt[5]);
            int off1 = 0, off2 = 0;
#pragma unroll
            for (int e = 0; e < NE; ++e) { const int cnt = (int)ctl[cbase + e]; const int pad = (cnt + 255) & ~255; off1 += (e < (int)e1) ? pad : 0; off2 += (e < (int)e2) ? pad : 0; }
            const GAS unsigned long long* ya = (const GAS unsigned long long*)(Y + (size_t)(off1 + (int)s1) * D) + lane;
            const GAS unsigned long long* yb = (const GAS unsigned long long*)(Y + (size_t)(off2 + (int)s2) * D) + lane;
            unsigned long long yq1[4], yq2[4]; f32x4 xq[4];
#pragma unroll
            for (int j = 0; j < 4; ++j) { yq1[j] = ya[64 * j]; yq2[j] = yb[64 * j]; }
#pragma unroll
            for (int j = 0; j < 4; ++j) xq[j] = xr[64 * j];
            __builtin_amdgcn_sched_barrier(0);
#pragma unroll
            for (int j = 0; j < 4; ++j) { const unsigned long long y1 = yq1[j], y2 = yq2[j];
                const unsigned l1 = (unsigned)y1, h1 = (unsigned)(y1 >> 32), l2 = (unsigned)y2, h2 = (unsigned)(y2 >> 32);
                const f32x4 s1v = {bflo(l1), bfhi(l1), bflo(h1), bfhi(h1)}, s2v = {bflo(l2), bfhi(l2), bflo(h2), bfhi(h2)};
                v[j] = xq[j] * ALPHA + Lg[lane + 64 * j] * (s1v * w1 + s2v * w2); }
        }
        float mean, rstd; ln_stats(v, mean, rstd, lane);
#pragma unroll
        for (int j = 0; j < 4; ++j) v[j] = (v[j] - mean) * rstd * Llg[lane + 64 * j] + Llb[lane + 64 * j];
        GAS f32x4* xo = (GAS f32x4*)(xdst + (size_t)row * D) + lane;
#pragma unroll
        for (int j = 0; j < 4; ++j) xo[64 * j] = v[j];
        if (WRITE_H2) {
            ln_stats(v, mean, rstd, lane);
#pragma unroll
            for (int j = 0; j < 4; ++j) v[j] = (v[j] - mean) * rstd * Lsc[lane + 64 * j] + Lsh[lane + 64 * j];
            store_bf16_row(H2 + (size_t)row * D, v, lane);
            if (ROUTE) {
                float lg[8];
#pragma unroll
                for (int e = 0; e < 8; ++e) lg[e] = 0.f;
#pragma unroll
                for (int j = 0; j < 4; ++j)
#pragma unroll
                    for (int q = 0; q < 4; ++q) { const int k = 4 * lane + 256 * j + q; const f32x4 wa = Lwr[2 * k], wb = Lwr[2 * k + 1]; const float hv = v[j][q];
                        lg[0] = fmaf(hv, wa.x, lg[0]); lg[1] = fmaf(hv, wa.y, lg[1]); lg[2] = fmaf(hv, wa.z, lg[2]); lg[3] = fmaf(hv, wa.w, lg[3]);
                        lg[4] = fmaf(hv, wb.x, lg[4]); lg[5] = fmaf(hv, wb.y, lg[5]); lg[6] = fmaf(hv, wb.z, lg[6]); lg[7] = fmaf(hv, wb.w, lg[7]); if (q == 3) asm volatile("" ::: "memory"); }
#pragma unroll
                for (int e = 0; e < 8; ++e) lg[e] = wave_sum(lg[e], lane);
                int e1 = 0; float v1 = lg[0];
#pragma unroll
                for (int e = 1; e < 8; ++e) if (lg[e] > v1) { v1 = lg[e]; e1 = e; }
                int e2 = -1; float v2 = -3.0e38f;
#pragma unroll
                for (int e = 0; e < 8; ++e) if (e != e1 && lg[e] > v2) { v2 = lg[e]; e2 = e; }
                if (e2 < 0) e2 = (e1 == 0) ? 1 : 0;
                const float p2 = __expf(v2 - v1), w1 = 1.f / (1.f + p2), w2 = p2 / (1.f + p2);
                if (lane == 0) {
                    const unsigned s1 = atomicAdd(&ctl[cbase + e1], 1u), s2 = atomicAdd(&ctl[cbase + e2], 1u);
                    unsigned* rt = route + (size_t)row * 8; rt[0] = (unsigned)e1; rt[1] = (unsigned)e2; rt[2] = s1; rt[3] = s2; rt[4] = __float_as_uint(w1); rt[5] = __float_as_uint(w2); }
            }
        }
    }
    __syncthreads();
}
__device__ __forceinline__ void moe_sort_phase(CArgs* a, const bf16* H2, bf16* AS, int gw, int NGW, int lane, int cbase) {
    unsigned* ctl = (unsigned*)(a->ws + WS_CTL); const unsigned* route = (const unsigned*)(a->ws + WS_ROUTE);
    for (int row = gw; row < T; row += NGW) {
        const unsigned* rt = route + (size_t)row * 8; const unsigned e1 = rt[0], e2 = rt[1], s1 = rt[2], s2 = rt[3];
        int off1 = 0, off2 = 0;
#pragma unroll
        for (int e = 0; e < NE; ++e) { const int cnt = (int)ctl[cbase + e]; const int pad = (cnt + 255) & ~255; off1 += (e < (int)e1) ? pad : 0; off2 += (e < (int)e2) ? pad : 0; }
        const GAS v4u* src = (const GAS v4u*)(H2 + (size_t)row * D) + lane;
        const v4u x0 = src[0], x1 = src[64];
        GAS v4u* d1 = (GAS v4u*)(AS + (size_t)(off1 + (int)s1) * D) + lane; GAS v4u* d2 = (GAS v4u*)(AS + (size_t)(off2 + (int)s2) * D) + lane;
        d1[0] = x0; d1[64] = x1; d2[0] = x0; d2[64] = x1; }
}

typedef short bf16x8 __attribute__((ext_vector_type(8)));
typedef float f32x16 __attribute__((ext_vector_type(16)));
typedef __bf16 bf16x2_t __attribute__((ext_vector_type(2)));
typedef float f32x2_t __attribute__((ext_vector_type(2)));
#define MFMA32(a, b, c) __builtin_amdgcn_mfma_f32_32x32x16_bf16((a), (b), (c), 0, 0, 0)
#define KOFF(r) (((r) & 7) + 16 * ((r) >> 3))
#define PI32(i) (((i) & ~12) | (((i) & 4) << 1) | (((i) & 8) >> 1))
__device__ __forceinline__ unsigned cvtpk(float lo, float hi) { f32x2_t v = {lo, hi}; bf16x2_t b = __builtin_convertvector(v, bf16x2_t); return __builtin_bit_cast(unsigned, b); }
__device__ __forceinline__ float xhalf(float v, int xaddr) { return __int_as_float(__builtin_amdgcn_ds_bpermute(xaddr, __float_as_int(v))); }

constexpr int KV_ROWB = 144, KV_VOFF = 64 * KV_ROWB, KV_BUF = 2 * 64 * KV_ROWB;
struct Stage { v4u k, v; };
__device__ __forceinline__ void stage_load(Stage& st, int tid, const bf16* Kb, size_t kstride, const bf16* Vt, int vstride, int k0) {
    const int row = tid >> 3, c = tid & 7;
    st.k = *(const GAS v4u*)(Kb + (size_t)(k0 + row) * kstride + c * 8);
    st.v = *(const GAS v4u*)(Vt + (size_t)row * vstride + k0 + c * 8);
}
__device__ __forceinline__ void stage_store(const Stage& st, int tid, LAS unsigned char* buf) {
    const int row = tid >> 3, c = tid & 7;
    *(LAS v4u*)(buf + row * KV_ROWB + c * 16) = st.k; *(LAS v4u*)(buf + KV_VOFF + row * KV_ROWB + c * 16) = st.v;
}
struct KVFrag { bf16x8 k[4]; bf16x8 v[4]; };
__device__ __forceinline__ void frag_read(KVFrag& f, const LAS unsigned char* buf, int sub, int ql, int h2) {
    const LAS unsigned char* kp = buf + (32 * sub + PI32(ql)) * KV_ROWB + 16 * h2;
#pragma unroll
    for (int s = 0; s < 4; ++s) f.k[s] = *(const LAS bf16x8*)(kp + 32 * s);
    const LAS unsigned char* vp = buf + KV_VOFF + ql * KV_ROWB + 64 * sub + 16 * h2;
#pragma unroll
    for (int dt = 0; dt < 2; ++dt)
#pragma unroll
        for (int s2 = 0; s2 < 2; ++s2) f.v[dt * 2 + s2] = *(const LAS bf16x8*)(vp + dt * 32 * KV_ROWB + 32 * s2);
}
__device__ __forceinline__ void load_qfrag(bf16x8 (&q)[4], const bf16* qrow, int h2) {
#pragma unroll
    for (int s = 0; s < 4; ++s) q[s] = *(const GAS bf16x8*)(qrow + 16 * s + 8 * h2);
}
__device__ __forceinline__ f32x16 zero16() { f32x16 z;
#pragma unroll
    for (int i = 0; i < 16; ++i) z[i] = 0.f;
    return z; }
__device__ __forceinline__ f32x16 qk_tile(const bf16x8 (&q)[4], const bf16x8 (&k)[4]) {
    f32x16 S = zero16();
#pragma unroll
    for (int s = 0; s < 4; ++s) S = MFMA32(k[s], q[s], S);
    return S;
}
__device__ __forceinline__ void pv_tile(f32x16& O0, f32x16& O1, const float (&p)[16], const bf16x8 (&v)[4]) {
    v4u w0, w1;
    w0.x = cvtpk(p[0], p[1]); w0.y = cvtpk(p[2], p[3]); w0.z = cvtpk(p[4], p[5]); w0.w = cvtpk(p[6], p[7]);
    w1.x = cvtpk(p[8], p[9]); w1.y = cvtpk(p[10], p[11]); w1.z = cvtpk(p[12], p[13]); w1.w = cvtpk(p[14], p[15]);
    const bf16x8 p0 = __builtin_bit_cast(bf16x8, w0), p1 = __builtin_bit_cast(bf16x8, w1);
    O0 = MFMA32(v[0], p0, O0); O0 = MFMA32(v[1], p1, O0);
    O1 = MFMA32(v[2], p0, O1); O1 = MFMA32(v[3], p1, O1);
}
struct AttnAcc { float m, l; f32x16 O0, O1; };
__device__ __forceinline__ void acc_init(AttnAcc& A) { A.m = -1e30f; A.l = 0.f; A.O0 = zero16(); A.O1 = zero16(); }
__device__ __forceinline__ void sm_update(AttnAcc& A, const float (&t)[16], const bf16x8 (&v)[4], int xaddr) {
    float mx = t[0];
#pragma unroll
    for (int r = 1; r < 16; ++r) mx = fmaxf(mx, t[r]);
    mx = fmaxf(mx, xhalf(mx, xaddr));
    const float mnew = fmaxf(A.m, mx);
    if (__any(mnew > A.m)) { const float corr = __expf(A.m - mnew); A.l *= corr; A.O0 = A.O0 * corr; A.O1 = A.O1 * corr; A.m = mnew; }
    float p[16]; float ls = 0.f;
#pragma unroll
    for (int r = 0; r < 16; ++r) { p[r] = (t[r] > -1e29f) ? __expf(t[r] - A.m) : 0.f; ls += p[r]; }
    A.l += ls;
    pv_tile(A.O0, A.O1, p, v);
}
__device__ __forceinline__ void store_ot(bf16* orow, const f32x16& O0, const f32x16& O1, float scale, int h2) {
#pragma unroll
    for (int g = 0; g < 4; ++g) {
        unsigned long long a = (unsigned long long)cvtpk(O0[4 * g] * scale, O0[4 * g + 1] * scale) | ((unsigned long long)cvtpk(O0[4 * g + 2] * scale, O0[4 * g + 3] * scale) << 32);
        unsigned long long b = (unsigned long long)cvtpk(O1[4 * g] * scale, O1[4 * g + 1] * scale) | ((unsigned long long)cvtpk(O1[4 * g + 2] * scale, O1[4 * g + 3] * scale) << 32);
        *(GAS unsigned long long*)(orow + 8 * g + 4 * h2) = a; *(GAS unsigned long long*)(orow + 32 + 8 * g + 4 * h2) = b; }
}
__device__ __forceinline__ void band_subtile(AttnAcc& A, const bf16x8 (&q)[4], const KVFrag& f, int qpos, int k0, int nback, const LAS float* tab, int h2, int xaddr) {
    const f32x16 S = qk_tile(q, f.k);
    const int base = qpos - k0 - 8 * h2;
    float t[16];
#pragma unroll
    for (int r = 0; r < 16; ++r) { const int dd = base - KOFF(r); const float bv = tab[dd]; t[r] = (dd >= 0 && dd <= nback) ? S[r] * 0.125f + bv : -1e30f; }
    sm_update(A, t, f.v, xaddr);
}
__device__ __forceinline__ void band_block(AttnAcc& A, const bf16x8 (&q)[4], LAS unsigned char* kvbuf, int tid, const bf16* Kb, size_t kstride, const bf16* Vt, int vstride,
                                           int q0w, int nback, int kmin, int kmax, const LAS float* tab, int ql, int h2, int xaddr) {
    Stage st; stage_load(st, tid, Kb, kstride, Vt, vstride, kmin); stage_store(st, tid, kvbuf); __syncthreads();
    const int klo = (q0w - nback) & ~31;
    int par = 0;
    for (int k0 = kmin; k0 <= kmax; k0 += 64, par ^= 1) {
        const bool more = k0 + 64 <= kmax;
        if (more) stage_load(st, tid, Kb, kstride, Vt, vstride, k0 + 64);
        const LAS unsigned char* buf = kvbuf + par * KV_BUF;
#pragma unroll
        for (int sub = 0; sub < 2; ++sub) { const int ks = k0 + 32 * sub;
            if (ks >= klo && ks <= q0w) { KVFrag f; frag_read(f, buf, sub, ql, h2); band_subtile(A, q, f, q0w + ql, ks, nback, tab, h2, xaddr); } }
        if (more) stage_store(st, tid, kvbuf + (par ^ 1) * KV_BUF);
        __syncthreads();
    }
}

constexpr int L_BLKA = 2 * KV_BUF + 2048, L_BLKB = L_BLKA + 32768, L_SCK = L_BLKA, L_MASK = L_BLKB + 32768, L_BT = L_MASK + 512, BT_STRIDE = 2176;
static_assert(L_BT + 4 * BT_STRIDE * 4 <= MISC_OFF, "NSA LDS map");
__device__ __forceinline__ void nsa_tables(CArgs* a, LAS unsigned char* lds, int wave) {
    const float* biasT = (const float*)(a->ws + WS_BIAS); LAS float* BT = (LAS float*)(lds + L_BT);
    const int lane = lane_id_l(), tid = wave * 64 + lane;
    for (int i = tid; i < 4 * BT_STRIDE; i += 512) { const int hh = i / BT_STRIDE, e = i - hh * BT_STRIDE; int dist = e - 64; dist = dist < 0 ? 0 : (dist > 2047 ? 2047 : dist); BT[i] = biasT[hh * 2048 + dist]; }
}
__device__ __forceinline__ void nsa_unit(CArgs* a, LAS unsigned char* lds, const int wave, const int b, const int tile, const int lane, const int tid, const int ql, const int h2, const int xaddr) {
    unsigned char* ws = a->ws; const bf16* QKV = (const bf16*)(ws + A_QKV); bf16* O4 = (bf16*)(ws + A_O4);
    const float* NG = (const float*)(ws + WS_NG); const bf16* KCB = (const bf16*)(ws + WS_KC); const bf16* VCT = KCB + (size_t)BH * 128 * 64;
    const int h = wave & 3, qh = wave >> 2;
    LAS float* BLKA = (LAS float*)(lds + L_BLKA); LAS float* BLKB = (LAS float*)(lds + L_BLKB);
    LAS unsigned* SCK = (LAS unsigned*)(lds + L_SCK); LAS unsigned* MASK = (LAS unsigned*)(lds + L_MASK);
    LAS float* BT = (LAS float*)(lds + L_BT);
        const int t0 = tile * 64, qpos0 = t0 + 32 * qh, qpos = qpos0 + ql; const size_t rowb = (size_t)b * SEQ, row = rowb + qpos;
        const int qi = 32 * qh + ql;
        bf16x8 q[4]; load_qfrag(q, QKV + (HT_NSAQ + h) * HT_ELEMS + row * 64, h2);
        const float g0 = sigm(NG[row * 16 + h * 3 + 0]), g1 = sigm(NG[row * 16 + h * 3 + 1]), g2 = sigm(NG[row * 16 + h * 3 + 2]);
        f32x16 T0, T1;
        {
            const bf16* Kb = KCB + (size_t)b * 128 * 64; const bf16* Vt = VCT + (size_t)b * 64 * 128;
            Stage s0, s1; stage_load(s0, tid, Kb, 64, Vt, 128, 0); stage_load(s1, tid, Kb, 64, Vt, 128, 64);
            stage_store(s0, tid, lds); stage_store(s1, tid, lds + KV_BUF);
            __syncthreads();
            const int imax = (qpos >= 31) ? ((qpos - 31) >> 4) : -1;
            const int ntile = (min(qpos0 >> 4, 126) >> 5) + 1;
            float m = -1e30f, l = 0.f;
            for (int kt = 0; kt < ntile; ++kt) { KVFrag f; frag_read(f, lds + (kt >> 1) * KV_BUF, kt & 1, ql, h2);
                const f32x16 S = qk_tile(q, f.k); float mx = -1e30f; float t[16];
#pragma unroll
                for (int r = 0; r < 16; ++r) { const int i = kt * 32 + KOFF(r) + 8 * h2; t[r] = (i <= imax) ? S[r] * 0.125f : -1e30f; mx = fmaxf(mx, t[r]); }
                mx = fmaxf(mx, xhalf(mx, xaddr)); const float mn = fmaxf(m, mx); l *= __expf(m - mn); m = mn;
#pragma unroll
                for (int r = 0; r < 16; ++r) l += (t[r] > -1e29f) ? __expf(t[r] - m) : 0.f; }
            l += xhalf(l, xaddr);
            const float inv = 1.f / fmaxf(l, 1e-30f);
            f32x16 C0 = zero16(), C1 = zero16();
            for (int kt = 0; kt < 4; ++kt) {
                float p[16];
                if (kt < ntile) { KVFrag f; frag_read(f, lds + (kt >> 1) * KV_BUF, kt & 1, ql, h2);
                    const f32x16 S = qk_tile(q, f.k);
#pragma unroll
                    for (int r = 0; r < 16; ++r) { const int i = kt * 32 + KOFF(r) + 8 * h2; p[r] = (i <= imax) ? __expf(S[r] * 0.125f - m) * inv : 0.f; }
                    pv_tile(C0, C1, p, f.v);
                } else {
#pragma unroll
                    for (int r = 0; r < 16; ++r) p[r] = 0.f;
                }
#pragma unroll
                for (int gq = 0; gq < 4; ++gq) { const int j = (32 * kt + KOFF(4 * gq) + 8 * h2) >> 2;
                    BLKA[(h * 32 + j) * 64 + qi] = (p[4 * gq] + p[4 * gq + 1]) + (p[4 * gq + 2] + p[4 * gq + 3]);
                    if (j + 1 < 32) BLKB[(h * 32 + j + 1) * 64 + qi] = p[4 * gq + 3]; }
            }
            if (h2 == 0) BLKB[(h * 32 + 0) * 64 + qi] = 0.f;
            T0 = C0 * g0; T1 = C1 * g0;
        }
        __syncthreads();
        float ssc[4];
        {
            const int sq = tid >> 3, jg = tid & 7;
#pragma unroll
            for (int jj = 0; jj < 4; ++jj) { const int j = jg * 4 + jj; float s = 0.f;
#pragma unroll
                for (int hh = 0; hh < 4; ++hh) s += BLKA[(hh * 32 + j) * 64 + sq] + BLKB[(hh * 32 + j) * 64 + sq];
                if (j == 0 || j == tile || j == tile - 1) s = 1e4f; else if (j > tile) s = -1e30f;
                ssc[jj] = s; }
        }
        __syncthreads();
        {
            const int sq = tid >> 3, jg = tid & 7;
#pragma unroll
            for (int jj = 0; jj < 4; ++jj) { const int j = jg * 4 + jj; const unsigned ub = __float_as_uint(ssc[jj]); const unsigned ord = (ub & 0x80000000u) ? ~ub : (ub | 0x80000000u);
                SCK[sq * 33 + j] = (ord & ~31u) | (unsigned)(31 - j); }
            if (tid == 0) MASK[64] = 0u;
        }
        __syncthreads();
        {
            const int sq = tid >> 3, jg = tid & 7; unsigned bits = 0u;
            const unsigned k0 = SCK[sq * 33 + jg * 4 + 0], k1 = SCK[sq * 33 + jg * 4 + 1], k2 = SCK[sq * 33 + jg * 4 + 2], k3 = SCK[sq * 33 + jg * 4 + 3];
            int r0 = 0, r1 = 0, r2 = 0, r3 = 0;
#pragma unroll 1
            for (int j2 = 0; j2 < 32; ++j2) { const unsigned kk = SCK[sq * 33 + j2]; r0 += (kk > k0) ? 1 : 0; r1 += (kk > k1) ? 1 : 0; r2 += (kk > k2) ? 1 : 0; r3 += (kk > k3) ? 1 : 0; }
            bits = ((r0 < 16) ? 1u : 0u) | ((r1 < 16) ? 2u : 0u) | ((r2 < 16) ? 4u : 0u) | ((r3 < 16) ? 8u : 0u);
            bits <<= (jg * 4);
            bits |= shfl_xor_u(bits, 1, lane); bits |= shfl_xor_u(bits, 2, lane); bits |= shfl_xor_u(bits, 4, lane);
            if (jg == 0) { MASK[sq] = bits; atomicOr((unsigned*)&MASK[64], bits); }
        }
        __syncthreads();
        {
            const unsigned msk = MASK[qi]; unsigned un = MASK[64] & ((tile >= 31) ? 0xffffffffu : ((2u << tile) - 1u));
            const bf16* Kb = QKV + (size_t)HT_KSEL * HT_ELEMS + rowb * 64; const bf16* Vt = QKV + (size_t)HT_VSEL * HT_ELEMS + (size_t)b * 64 * SEQ;
            const LAS float* tab = BT + h * BT_STRIDE + 64;
            AttnAcc A; acc_init(A);
            int j = __builtin_ctz(un); un &= un - 1;
            Stage st; stage_load(st, tid, Kb, 64, Vt, SEQ, 64 * j); stage_store(st, tid, lds); __syncthreads();
            int par = 0;
            for (;;) {
                const bool more = un != 0u; const int jn = more ? __builtin_ctz(un) : 0; un &= un - 1;
                if (more) stage_load(st, tid, Kb, 64, Vt, SEQ, 64 * jn);
                const LAS unsigned char* buf = lds + par * KV_BUF;
                const bool selj = (msk >> j) & 1u;
                if (__any(selj)) {
#pragma unroll
                    for (int sub = 0; sub < 2; ++sub) { const int ks = 64 * j + 32 * sub;
                        if (ks <= qpos0) { KVFrag f; frag_read(f, buf, sub, ql, h2);
                            const f32x16 S = qk_tile(q, f.k);
                            const int base = qpos - ks - 8 * h2;
                            float t[16];
#pragma unroll
                            for (int r = 0; r < 16; ++r) { const int dd = base - KOFF(r); const float bv = tab[dd]; t[r] = (selj && dd >= 0) ? S[r] * 0.125f + bv : -1e30f; }
                            sm_update(A, t, f.v, xaddr); } }
                }
                if (more) stage_store(st, tid, lds + (par ^ 1) * KV_BUF);
                __syncthreads();
                if (!more) break;
                j = jn; par ^= 1;
            }
            const float lt = A.l + xhalf(A.l, xaddr); const float sc = g1 / lt;
            T0 = T0 + A.O0 * sc; T1 = T1 + A.O1 * sc;
        }
        {
            AttnAcc A; acc_init(A);
            int kmin = (t0 - 511) & ~63; if (kmin < 0) kmin = 0;
            band_block(A, q, lds, tid, QKV + (size_t)HT_KWIN * HT_ELEMS + rowb * 64, 64, QKV + (size_t)HT_VWIN * HT_ELEMS + (size_t)b * 64 * SEQ, SEQ, qpos0, 511, kmin, t0, BT + h * BT_STRIDE + 64, ql, h2, xaddr);
            const float lt = A.l + xhalf(A.l, xaddr); const float sc = g2 / lt;
            T0 = T0 + A.O0 * sc; T1 = T1 + A.O1 * sc;
        }
        store_ot(O4 + row * 1024 + 0 * 256 + h * 64, T0, T1, 1.f, h2);
        __syncthreads();
}

constexpr size_t DILO_OFF = 0, DILL_OFF = (size_t)3 * TH * 256 * 2;
constexpr int U_SB = BH * 4 * 8, U_NSA = BH * 32, U_DIL = 3 * BH * 4 * 8, U_SWA = BH * 4 * 8, U_CMP = BH, U_ALL = U_CMP + U_SB + U_NSA + U_DIL + U_SWA;
constexpr int LQ_OFF = 2 * KV_BUF, LTAB_OFF = LQ_OFF + 64;
__device__ __forceinline__ void attn_queue_phase(CArgs* a, int layer, int inst, LAS unsigned char* lds, int wave) {
    unsigned char* ws = a->ws; const bf16* QKV = (const bf16*)(ws + A_QKV); bf16* O4 = (bf16*)(ws + A_O4); const float* biasT = (const float*)(ws + WS_BIAS);
    bf16* DILO = (bf16*)(ws + A_DIL + DILO_OFF); float* DILL = (float*)(ws + A_DIL + DILL_OFF);
    unsigned* qctr = (unsigned*)(ws + WS_CTL) + CW_QUEUE + inst * 64;
    LAS unsigned* LQ = (LAS unsigned*)(lds + LQ_OFF); LAS float* tabw = (LAS float*)(lds + LTAB_OFF);
    unsigned* cflag = (unsigned*)(ws + WS_CTL) + CW_CMPF + inst * 64;
    nsa_tables(a, lds, wave);
    if (wave == 0 && lane_id_l() == 0) LQ[0] = atomicAdd(qctr, 1u);
    __syncthreads();
    for (;;) {
        const int lane = lane_id_l(), tid = wave * 64 + lane, ql = lane & 31, h2 = lane >> 5, xaddr = (lane ^ 32) << 2;
        const int u = (int)LQ[0];
        __syncthreads();
        if (u >= U_ALL) break;
        unsigned nxt_u = 0u; if (tid == 0) nxt_u = atomicAdd(qctr, 1u);
        const int uu = u - U_CMP;
        if (uu >= 0 && uu < U_SB) {
            const int bh = uu % (4 * BH), h = bh & 3, b = bh >> 2, Qb = 7 - uu / (4 * BH);
            const int q0w = Qb * 256 + 32 * wave; const size_t rowb = (size_t)b * SEQ;
            bf16x8 q[4]; load_qfrag(q, QKV + (HT_SBQ + h) * HT_ELEMS + (rowb + q0w + ql) * 64, h2);
            const bf16* Kb = QKV + (HT_SBK + h) * HT_ELEMS + rowb * 64;
            const bf16* Vt = QKV + (HT_SBV + h) * HT_ELEMS + (size_t)b * 64 * SEQ;
            f32x16 O0 = zero16(), O1 = zero16(); float R = 0.f;
            const int ktop = Qb * 256 + 192;
            Stage st; stage_load(st, tid, Kb, 64, Vt, SEQ, ktop); stage_store(st, tid, lds); __syncthreads();
            int par = 0;
            for (int k0 = ktop; k0 >= 0; k0 -= 64, par ^= 1) {
                const bool more = k0 >= 64;
                if (more) stage_load(st, tid, Kb, 64, Vt, SEQ, k0 - 64);
                const LAS unsigned char* buf = lds + par * KV_BUF;
#pragma unroll
                for (int sub = 1; sub >= 0; --sub) { const int ks = k0 + 32 * sub;
                    if (ks <= q0w) { KVFrag f; frag_read(f, buf, sub, ql, h2);
                        const f32x16 S = qk_tile(q, f.k);
                        float ls[16], lf[16];
                        if (ks == q0w) {
                            const int base = ql - 8 * h2;
#pragma unroll
                            for (int r = 0; r < 16; ++r) { const float z2 = S[r] * (0.125f * 1.4426950408889634f); const bool valid = (base - KOFF(r)) >= 1;
                                const float L2 = __builtin_amdgcn_logf(1.f + __builtin_amdgcn_exp2f(-fabsf(z2)));
                                ls[r] = valid ? fminf(z2, 0.f) - L2 : -1e30f; lf[r] = valid ? -fmaxf(z2, 0.f) - L2 : 0.f; }
                        } else {
#pragma unroll
                            for (int r = 0; r < 16; ++r) { const float z2 = S[r] * (0.125f * 1.4426950408889634f);
                                const float L2 = __builtin_amdgcn_logf(1.f + __builtin_amdgcn_exp2f(-fabsf(z2)));
                                ls[r] = fminf(z2, 0.f) - L2; lf[r] = -fmaxf(z2, 0.f) - L2; }
                        }
                        float G0 = 0.f, G1 = 0.f;
#pragma unroll
                        for (int r = 0; r < 8; ++r) { G0 += lf[r]; G1 += lf[8 + r]; }
                        const float P0 = xhalf(G0, xaddr), P1 = xhalf(G1, xaddr);
                        const float aft0 = (h2 == 0) ? (P0 + G1 + P1) : (P1 + G1), aft1 = (h2 == 0) ? P1 : 0.f;
                        float p[16]; float w = aft0 + R;
#pragma unroll
                        for (int r = 7; r >= 0; --r) { p[r] = __builtin_amdgcn_exp2f(ls[r] + w); w += lf[r]; }
                        w = aft1 + R;
#pragma unroll
                        for (int r = 15; r >= 8; --r) { p[r] = __builtin_amdgcn_exp2f(ls[r] + w); w += lf[r]; }
                        R += (G0 + P0) + (G1 + P1);
                        pv_tile(O0, O1, p, f.v); } }
                if (more) stage_store(st, tid, lds + (par ^ 1) * KV_BUF);
                __syncthreads();
            }
            store_ot(O4 + (rowb + q0w + ql) * 1024 + 3 * 256 + h * 64, O0, O1, 1.f, h2);
        } else if (uu >= U_SB && uu < U_SB + U_NSA) {
            const int un = uu - U_SB, b = un % BH, tile = 31 - un / BH;
            if (tid == 0) { unsigned sp = 0;
                while (__hip_atomic_load(cflag + b, __ATOMIC_RELAXED, __HIP_MEMORY_SCOPE_AGENT) == 0u) { __builtin_amdgcn_s_sleep(2); if (++sp > (1u << 22)) break; }
                __builtin_amdgcn_fence(__ATOMIC_ACQUIRE, "agent"); asm volatile("s_waitcnt vmcnt(0)" ::: "memory"); }
            __syncthreads();
            nsa_unit(a, lds, wave, b, tile, lane, tid, ql, h2, xaddr);
        } else if (uu >= U_SB + U_NSA && uu < U_SB + U_NSA + U_DIL) {
            const int r0 = uu - U_SB - U_NSA; const int h = r0 & 3, b = (r0 >> 2) % BH, pb = (r0 / (4 * BH)) & 7, g = r0 / (32 * BH);
            const int dil = (g == 0) ? 1 : (g == 1) ? 4 : 16, L = SEQ / dil;
            const int p0 = pb * 256 + 32 * wave, res = p0 / L, i0 = p0 - res * L;
            const size_t rowb = (size_t)b * SEQ;
            const float* bsrc = biasT + (8 + g * 4 + h) * 2048;
            for (int e = tid; e < 320; e += 512) { const int dd = e - 32; int dist = dd * dil; dist = dist < 0 ? 0 : (dist > 2047 ? 2047 : dist); tabw[e] = bsrc[dist]; }
            const int tq = (i0 + ql) * dil + res;
            bf16x8 q[4]; load_qfrag(q, QKV + (HT_DILQ + g * 4 + h) * HT_ELEMS + (rowb + tq) * 64, h2);
            const int vslot = (g == 0) ? (HT_DILV + h) : (50 + h * 2 + (g - 1));
            AttnAcc A; acc_init(A);
            if (L >= 256) {
                const int res_b = (pb * 256) / L, ib = pb * 256 - res_b * L;
                const bf16* Kb = QKV + (HT_DILK + h) * HT_ELEMS + (rowb + res_b) * 64; const bf16* Vt = QKV + (size_t)vslot * HT_ELEMS + (size_t)b * 64 * SEQ + res_b * L;
                int kmin = (ib - 128) & ~63; if (kmin < 0) kmin = 0;
                band_block(A, q, lds, tid, Kb, (size_t)dil * 64, Vt, SEQ, i0, 128, kmin, ib + 192, tabw + 32, ql, h2, xaddr);
            } else {
#pragma unroll 1
                for (int half = 0; half < 2; ++half) { const int res_b = 2 * pb + half;
                    const bf16* Kb = QKV + (HT_DILK + h) * HT_ELEMS + (rowb + res_b) * 64; const bf16* Vt = QKV + (size_t)vslot * HT_ELEMS + (size_t)b * 64 * SEQ + res_b * L;
                    const bool mine = (wave >> 2) == half;
                    band_block(A, q, lds, tid, Kb, (size_t)dil * 64, Vt, SEQ, mine ? i0 : -4096, 128, 0, 64, tabw + 32, ql, h2, xaddr); }
            }
            const float lt = A.l + xhalf(A.l, xaddr);
            store_ot(DILO + ((size_t)g * TH + rowb + tq) * 256 + h * 64, A.O0, A.O1, 1.f / lt, h2);
            if (h2 == 0) DILL[((size_t)g * TH + rowb + tq) * 4 + h] = A.m + __logf(lt);
        } else if (uu >= U_SB + U_NSA + U_DIL) {
            const int r0 = uu - U_SB - U_NSA - U_DIL; const int h = r0 & 3, b = (r0 >> 2) % BH, Qb = r0 / (4 * BH);
            const int q0w = Qb * 256 + 32 * wave; const size_t rowb = (size_t)b * SEQ;
            const float* bsrc = biasT + (4 + h) * 2048;
            for (int e = tid; e < 320; e += 512) { int dist = e - 32; dist = dist < 0 ? 0 : dist; tabw[e] = bsrc[dist]; }
            bf16x8 q[4]; load_qfrag(q, QKV + (HT_SWAQ + h) * HT_ELEMS + (rowb + q0w + ql) * 64, h2);
            AttnAcc A; acc_init(A);
            int kmin = (Qb * 256 - 127) & ~63; if (kmin < 0) kmin = 0;
            band_block(A, q, lds, tid, QKV + (HT_SWAK + (h >> 1)) * HT_ELEMS + rowb * 64, 64, QKV + (HT_SWAV + (h >> 1)) * HT_ELEMS + (size_t)b * 64 * SEQ, SEQ, q0w, 127, kmin, Qb * 256 + 192, tabw + 32, ql, h2, xaddr);
            const float lt = A.l + xhalf(A.l, xaddr);
            const float sk = a->in[IN_SINK][layer * 4 + h]; const float mf = fmaxf(A.m, sk); const float c0 = __expf(A.m - mf); const float den = lt * c0 + __expf(sk - mf);
            store_ot(O4 + (rowb + q0w + ql) * 1024 + 1 * 256 + h * 64, A.O0, A.O1, c0 / den, h2);
        } else {
            const int it = u * 8 + wave; const int rt = it & 3, which = (it >> 2) & 1, b = it >> 3;
            bf16* kcb = (bf16*)(ws + WS_KC); bf16* vct = kcb + (size_t)BH * 128 * 64;
            const int i = rt * 32 + ql, ic = i > 126 ? 126 : i;
            const bf16* src = QKV + (HT_KCMP + which) * HT_ELEMS + ((size_t)b * SEQ + 16 * ic) * 64;
            const float* pe = a->in[IN_CPE] + ((size_t)layer * 2 + which) * 32 * 64;
            const bf16* w1t = (const bf16*)(ws + WS_C1) + ((size_t)layer * 2 + which) * 64 * 2048 + (size_t)ql * 2048;
            f32x16 H0 = zero16(), H1 = zero16();
#pragma unroll 1
            for (int ks0 = 0; ks0 < 128; ks0 += 4) {
                v4u xa[4]; f32x4 pa[4], pb2[4]; bf16x8 a0[4], a1[4];
#pragma unroll
                for (int e = 0; e < 4; ++e) { const int k = 16 * (ks0 + e) + 8 * h2;
                    xa[e] = *(const GAS v4u*)(src + k); pa[e] = *(const GAS f32x4*)(pe + k); pb2[e] = *(const GAS f32x4*)(pe + k + 4);
                    a0[e] = *(const GAS bf16x8*)(w1t + k); a1[e] = *(const GAS bf16x8*)(w1t + 32 * 2048 + k); }
                __builtin_amdgcn_sched_barrier(0);
#pragma unroll
                for (int e = 0; e < 4; ++e) {
                    v4u xb; xb.x = cvtpk(bflo(xa[e].x) + pa[e].x, bfhi(xa[e].x) + pa[e].y); xb.y = cvtpk(bflo(xa[e].y) + pa[e].z, bfhi(xa[e].y) + pa[e].w);
                    xb.z = cvtpk(bflo(xa[e].z) + pb2[e].x, bfhi(xa[e].z) + pb2[e].y); xb.w = cvtpk(bflo(xa[e].w) + pb2[e].z, bfhi(xa[e].w) + pb2[e].w);
                    const bf16x8 bfr = __builtin_bit_cast(bf16x8, xb);
                    H0 = MFMA32(a0[e], bfr, H0); H1 = MFMA32(a1[e], bfr, H1); }
            }
            float g[32];
#pragma unroll
            for (int r = 0; r < 16; ++r) { const float x0 = H0[r], x1 = H1[r];
                g[r] = 0.5f * x0 * (1.f + tanhf(0.7978845608028654f * (x0 + 0.044715f * x0 * x0 * x0))); g[16 + r] = 0.5f * x1 * (1.f + tanhf(0.7978845608028654f * (x1 + 0.044715f * x1 * x1 * x1))); }
            const float* w2 = a->in[IN_CW2] + ((size_t)layer * 2 + which) * 64 * 64;
            f32x16 E0 = zero16(), E1 = zero16();
#pragma unroll
            for (int s = 0; s < 4; ++s) { v4u gw_; gw_.x = cvtpk(g[8 * s], g[8 * s + 1]); gw_.y = cvtpk(g[8 * s + 2], g[8 * s + 3]); gw_.z = cvtpk(g[8 * s + 4], g[8 * s + 5]); gw_.w = cvtpk(g[8 * s + 6], g[8 * s + 7]);
                const bf16x8 gb = __builtin_bit_cast(bf16x8, gw_);
                float wa[8], wb[8];
#pragma unroll
                for (int j = 0; j < 8; ++j) { const int n = 16 * s + 8 * (j >> 2) + 4 * h2 + (j & 3); wa[j] = w2[(size_t)n * 64 + ql]; wb[j] = w2[(size_t)n * 64 + 32 + ql]; }
                v4u ua, ub; ua.x = cvtpk(wa[0], wa[1]); ua.y = cvtpk(wa[2], wa[3]); ua.z = cvtpk(wa[4], wa[5]); ua.w = cvtpk(wa[6], wa[7]);
                ub.x = cvtpk(wb[0], wb[1]); ub.y = cvtpk(wb[2], wb[3]); ub.z = cvtpk(wb[4], wb[5]); ub.w = cvtpk(wb[6], wb[7]);
                E0 = MFMA32(__builtin_bit_cast(bf16x8, ua), gb, E0); E1 = MFMA32(__builtin_bit_cast(bf16x8, ub), gb, E1); }
            const float zs = (i > 126) ? 0.f : 1.f;
            if (which == 0) store_ot(kcb + ((size_t)b * 128 + i) * 64, E0, E1, zs, h2);
            else {
#pragma unroll
                for (int r = 0; r < 16; ++r) { const int m = (r & 3) + 8 * (r >> 2) + 4 * h2;
                    vct[((size_t)b * 64 + m) * 128 + i] = (bf16)f2bf(E0[r] * zs); vct[((size_t)b * 64 + 32 + m) * 128 + i] = (bf16)f2bf(E1[r] * zs); } }
        }
        if (u < U_CMP) {
            asm volatile("s_waitcnt vmcnt(0)" ::: "memory"); __syncthreads();
            if (tid == 0) { __builtin_amdgcn_fence(__ATOMIC_RELEASE, "agent"); asm volatile("s_waitcnt vmcnt(0)" ::: "memory"); __hip_atomic_store(cflag + u, 1u, __ATOMIC_RELAXED, __HIP_MEMORY_SCOPE_AGENT); } }
        if (tid == 0) LQ[0] = nxt_u;
        __syncthreads();
    }
}


__device__ __forceinline__ void dil_merge_phase(CArgs* a, int G, int c, const int wave) {
    unsigned char* ws = a->ws; bf16* O4 = (bf16*)(ws + A_O4);
    {
        const bf16* DILO = (const bf16*)(ws + A_DIL + DILO_OFF); const float* DILL = (const float*)(ws + A_DIL + DILL_OFF);
        const int lane = lane_id_l(), gw = c * NWAVES + wave, NGW = G * NWAVES, hh = lane >> 4;
        for (int r = gw; r < TH; r += NGW) {
            const float l0 = DILL[((size_t)0 * TH + r) * 4 + hh], l1 = DILL[((size_t)1 * TH + r) * 4 + hh], l2 = DILL[((size_t)2 * TH + r) * 4 + hh];
            const float mx = fmaxf(l0, fmaxf(l1, l2)); const float e0 = __expf(l0 - mx), e1 = __expf(l1 - mx), e2 = __expf(l2 - mx); const float inv = 1.f / (e0 + e1 + e2);
            const unsigned long long y0 = *((const GAS unsigned long long*)(DILO + ((size_t)0 * TH + r) * 256) + lane), y1 = *((const GAS unsigned long long*)(DILO + ((size_t)1 * TH + r) * 256) + lane),
                                     y2 = *((const GAS unsigned long long*)(DILO + ((size_t)2 * TH + r) * 256) + lane);
            const float w0 = e0 * inv, w1 = e1 * inv, w2 = e2 * inv;
            const unsigned a0 = (unsigned)y0, b0 = (unsigned)(y0 >> 32), a1 = (unsigned)y1, b1 = (unsigned)(y1 >> 32), a2 = (unsigned)y2, b2 = (unsigned)(y2 >> 32);
            const unsigned o_lo = pk2(w0 * bflo(a0) + w1 * bflo(a1) + w2 * bflo(a2), w0 * bfhi(a0) + w1 * bfhi(a1) + w2 * bfhi(a2));
            const unsigned o_hi = pk2(w0 * bflo(b0) + w1 * bflo(b1) + w2 * bflo(b2), w0 * bfhi(b0) + w1 * bfhi(b1) + w2 * bfhi(b2));
            *((GAS unsigned long long*)(O4 + (size_t)r * 1024 + 2 * 256) + lane) = (unsigned long long)o_lo | ((unsigned long long)o_hi << 32);
        }
    }
}

#ifndef PROBE_REP
#define PROBE_REP 0
#endif
#define NREP(k) ((PROBE_REP == (k) || (PROBE_REP == 20 && (k) == 20)) ? 2 : 1)
#ifndef PROBE_SKIP
#define PROBE_SKIP 0
#endif
#define SKIP(k) (PROBE_REP == 20 && PROBE_SKIP == (k) && pass_ == 0)
constexpr int PH_PER_LAYER = 27, PH_END = 1 + 2 * PH_PER_LAYER;
__global__ void __launch_bounds__(NWAVES * 64, 2) fwd(Args args_unused) {
    extern __shared__ __attribute__((aligned(16))) unsigned char lds_raw[];
    LAS unsigned char* lds = (LAS unsigned char*)lds_raw;
    volatile LAS unsigned* MISC = (volatile LAS unsigned*)(lds + MISC_OFF);
    const int GK = gridDim.x, cK = blockIdx.x;
    const int wave_s = __builtin_amdgcn_readfirstlane(threadIdx.x >> 6);
    for (int u = threadIdx.x; u < (LDS_BYTES - MISC_OFF) / 4; u += NWAVES * 64) ((LAS unsigned*)(lds + MISC_OFF))[u] = 0u;
    __syncthreads();
    int lo, hi;
    XcdBarrier bar;
    { CArgs* a = get_args(); lo = a->ph_lo; hi = a->ph_hi; unsigned* ctl0 = (unsigned*)(a->ws + WS_CTL);
      bar.bar = ctl0 + CW_BAR; bar.x = 0; bar.st = MISC + 8;
      if (hi - lo > 1) bar = xcd_barrier_post(ctl0 + CW_BAR, MISC + 8); }
#define IN(k) ({ int l_ = lo, h_ = hi; asm volatile("" : "+s"(l_), "+s"(h_)); (l_ <= (k)) && ((k) < h_); })
#define SEAM(k) do { int h_ = hi; asm volatile("" : "+s"(h_)); if ((k) + 1 < h_) { xcd_barrier(bar, wave_s); if (PROBE_REP == 10) xcd_barrier(bar, wave_s); } } while (0)
#define PHASE_VARS CArgs* a = get_args(); unsigned char* ws = a->ws; int G = GK, c = cK; asm volatile("" : "+s"(G), "+s"(c)); \
    const int NGW = G * NWAVES, lane = lane_id_l(), wave = wave_s, tid = wave_s * 64 + lane, gw = c * NWAVES + wave; (void)lane; (void)gw; (void)ws; (void)tid; (void)NGW;
#define SKIPSEAM(k, id) if (SKIP(k) && IN(id)) { SEAM(id); }
#define WPTR(off) ((const bf16*)(ws + WS_W + (off)))

    if (IN(0)) { _Pragma("unroll") for (int rep_ = 0; rep_ < NREP(1); ++rep_) { PHASE_VARS p0_prologue<0>(a, lds, G, c, wave_s); } SEAM(0); }

    for (int pass_ = 0; pass_ < NREP(20); ++pass_)
    for (int layer = 0; layer < 2; ++layer) {
        const int pb = 1 + layer * PH_PER_LAYER;
        for (int hf = 0; hf < NHALF; ++hf) {
            const int p = pb + 7 * hf;
            if (layer == 0 && IN(p + 0) && !SKIP(11)) { _Pragma("unroll") for (int rep_ = 0; rep_ < NREP(11); ++rep_) { PHASE_VARS
                ln_mod_phase((layer == 0) ? a->in[IN_X] : a->out, (const float*)(ws + WS_MOD) + (size_t)layer * 16 * 6144, (bf16*)(ws + A_HY), hf, G, c, wave, lane, lds); } SEAM(p + 0); }
            if (layer == 0) { SKIPSEAM(11, p + 0) }
            if (IN(p + 1) && !SKIP(4)) { _Pragma("unroll") for (int rep_ = 0; rep_ < NREP(4); ++rep_) { PHASE_VARS
                pg8::Gemm g{(const bf16*)(ws + A_HY), WPTR(W_IN + layer * W_IN_L), TH, D, D}; pg8::InProjOrder S; S.init(TH, 14 * 256, G, c, D);
                pg8::EpiInProj E{(bf16*)(ws + A_QKV), (float*)(ws + WS_NG), HT_ELEMS};
                pg8::gemm_phase<pg8::EpiInProj, pg8::InProjOrder, true, true>(lds, g, S, E, wave_s); }
                SEAM(p + 1);
            }
            SKIPSEAM(4, p + 1)
            if (IN(p + 2) && !SKIP(2)) { _Pragma("unroll") for (int rep_ = 0; rep_ < NREP(2); ++rep_) { PHASE_VARS attn_queue_phase(a, layer, layer + 4 * rep_ + 8 * pass_, lds, wave_s); } SEAM(p + 2); }
            SKIPSEAM(2, p + 2)
            if (IN(p + 3) && !SKIP(3)) { _Pragma("unroll") for (int rep_ = 0; rep_ < NREP(3); ++rep_) { PHASE_VARS dil_merge_phase(a, G, c, wave_s); } SEAM(p + 3); }
            SKIPSEAM(3, p + 3)
            if (IN(p + 4) && !SKIP(5)) { _Pragma("unroll") for (int rep_ = 0; rep_ < NREP(5); ++rep_) { PHASE_VARS
                pg8::Gemm g{(const bf16*)(ws + A_HY), WPTR(W_IN + layer * W_IN_L + W_GATE), TH, D, D};
                const int vc = (G % 8 == 0) ? (c % 8) * (G / 8) + c / 8 : c;
                pg8::MergeOrder S{(TH / 256) * 4, G, vc, (int)((A_O4 - A_HY) / TILE_B), 17};
                pg8::EpiMerge E{(bf16*)(ws + A_MERGED), (bf16*)(ws + A_PS) + (size_t)c * 65536, (int)((A_O4 - A_HY) / TILE_B), 17};
                pg8::gemm_phase<pg8::EpiMerge, pg8::MergeOrder, true, true>(lds, g, S, E, wave_s); }
                SEAM(p + 4);
            }
            SKIPSEAM(5, p + 4)
            if (IN(p + 5) && !SKIP(6)) { _Pragma("unroll") for (int rep_ = 0; rep_ < NREP(6); ++rep_) { PHASE_VARS
                pg8::Gemm g{(const bf16*)(ws + A_MERGED), WPTR(W_OUT + layer * W_OUT_L), TH, D, D}; pg8::StaticOrder S; S.init(TH, D, G, c, D);
                pg8::EpiBf16 E{(bf16*)(ws + A_HY), D, 1 << 20, 1 << 30, 0};
                pg8::gemm_phase<pg8::EpiBf16, pg8::StaticOrder, true, true>(lds, g, S, E, wave_s); }
                SEAM(p + 5);
            }
            SKIPSEAM(6, p + 5)
            if (IN(p + 6) && !(SKIP(12) && layer == 0)) { PHASE_VARS
                const float* mod_l = (const float*)(ws + WS_MOD) + (size_t)layer * 16 * 6144;
                const float* lng = a->in[IN_LNG] + (size_t)(layer * 2 + 0) * D; const float* lnb = a->in[IN_LNB] + (size_t)(layer * 2 + 0) * D;
                if (layer == 0) post_norm_phase<0, true, false>(a, a->in[IN_X], a->out, (const bf16*)(ws + A_HY), (size_t)hf * TH, mod_l + 2048, lng, lnb, mod_l + 3072, (bf16*)(ws + A_H2), hf * TH, TH, G, c, wave, lane, CW_CNT + 32 * pass_, lds);
                else            post_norm_phase<0, true, true >(a, a->out, a->out, (const bf16*)(ws + A_HY), (size_t)hf * TH, mod_l + 2048, lng, lnb, mod_l + 3072, (bf16*)(ws + A_H2), hf * TH, TH, G, c, wave, lane, CW_CNT + 32 * pass_, lds);
                SEAM(p + 6);
            }
            if (SKIP(12) && layer == 0 && IN(p + 6)) { SEAM(p + 6); }
        }
        const int pf = pb + 14;
        if (layer == 0) {
            if (IN(pf + 0) && !SKIP(7)) { _Pragma("unroll") for (int rep_ = 0; rep_ < NREP(7); ++rep_) { PHASE_VARS
                pg8::Gemm g{(const bf16*)(ws + A_H2), WPTR(W_GU), T, D, D}; pg8::StaticOrder S; S.init(T, 2 * DFF, G, c, D);
                pg8::EpiSwiGLU E{(bf16*)(ws + A_ACT), DFF, 1 << 20};
                pg8::gemm_phase<pg8::EpiSwiGLU, pg8::StaticOrder, true, true>(lds, g, S, E, wave_s); }
                SEAM(pf + 0);
            }
            SKIPSEAM(7, pf + 0)
            if (IN(pf + 1) && !SKIP(7)) { _Pragma("unroll") for (int rep_ = 0; rep_ < NREP(7); ++rep_) { PHASE_VARS
                pg8::Gemm g{(const bf16*)(ws + A_ACT), WPTR(W_DN), T, DFF, DFF}; pg8::StaticOrder S; S.init(T, D, G, c, DFF);
                pg8::EpiBf16 E{(bf16*)(ws + A_Y2), D, 1 << 20, 1 << 30, 0};
                pg8::gemm_phase<pg8::EpiBf16, pg8::StaticOrder, true, true>(lds, g, S, E, wave_s); }
                SEAM(pf + 1);
            }
            SKIPSEAM(7, pf + 1)
            if (IN(pf + 2) && !SKIP(13)) { PHASE_VARS
                const float* mod_l = (const float*)(ws + WS_MOD) + (size_t)layer * 16 * 6144;
                const float* lng = a->in[IN_LNG] + (size_t)(layer * 2 + 1) * D; const float* lnb = a->in[IN_LNB] + (size_t)(layer * 2 + 1) * D;
                post_norm_phase<0, true, false>(a, a->out, a->out, (const bf16*)(ws + A_Y2), 0, mod_l + 5120, lng, lnb, mod_l + 16 * 6144  , (bf16*)(ws + A_HY), 0, T, G, c, wave, lane, CW_CNT + 32 * pass_, lds);
                SEAM(pf + 2);
            }
            SKIPSEAM(13, pf + 2)
        } else {
            if (IN(pf + 0) && !SKIP(13)) { PHASE_VARS p0_prologue<1>(a, lds, G, c, wave_s); moe_sort_phase(a, (const bf16*)(ws + A_H2), (bf16*)(ws + A_AS), gw, NGW, lane, CW_CNT + 32 * pass_); SEAM(pf + 0); }
            SKIPSEAM(13, pf + 0)
#define LOAD_NT int nt[8], NT = 0; { const unsigned* cnt = (const unsigned*)(ws + WS_CTL) + CW_CNT + 32 * pass_; _Pragma("unroll") for (int e = 0; e < 8; ++e) { nt[e] = ((int)__builtin_amdgcn_readfirstlane(cnt[e]) + 255) >> 8; NT += nt[e]; } } \
                const int nch = (NT + MOE_CT - 1) / MOE_CT, cs = (NT + nch - 1) / nch, tlo = ch * cs, thi = (tlo + cs < NT) ? tlo + cs : NT;
            for (int ch = 0; ch < MOE_MAXCH; ++ch) {
                const int pc = pf + 1 + 2 * ch;
                if (IN(pc + 0) && !SKIP(8)) { _Pragma("unroll") for (int rep_ = 0; rep_ < NREP(8); ++rep_) { PHASE_VARS LOAD_NT
                    if (tlo < NT) {
                    if (ch == 0) p0_prologue<2>(a, lds, G, c, wave_s);
                    pg8::Gemm g{(const bf16*)(ws + A_AS), (const bf16*)(ws + A_MGU), MOE_ROWS, D, D};
                    pg8::GroupedOrder S{nt[0], nt[1], nt[2], nt[3], nt[4], nt[5], nt[6], nt[7], 2 * DFFE / 256, G, (G % 8 == 0) ? (c % 8) * (G / 8) + c / 8 : c, 1, D, tlo, thi};
                    pg8::EpiSwiGLU E{(bf16*)(ws + A_ACTE) - (size_t)tlo * 256 * DFFE, DFFE, 2 * DFFE / 256};
                    pg8::gemm_phase<pg8::EpiSwiGLU, pg8::GroupedOrder, true, true>(lds, g, S, E, wave_s); } }
                    { PHASE_VARS LOAD_NT if (tlo < NT) { SEAM(pc + 0); } }
                }
                SKIPSEAM(8, pc + 0)
                if (IN(pc + 1) && !SKIP(9)) { _Pragma("unroll") for (int rep_ = 0; rep_ < NREP(9); ++rep_) { PHASE_VARS LOAD_NT
                    if (tlo < NT) {
                    pg8::Gemm g{(const bf16*)(ws + A_ACTE) - (size_t)tlo * 256 * DFFE, (const bf16*)(ws + A_MDN), MOE_ROWS, DFFE, DFFE};
                    pg8::GroupedOrder S{nt[0], nt[1], nt[2], nt[3], nt[4], nt[5], nt[6], nt[7], D / 256, G, (G % 8 == 0) ? (c % 8) * (G / 8) + c / 8 : c, 1, DFFE, tlo, thi};
                    pg8::EpiBf16 E{(bf16*)(ws + A_YP), D, D / 256, 1 << 30, 0};
                    pg8::gemm_phase<pg8::EpiBf16, pg8::GroupedOrder, true, true>(lds, g, S, E, wave_s); } }
                    { PHASE_VARS LOAD_NT if (tlo < NT) { SEAM(pc + 1); } }
                }
                SKIPSEAM(9, pc + 1)
            }
            if (IN(pf + 11) && !SKIP(13)) { PHASE_VARS
                const float* mod_l = (const float*)(ws + WS_MOD) + (size_t)layer * 16 * 6144;
                const float* lng = a->in[IN_LNG] + (size_t)(layer * 2 + 1) * D; const float* lnb = a->in[IN_LNB] + (size_t)(layer * 2 + 1) * D;
                post_norm_phase<1, false, false>(a, a->out, a->out, (const bf16*)(ws + A_YP), 0, mod_l + 5120, lng, lnb, mod_l, nullptr, 0, T, G, c, wave, lane, CW_CNT + 32 * pass_, lds);
            }
        }
    }
#undef IN
#undef SEAM
}

#ifndef MK_PER_PHASE
#define MK_PER_PHASE 0
#endif
extern "C" void kernel_launch(void* const* d_in, const int* in_sizes, int n_in, void* d_out, int out_size, void* d_ws, size_t ws_size, hipStream_t stream) {
    static int grid = 0;
    if (grid == 0) {
        if (n_in != 21 || out_size != T * D || ws_size < WS_END) { fprintf(stderr, "kernel_launch: unexpected shapes (n_in %d out %d ws %zu need %zu)\n", n_in, out_size, ws_size, (size_t)WS_END); grid = -1; return; }
        int dev = 0, cus = 0, per_cu = 0;
        if (hipGetDevice(&dev) != hipSuccess || hipDeviceGetAttribute(&cus, hipDeviceAttributeMultiprocessorCount, dev) != hipSuccess) { grid = -1; return; }
        if (hipFuncSetAttribute((const void*)fwd, hipFuncAttributeMaxDynamicSharedMemorySize, LDS_BYTES) != hipSuccess) { fprintf(stderr, "kernel_launch: hipFuncSetAttribute failed\n"); grid = -1; return; }
        if (hipOccupancyMaxActiveBlocksPerMultiprocessor(&per_cu, (const void*)fwd, NWAVES * 64, LDS_BYTES) != hipSuccess || per_cu < 1) fprintf(stderr, "kernel_launch: occupancy query reports %d\n", per_cu);
        (void)hipGetLastError();
        grid = cus;
    }
    if (grid < 0) return;
    if (hipMemsetAsync((char*)d_ws + WS_CTL, 0, CTL_ZERO_BYTES, stream) != hipSuccess) return;
    Args a{};
    for (int i = 0; i < 21; ++i) a.in[i] = (const float*)d_in[i];
    a.out = (float*)d_out; a.ws = (unsigned char*)d_ws;
#if MK_PER_PHASE
    for (int ph = 0; ph < PH_END; ++ph) {
        const int k = (ph - 1) % PH_PER_LAYER, layer = (ph - 1) / PH_PER_LAYER;
        if (ph > 0 && layer == 0 && k > 16) continue;
        a.ph_lo = ph; a.ph_hi = ph + 1;
        hipLaunchKernelGGL(fwd, dim3(grid), dim3(NWAVES * 64), LDS_BYTES, stream, a);
    }
#else
    a.ph_lo = 0; a.ph_hi = PH_END;
    hipLaunchKernelGGL(fwd, dim3(grid), dim3(NWAVES * 64), LDS_BYTES, stream, a);
#endif
}
```

```cpp
#include <hip/hip_runtime.h>
#include <cstdio>
#include <cstdint>

namespace pg8 {
#define PG8_LAS __attribute__((address_space(3)))
typedef unsigned short bf16_t;
typedef short bf16x8 __attribute__((ext_vector_type(8)));
typedef float f32x4 __attribute__((ext_vector_type(4)));
typedef unsigned u32x4 __attribute__((ext_vector_type(4)));
constexpr int BM = 256, BK = 64, HALF = 128, HTB = HALF * BK * 2  , STAGE_BYTES = 8 * HTB, NXCD = 8, WGM = 8;

__host__ __device__ __forceinline__ int lds_byte(int r, int c) { const int st = (r >> 4) * 2 + (c >> 5), rr = r & 15, cc = c & 31, ob = rr * 64 + cc * 2; return st * 1024 + (ob ^ (((ob >> 9) & 1) << 5)); }
__host__ __device__ __forceinline__ void stage_rc(int b, int& R, int& C) { const int st = b / 1024, sb = b % 1024, swz = sb ^ (((sb >> 9) & 1) << 5); R = (st >> 1) * 16 + swz / 64; C = (st & 1) * 32 + (swz % 64) / 2; }
__host__ __device__ __forceinline__ int perm32(int rho) { const int n = rho >> 4, i = rho & 15; return 8 * (i >> 2) + 4 * n + (i & 3); }

struct Unit { int pm, pn, ko, kl; };
struct Gemm { const bf16_t* A; const bf16_t* Bt; int M, N, K; };

struct StaticOrder {
    int nM, nN, nwg, G, c, kl;
    __host__ __device__ void init(int M, int N, int G_, int c_, int kl_) { nM = M / BM; nN = N / BM; nwg = nM * nN; G = G_; c = c_; kl = kl_; }
    __host__ __device__ bool next(int i, Unit& u) const {
        const long L = (long)i * G + c; if (L >= nwg) return false;
        int wgid = (int)L; { const int q = nwg / NXCD, r = nwg % NXCD, xcd = wgid % NXCD, off = wgid / NXCD; wgid = (xcd < r ? xcd * (q + 1) : r * (q + 1) + (xcd - r) * q) + off; }
        const int nig = WGM * nN, gid = wgid / nig, fm = gid * WGM, gsz = (nM - fm) < WGM ? (nM - fm) : WGM;
        u.pm = fm + ((wgid % nig) % gsz); u.pn = (wgid % nig) / gsz; u.ko = 0; u.kl = kl; return true;
    }
    __device__ __forceinline__ void a_ready(const Unit&) const {}
    __device__ __forceinline__ void done(const Unit&) const {}
};

struct InProjOrder : StaticOrder {
    __device__ __forceinline__ bool next(int i, Unit& u) const { if (!StaticOrder::next(i, u)) return false; if (u.pn == 13) u.pn = 28; return true; }
};

__device__ __forceinline__ unsigned cvt_pk_bf16(float lo, float hi) { unsigned r; asm volatile("v_cvt_pk_bf16_f32 %0, %1, %2" : "=v"(r) : "v"(lo), "v"(hi)); return r; }
__device__ __forceinline__ int lane_now() { int l; asm volatile("v_mbcnt_lo_u32_b32 %0, -1, 0\n\tv_mbcnt_hi_u32_b32 %0, -1, %0" : "=v"(l)); return l; }
__device__ __forceinline__ float sigmoidf_(float v) { return __builtin_amdgcn_rcpf(1.f + __expf(-v)); }
__device__ __forceinline__ float bflo(unsigned u) { return __uint_as_float(u << 16); }
__device__ __forceinline__ float bfhi(unsigned u) { return __uint_as_float(u & 0xffff0000u); }

__device__ __forceinline__ void st16(void* ubase, unsigned voff, u32x4 w) { *(u32x4*)((char*)ubase + voff) = w; }
__device__ __forceinline__ u32x4 ld16(const void* ubase, unsigned voff) { return *(const u32x4*)((const char*)ubase + voff); }
__device__ __forceinline__ u32x4 pack8(const f32x4 v0, const f32x4 v1) { u32x4 w; w.x = cvt_pk_bf16(v0[0], v0[1]); w.y = cvt_pk_bf16(v0[2], v0[3]); w.z = cvt_pk_bf16(v1[0], v1[1]); w.w = cvt_pk_bf16(v1[2], v1[3]); return w; }
struct EpiBf16 {
    static constexpr bool PERM = true, AFTER_DRAIN = false;
    bf16_t* O; int ldc; int pn_mod; int klen; size_t kstride;
    __device__ __forceinline__ void operator()(const f32x4 (&acc)[2][2][4][2], const Unit& u, int wr, int wc, int, int) const {
        const int ln_ = lane_now(), fr = ln_ & 15, fq = ln_ >> 4;
        const unsigned voff = (unsigned)((wr * 64 + fr) * ldc + wc * 32 + 8 * fq) * 2u;
        char* tb = (char*)O + ((size_t)(u.ko / klen) * kstride + (size_t)u.pm * BM * ldc + (size_t)(u.pn % pn_mod) * BM) * 2;
#pragma unroll
        for (int ai = 0; ai < 2; ++ai)
#pragma unroll
            for (int m = 0; m < 4; ++m)
#pragma unroll
                for (int bj = 0; bj < 2; ++bj) st16(tb + ((size_t)(ai * HALF + m * 16) * ldc + bj * HALF) * 2, voff, pack8(acc[ai][bj][m][0], acc[ai][bj][m][1]));
    }
};
struct EpiSwiGLU {
    static constexpr bool PERM = true, AFTER_DRAIN = false;
    bf16_t* O; int ldc; int pn_mod;
    __device__ __forceinline__ void operator()(const f32x4 (&acc)[2][2][4][2], const Unit& u, int wr, int wc, int, int) const {
        const int ln_ = lane_now(), fr = ln_ & 15, fq = ln_ >> 4;
        const unsigned voff = (unsigned)((wr * 64 + fr) * ldc + wc * 32 + 8 * fq) * 2u;
        char* tb = (char*)O + ((size_t)u.pm * BM * ldc + (size_t)(u.pn % pn_mod) * HALF) * 2;
#pragma unroll
        for (int ai = 0; ai < 2; ++ai)
#pragma unroll
            for (int m = 0; m < 4; ++m) {
                f32x4 r0, r1;
#pragma unroll
                for (int j = 0; j < 4; ++j) { const float g0 = acc[ai][0][m][0][j], u0 = acc[ai][1][m][0][j], g1 = acc[ai][0][m][1][j], u1 = acc[ai][1][m][1][j];
                    r0[j] = g0 * sigmoidf_(g0) * u0; r1[j] = g1 * sigmoidf_(g1) * u1; }
                st16(tb + (size_t)(ai * HALF + m * 16) * ldc * 2, voff, pack8(r0, r1)); }
    }
};
struct EpiInProj {
    static constexpr bool PERM = true, AFTER_DRAIN = false;
    bf16_t* qkv; float* ng; size_t ht;
    __device__ __forceinline__ void operator()(const f32x4 (&acc)[2][2][4][2], const Unit& u, int wr, int wc, int, int) const {
        const int ln_ = lane_now(), fr = ln_ & 15, fq = ln_ >> 4;
        const int rl = wr * 64 + fr;
#pragma unroll
        for (int bj = 0; bj < 2; ++bj) {
            const int colblk = u.pn * BM + bj * HALF + wc * 32;
            const int hb = colblk >> 6, cin = (colblk & 63) + 8 * fq;
            if (hb < 50) {
                const bool vt = (hb == 7) | (hb == 9) | (hb == 16) | (hb == 17) | (hb >= 34 && hb < 38) | (hb >= 46);
                if (!vt) {
                    char* tb = (char*)qkv + ((size_t)hb * ht + (size_t)u.pm * BM * 64) * 2; const unsigned voff = (unsigned)(rl * 64 + cin) * 2u;
#pragma unroll
                    for (int ai = 0; ai < 2; ++ai)
#pragma unroll
                        for (int m = 0; m < 4; ++m) st16(tb + (size_t)(ai * HALF + m * 16) * 64 * 2, voff, pack8(acc[ai][bj][m][0], acc[ai][bj][m][1]));
                } else {
                    const int bb = u.pm >> 3, s0 = (u.pm & 7) * BM + rl;
                    char* tb = (char*)qkv + ((size_t)hb * ht + ((size_t)bb * 64 + (colblk & 63)) * 2048) * 2;
                    const bool dilv = (hb >= 34 && hb < 38);
                    char* t4 = (char*)qkv + ((size_t)(50 + (hb - 34) * 2) * ht + ((size_t)bb * 64 + (colblk & 63)) * 2048) * 2; char* t16 = t4 + ht * 2;
#pragma unroll
                    for (int ai = 0; ai < 2; ++ai)
#pragma unroll
                        for (int m = 0; m < 4; ++m) { const int s = s0 + ai * HALF + m * 16; const u32x4 w = pack8(acc[ai][bj][m][0], acc[ai][bj][m][1]);
                            {
                                const int j = fr & 7; u32x4 t = w;
#define PG8_SWZ(v, m) ((unsigned)__builtin_amdgcn_ds_swizzle((int)(v), ((m) << 10) | 0x1f))
                                { const unsigned s0 = (j & 4) ? t.x : t.z, s1 = (j & 4) ? t.y : t.w; const unsigned r0 = PG8_SWZ(s0, 4), r1 = PG8_SWZ(s1, 4);
                                  if (j & 4) { t.x = r0; t.y = r1; } else { t.z = r0; t.w = r1; } }
                                { const unsigned s0 = (j & 2) ? t.x : t.y, s1 = (j & 2) ? t.z : t.w; const unsigned r0 = PG8_SWZ(s0, 2), r1 = PG8_SWZ(s1, 2);
                                  if (j & 2) { t.x = r0; t.z = r1; } else { t.y = r0; t.w = r1; } }
                                { const unsigned p0 = PG8_SWZ(t.x, 1), p1 = PG8_SWZ(t.y, 1), p2 = PG8_SWZ(t.z, 1), p3 = PG8_SWZ(t.w, 1);
                                  if (j & 1) { t.x = (p0 >> 16) | (t.x & 0xffff0000u); t.y = (p1 >> 16) | (t.y & 0xffff0000u); t.z = (p2 >> 16) | (t.z & 0xffff0000u); t.w = (p3 >> 16) | (t.w & 0xffff0000u); }
                                  else       { t.x = (t.x & 0xffffu) | (p0 << 16); t.y = (t.y & 0xffffu) | (p1 << 16); t.z = (t.z & 0xffffu) | (p2 << 16); t.w = (t.w & 0xffffu) | (p3 << 16); } }
#undef PG8_SWZ
                                st16(tb, (unsigned)((8 * fq + j) * 2048 + (s - j)) * 2u, t);
                            }
                            if (dilv) {
                                const unsigned v4 = (unsigned)(8 * fq * 2048 + (s & 3) * 512 + (s >> 2)) * 2u, v16 = (unsigned)(8 * fq * 2048 + (s & 15) * 128 + (s >> 4)) * 2u;
                                *(unsigned short*)(t4 + v4) = (unsigned short)w.x; *(unsigned short*)(t4 + v4 + 4096) = (unsigned short)(w.x >> 16);
                                *(unsigned short*)(t4 + v4 + 2 * 4096) = (unsigned short)w.y; *(unsigned short*)(t4 + v4 + 3 * 4096) = (unsigned short)(w.y >> 16);
                                *(unsigned short*)(t4 + v4 + 4 * 4096) = (unsigned short)w.z; *(unsigned short*)(t4 + v4 + 5 * 4096) = (unsigned short)(w.z >> 16);
                                *(unsigned short*)(t4 + v4 + 6 * 4096) = (unsigned short)w.w; *(unsigned short*)(t4 + v4 + 7 * 4096) = (unsigned short)(w.w >> 16);
                                *(unsigned short*)(t16 + v16) = (unsigned short)w.x; *(unsigned short*)(t16 + v16 + 4096) = (unsigned short)(w.x >> 16);
                                *(unsigned short*)(t16 + v16 + 2 * 4096) = (unsigned short)w.y; *(unsigned short*)(t16 + v16 + 3 * 4096) = (unsigned short)(w.y >> 16);
                                *(unsigned short*)(t16 + v16 + 4 * 4096) = (unsigned short)w.z; *(unsigned short*)(t16 + v16 + 5 * 4096) = (unsigned short)(w.z >> 16);
                                *(unsigned short*)(t16 + v16 + 6 * 4096) = (unsigned short)w.w; *(unsigned short*)(t16 + v16 + 7 * 4096) = (unsigned short)(w.w >> 16);
                            } }
                }
            } else if (hb == 114) {
                if (cin < 16) {
                    char* tb = (char*)ng + (size_t)u.pm * BM * 16 * 4; const unsigned voff = (unsigned)(rl * 16 + cin) * 4u;
#pragma unroll
                    for (int ai = 0; ai < 2; ++ai)
#pragma unroll
                        for (int m = 0; m < 4; ++m) { char* p = tb + (size_t)(ai * HALF + m * 16) * 16 * 4;
                            *(f32x4*)(p + voff) = acc[ai][bj][m][0]; *(f32x4*)(p + 16 + voff) = acc[ai][bj][m][1]; }
                }
            }
        }
    }
};
struct MergeOrder {
    int ntile, G, c, pm_off, pn_off;
    __device__ __forceinline__ bool next(int i, Unit& u) const {
        const int tl = (i >> 3) * G + c, sub = i & 7, br = sub >> 1; if (tl >= ntile) return false;
        const int pml = tl >> 2, pnl = tl & 3;
        if (sub & 1) { u.pm = pml; u.pn = br * 4 + pnl; u.ko = 0; u.kl = 1024; }
        else         { u.pm = pm_off + pml; u.pn = pn_off + pnl; u.ko = br * 256; u.kl = 256; }
        return true;
    }
    __device__ __forceinline__ void a_ready(const Unit&) const {}
    __device__ __forceinline__ void done(const Unit&) const {}
};
struct EpiMerge {
    static constexpr bool PERM = true, AFTER_DRAIN = false;
    bf16_t* merged; bf16_t* scratch; int pm_off, pn_off;
    __device__ __forceinline__ void operator()(const f32x4 (&acc)[2][2][4][2], const Unit& u, int wr, int wc, int, int) const {
        const int ln_ = lane_now(), fr = ln_ & 15, fq = ln_ >> 4;
        const int rl = wr * 64 + fr, cl = wc * 32 + 8 * fq;
        const unsigned voffs = (unsigned)(rl * 256 + cl) * 2u;
        if (u.kl == 256) {
#pragma unroll
            for (int ai = 0; ai < 2; ++ai)
#pragma unroll
                for (int m = 0; m < 4; ++m)
#pragma unroll
                    for (int bj = 0; bj < 2; ++bj) st16((char*)scratch + ((size_t)(ai * HALF + m * 16) * 256 + bj * HALF) * 2, voffs, pack8(acc[ai][bj][m][0], acc[ai][bj][m][1]));
        } else {
            const int br = u.pn >> 2, pml = u.pm, pnl = u.pn & 3;
            const unsigned voffm = (unsigned)(rl * 1024 + cl) * 2u;
            char* tm = (char*)merged + ((size_t)pml * BM * 1024 + (size_t)pnl * BM) * 2;
#pragma unroll
            for (int ai = 0; ai < 2; ++ai) {
                u32x4 pz[4][2], om[4][2];
#pragma unroll
                for (int m = 0; m < 4; ++m)
#pragma unroll
                    for (int bj = 0; bj < 2; ++bj) { pz[m][bj] = ld16((const char*)scratch + ((size_t)(ai * HALF + m * 16) * 256 + bj * HALF) * 2, voffs);
                        om[m][bj] = ld16(tm + ((size_t)(ai * HALF + m * 16) * 1024 + bj * HALF) * 2, voffm); }
                __builtin_amdgcn_sched_barrier(0);
                const unsigned keep = (br != 0) ? 0xffffffffu : 0u;
#pragma unroll
                for (int m = 0; m < 4; ++m)
#pragma unroll
                    for (int bj = 0; bj < 2; ++bj) { const f32x4 v0 = acc[ai][bj][m][0], v1 = acc[ai][bj][m][1]; const u32x4 z = pz[m][bj]; u32x4 o = om[m][bj]; o.x &= keep; o.y &= keep; o.z &= keep; o.w &= keep;
                        f32x4 r0, r1;
                        r0[0] = bflo(z.x) * sigmoidf_(v0[0]) + bflo(o.x); r0[1] = bfhi(z.x) * sigmoidf_(v0[1]) + bfhi(o.x); r0[2] = bflo(z.y) * sigmoidf_(v0[2]) + bflo(o.y); r0[3] = bfhi(z.y) * sigmoidf_(v0[3]) + bfhi(o.y);
                        r1[0] = bflo(z.z) * sigmoidf_(v1[0]) + bflo(o.z); r1[1] = bfhi(z.z) * sigmoidf_(v1[1]) + bfhi(o.z); r1[2] = bflo(z.w) * sigmoidf_(v1[2]) + bflo(o.w); r1[3] = bfhi(z.w) * sigmoidf_(v1[3]) + bfhi(o.w);
                        st16(tm + ((size_t)(ai * HALF + m * 16) * 1024 + bj * HALF) * 2, voffm, pack8(r0, r1)); }
            }
        }
    }
};
struct GroupedOrder {
    int nt0, nt1, nt2, nt3, nt4, nt5, nt6, nt7; int ncol, G, c, ksplit, klen;
    __device__ __forceinline__ bool next(int i, Unit& u) const {
        const int Lq = i * G + c; int L = Lq / ksplit; u.ko = (Lq - L * ksplit) * klen; u.kl = klen; int to = 0;
#define PG8_GO(e, nte) { const int n = (nte) * ncol; if (L < n) { u.pn = (e) * ncol + L / (nte); u.pm = to + L % (nte); return true; } L -= n; to += (nte); }
        PG8_GO(0, nt0) PG8_GO(1, nt1) PG8_GO(2, nt2) PG8_GO(3, nt3) PG8_GO(4, nt4) PG8_GO(5, nt5) PG8_GO(6, nt6) PG8_GO(7, nt7)
#undef PG8_GO
        return false;
    }
    __device__ __forceinline__ void a_ready(const Unit&) const {}
    __device__ __forceinline__ void done(const Unit&) const {}
};

template <class Epi, class Sched, bool ALIGN_EPI = false, bool SP2 = false>
__device__ __forceinline__ void gemm_phase(PG8_LAS unsigned char* lds, const Gemm g, const Sched& S, const Epi& E, const int wave_s  ) {
    const int tid_l = lane_now() + 64 * wave_s;
    const int tid = tid_l, wid = wave_s, lane = tid & 63, wr = wid >> 2, wc = wid & 3, fr = lane & 15, fq = lane >> 4;
    const int K = g.K;
    unsigned voffA[2], voffB[2];
#pragma unroll
    for (int i = 0; i < 2; ++i) { int R, C; stage_rc(tid * 16 + i * 8192, R, C); const int Rb = Epi::PERM ? ((R & ~31) + perm32(R & 31)) : R;
        voffA[i] = (unsigned)(R * K + C) * 2u; voffB[i] = (unsigned)(Rb * K + C) * 2u; }
    const size_t kstep = (size_t)(BK * 2);
    const size_t hstep = (size_t)HALF * K * 2;
    const size_t tstep = 2 * hstep;
    const unsigned ldsw = (unsigned)wid * 1024u;
    const int aoff = lds_byte(wr * 64 + fr, fq * 8), boff = lds_byte(wc * 32 + fr, fq * 8);
#define PG8_SA(b, h) (((b) * 2 + (h)) * HTB)
#define PG8_SB(b, h) ((4 + (b) * 2 + (h)) * HTB)
#define PG8_STAGE(bufoff, gbase, voff) do { _Pragma("unroll") for (int _i = 0; _i < 2; ++_i) \
        __builtin_amdgcn_global_load_lds((const unsigned*)((const char*)(gbase) + (voff)[_i]), (PG8_LAS unsigned*)(lds + (bufoff) + ldsw + _i * 8192), 16, 0, 0); } while (0)
#define PG8_LDA(dst, b, h) do { _Pragma("unroll") for (int m = 0; m < 4; ++m) _Pragma("unroll") for (int k = 0; k < 2; ++k) dst[m][k] = *(const PG8_LAS bf16x8*)(lds + PG8_SA(b, h) + aoff + m * 2048 + k * 1024); } while (0)
#define PG8_LDB(dst, b, h) do { _Pragma("unroll") for (int n = 0; n < 2; ++n) _Pragma("unroll") for (int k = 0; k < 2; ++k) dst[n][k] = *(const PG8_LAS bf16x8*)(lds + PG8_SB(b, h) + boff + n * 2048 + k * 1024); } while (0)
#define PG8_MMA(ai, bj, At, Bt) do { __builtin_amdgcn_s_setprio(1); _Pragma("unroll") for (int m = 0; m < 4; ++m) _Pragma("unroll") for (int n = 0; n < 2; ++n) _Pragma("unroll") for (int k = 0; k < 2; ++k) \
        acc[ai][bj][m][n] = __builtin_amdgcn_mfma_f32_16x16x32_bf16(Bt[n][k], At[m][k], acc[ai][bj][m][n], 0, 0, 0); __builtin_amdgcn_s_setprio(0); } while (0)
#define PG8_WAIT_V(n) asm volatile("s_waitcnt vmcnt(" #n ")" ::: "memory")
#define PG8_WAIT_L(n) asm volatile("s_waitcnt lgkmcnt(" #n ")" ::: "memory")
#define PG8_BAR __builtin_amdgcn_s_barrier()
#define PG8_SCHED __builtin_amdgcn_sched_barrier(0)
    Unit cur, nxt; int ui = 0;
    if (!S.next(0, cur)) return;
    f32x4 acc[2][2][4][2];
#pragma unroll
    for (int a = 0; a < 2; ++a)
#pragma unroll
        for (int b = 0; b < 2; ++b)
#pragma unroll
            for (int m = 0; m < 4; ++m)
#pragma unroll
                for (int n = 0; n < 2; ++n) acc[a][b][m][n] = (f32x4){0.f, 0.f, 0.f, 0.f};
    bf16x8 At[4][2], B0[2][2], B1[2][2];
    const char* cA = (const char*)g.A + (size_t)cur.pm * tstep + (size_t)cur.ko * 2; const char* cB = (const char*)g.Bt + (size_t)cur.pn * tstep + (size_t)cur.ko * 2;
    S.a_ready(cur);
    if constexpr (SP2) {
        PG8_STAGE(PG8_SB(0, 0), cB, voffB); PG8_STAGE(PG8_SB(0, 1), cB + hstep, voffB); PG8_STAGE(PG8_SA(0, 0), cA, voffA); PG8_STAGE(PG8_SA(0, 1), cA + hstep, voffA);
        if (wr == 1) PG8_BAR;
        PG8_WAIT_V(2); PG8_BAR;
        PG8_STAGE(PG8_SB(1, 0), cB + kstep, voffB); PG8_STAGE(PG8_SA(1, 0), cA + kstep, voffA); PG8_STAGE(PG8_SB(1, 1), cB + hstep + kstep, voffB);
        PG8_WAIT_V(6); PG8_BAR;
    } else {
        PG8_STAGE(PG8_SB(0, 0), cB, voffB); PG8_STAGE(PG8_SA(0, 0), cA, voffA); PG8_STAGE(PG8_SB(0, 1), cB + hstep, voffB); PG8_STAGE(PG8_SA(0, 1), cA + hstep, voffA);
        if (wr == 1) PG8_BAR;
        PG8_WAIT_V(4); PG8_BAR;
        PG8_STAGE(PG8_SB(1, 0), cB + kstep, voffB); PG8_STAGE(PG8_SA(1, 0), cA + kstep, voffA); PG8_STAGE(PG8_SB(1, 1), cB + hstep + kstep, voffB);
        PG8_WAIT_V(6); PG8_BAR;
    }
    for (;;) {
        const bool has_next = S.next(ui + 1, nxt);
        const char* nA = has_next ? (const char*)g.A + (size_t)nxt.pm * tstep + (size_t)nxt.ko * 2 : cA; const char* nB = has_next ? (const char*)g.Bt + (size_t)nxt.pn * tstep + (size_t)nxt.ko * 2 : cB;
        const int nt = cur.kl / BK;
        for (int t = 0; t < nt; t += 2) {
            const bool last = (t == nt - 2);
            const char* a1 = cA + (size_t)(t + 1) * kstep;
            const char* a2 = last ? nA : cA + (size_t)(t + 2) * kstep; const char* b2 = last ? nB : cB + (size_t)(t + 2) * kstep;
            const char* a3 = a2 + kstep; const char* b3 = b2 + kstep;
            if (last && has_next) S.a_ready(nxt);
            if constexpr (SP2) {
            PG8_LDB(B0, 0, 0); PG8_LDB(B1, 0, 1); PG8_SCHED; PG8_LDA(At, 0, 0); PG8_STAGE(PG8_SA(1, 1), a1 + hstep, voffA);
            PG8_WAIT_V(8); PG8_WAIT_L(0); PG8_BAR; PG8_MMA(0, 0, At, B0); PG8_MMA(0, 1, At, B1); PG8_BAR; PG8_SCHED;
            PG8_LDA(At, 0, 1); PG8_STAGE(PG8_SB(0, 0), b2, voffB); PG8_STAGE(PG8_SB(0, 1), b2 + hstep, voffB); PG8_STAGE(PG8_SA(0, 0), a2, voffA);
            PG8_WAIT_V(8); PG8_WAIT_L(0); PG8_BAR; PG8_MMA(1, 0, At, B0); PG8_MMA(1, 1, At, B1); PG8_BAR; PG8_SCHED;
            PG8_LDB(B0, 1, 0); PG8_LDB(B1, 1, 1); PG8_SCHED; PG8_LDA(At, 1, 0); PG8_STAGE(PG8_SA(0, 1), a2 + hstep, voffA);
            PG8_WAIT_V(8); PG8_WAIT_L(0); PG8_BAR; PG8_MMA(0, 0, At, B0); PG8_MMA(0, 1, At, B1); PG8_BAR; PG8_SCHED;
            PG8_LDA(At, 1, 1); PG8_STAGE(PG8_SB(1, 0), b3, voffB); PG8_STAGE(PG8_SB(1, 1), b3 + hstep, voffB); PG8_STAGE(PG8_SA(1, 0), a3, voffA);
            PG8_WAIT_V(8); PG8_WAIT_L(0); PG8_BAR; PG8_MMA(1, 0, At, B0); PG8_MMA(1, 1, At, B1); PG8_BAR; PG8_SCHED;
            } else {
            PG8_LDB(B0, 0, 0); PG8_SCHED; PG8_LDA(At, 0, 0); PG8_STAGE(PG8_SA(1, 1), a1 + hstep, voffA);
            PG8_WAIT_L(8); PG8_BAR; PG8_WAIT_L(0); PG8_MMA(0, 0, At, B0); PG8_BAR; PG8_SCHED;
            PG8_LDB(B1, 0, 1); PG8_STAGE(PG8_SB(0, 0), b2, voffB);
            PG8_BAR; PG8_WAIT_L(0); PG8_MMA(0, 1, At, B1); PG8_BAR;
            PG8_LDA(At, 0, 1); PG8_STAGE(PG8_SA(0, 0), a2, voffA);
            PG8_BAR; PG8_WAIT_L(0); PG8_MMA(1, 0, At, B0); PG8_BAR; PG8_SCHED;
            PG8_STAGE(PG8_SB(0, 1), b2 + hstep, voffB);
            PG8_WAIT_V(6); PG8_BAR; PG8_MMA(1, 1, At, B1); PG8_BAR;
            PG8_LDB(B0, 1, 0); PG8_SCHED; PG8_LDA(At, 1, 0); PG8_STAGE(PG8_SA(0, 1), a2 + hstep, voffA);
            PG8_WAIT_L(8); PG8_BAR; PG8_WAIT_L(0); PG8_MMA(0, 0, At, B0); PG8_BAR; PG8_SCHED;
            PG8_LDB(B1, 1, 1); PG8_STAGE(PG8_SB(1, 0), b3, voffB);
            PG8_BAR; PG8_WAIT_L(0); PG8_MMA(0, 1, At, B1); PG8_BAR;
            PG8_LDA(At, 1, 1); PG8_STAGE(PG8_SA(1, 0), a3, voffA);
            PG8_BAR; PG8_WAIT_L(0); PG8_MMA(1, 0, At, B0); PG8_BAR; PG8_SCHED;
            PG8_STAGE(PG8_SB(1, 1), b3 + hstep, voffB);
            PG8_WAIT_V(6); PG8_BAR; PG8_MMA(1, 1, At, B1); PG8_BAR;
            }
        }
        if constexpr (ALIGN_EPI) { if (wr == 0) PG8_BAR; }
        if constexpr (!Epi::AFTER_DRAIN) { E(acc, cur, wr, wc, fr, fq); S.done(cur); }
        if (!has_next) break;
#pragma unroll
        for (int a = 0; a < 2; ++a)
#pragma unroll
            for (int b = 0; b < 2; ++b)
#pragma unroll
                for (int m = 0; m < 4; ++m)
#pragma unroll
                    for (int n = 0; n < 2; ++n) acc[a][b][m][n] = (f32x4){0.f, 0.f, 0.f, 0.f};
        cur = nxt; cA = nA; cB = nB; ++ui;
        if constexpr (ALIGN_EPI) { if (wr == 1) PG8_BAR; }
    }
    PG8_WAIT_V(0);
    if constexpr (!ALIGN_EPI) { if (wr == 0) PG8_BAR; }
    PG8_BAR;
    if constexpr (Epi::AFTER_DRAIN) { E.fused(acc, cur, wr, wc, fr, fq, lds, wid, lane); S.done(cur); }
#undef PG8_SA
#undef PG8_SB
#undef PG8_STAGE
#undef PG8_LDA
#undef PG8_LDB
#undef PG8_MMA
#undef PG8_WAIT_V
#undef PG8_WAIT_L
#undef PG8_BAR
#undef PG8_SCHED
}
}

constexpr int NWAVES = 8;
constexpr int D = 1024, BATCH = 16, SEQ = 2048, T = BATCH * SEQ, NHALF = 1, TH = T / NHALF, BH = BATCH / NHALF;
constexpr int DIN = 7308, DINP = 7424;
constexpr int DFF = 2816, DFFE = 3584, NE = 8;
constexpr int KSPLIT = 4;
constexpr int NCHUNK = 4, TCH = T / NCHUNK, CH_ROWS = 2 * TCH + NE * 256;
constexpr float ALPHA = 1.4142135623730951f, LN_EPS = 1e-5f;
constexpr int NBH = 20;
constexpr int HT_NSAQ = 0, HT_KCMP = 4, HT_VCMP = 5, HT_KSEL = 6, HT_VSEL = 7, HT_KWIN = 8, HT_VWIN = 9, HT_SWAQ = 10, HT_SWAK = 14, HT_SWAV = 16,
              HT_DILQ = 18, HT_DILK = 30, HT_DILV = 34, HT_SBQ = 38, HT_SBK = 42, HT_SBV = 46, NHT = 58;
constexpr size_t HT_ELEMS = (size_t)TH * 64;

constexpr size_t MiB = 1u << 20;
constexpr size_t WS_CTL = 0, CTL_ZERO_BYTES = 1 * MiB;
constexpr size_t WS_MOD = 1 * MiB;
constexpr size_t WS_BIAS = 2 * MiB;
constexpr size_t WS_ROUTE = 3 * MiB;
constexpr size_t WS_KC = 4 * MiB;
constexpr size_t WS_C1 = 5 * MiB;
constexpr size_t WS_NG = 6 * MiB;
constexpr size_t WS_W = 8 * MiB;
constexpr size_t TILE_B = (size_t)256 * D * 2;
constexpr size_t W_IN = 0, W_IN_L = 34 * TILE_B;
constexpr size_t W_GATE = (size_t)3200 * D * 2, W_BRC = W_GATE + 17 * TILE_B;
constexpr size_t W_OUT = W_IN + 2 * W_IN_L, W_OUT_L = (size_t)D * D * 2;
constexpr size_t W_GU = W_OUT + 2 * W_OUT_L;
constexpr size_t W_DN = W_GU + (size_t)2 * DFF * D * 2;
constexpr size_t W_END = W_DN + (size_t)D * DFF * 2;
static_assert(WS_W + W_END <= 64 * MiB, "weights");
constexpr size_t WS_ACT = 64 * MiB;
constexpr size_t A_H2 = WS_ACT;
constexpr size_t A_HY = WS_ACT + 64 * MiB;
constexpr size_t A_QKV = WS_ACT + 128 * MiB, A_MERGED = A_QKV;
constexpr size_t A_O4 = WS_ACT + 360 * MiB;
constexpr size_t A_DIL = WS_ACT + 424 * MiB;
constexpr size_t A_PS = WS_ACT + 474 * MiB;
constexpr size_t A_ACT = WS_ACT + 64 * MiB, A_Y2 = WS_ACT + 240 * MiB;
constexpr size_t A_MGU = WS_ACT + 64 * MiB, W_MGU_E = (size_t)2 * DFFE * D * 2;
constexpr size_t A_MDN = WS_ACT + 176 * MiB, W_MDN_E = (size_t)D * DFFE * 2;
constexpr size_t A_AS = WS_ACT + 232 * MiB, A_ACTE = WS_ACT + 268 * MiB, A_YP = WS_ACT + 394 * MiB;
constexpr size_t WS_END = WS_ACT + 556 * MiB;
static_assert((A_O4 - A_HY) % TILE_B == 0, "tile offsets");
static_assert(NHT * HT_ELEMS * 2 <= 232 * MiB && (size_t)CH_ROWS * D * 2 <= 36 * MiB && (size_t)CH_ROWS * DFFE * 2 <= 126 * MiB && A_YP + (size_t)KSPLIT * CH_ROWS * D * 2 <= WS_END
              && A_DIL + (size_t)3 * TH * 256 * 2 + (size_t)3 * TH * 16 <= A_PS && A_MGU + NE * W_MGU_E <= A_MDN && A_MDN + NE * W_MDN_E <= A_AS, "arena");
constexpr int CW_BAR = 4096, CW_CNT = 16384, CW_QUEUE = 20480, CW_CMPF = 24576;

constexpr int RING_BYTES = 131072, LDS_BYTES = 155648, MISC_OFF = LDS_BYTES - 512;

#define GAS __attribute__((address_space(1)))
#define LAS __attribute__((address_space(3)))
typedef unsigned short bf16;
typedef unsigned v4u __attribute__((ext_vector_type(4)));
typedef float f32x4 __attribute__((ext_vector_type(4)));
#define LDS_WAIT() asm volatile("s_waitcnt lgkmcnt(0)" ::: "memory")
__device__ __forceinline__ unsigned f2bf(float f) { unsigned u = __builtin_bit_cast(unsigned, f); return (u + 0x7fffu + ((u >> 16) & 1u)) >> 16; }
__device__ __forceinline__ unsigned pk2(float lo, float hi) { return f2bf(lo) | (f2bf(hi) << 16); }
__device__ __forceinline__ float bflo(unsigned u) { return __uint_as_float(u << 16); }
__device__ __forceinline__ float bfhi(unsigned u) { return __uint_as_float(u & 0xffff0000u); }
__device__ __forceinline__ float sigm(float v) { return 1.f / (1.f + __expf(-v)); }

__device__ __forceinline__ int lane_id_l() { return pg8::lane_now(); }
#define XB_TMO      128
#define XB_XCNT(j)  (256  + 64 * (j))
#define XB_XSUB(j)  (1280 + 64 * (j))
#define XB_XGEN(j)  (2304 + 64 * (j))
#define XB_TOP      3328
#define XB_TOPGEN   3392
#define XCD_BAR_WORDS 3456
#define XB_SPIN_CAP (1u << 18)
__device__ __forceinline__ unsigned xb_ld(unsigned* p)              { return __hip_atomic_load(p, __ATOMIC_RELAXED, __HIP_MEMORY_SCOPE_AGENT); }
__device__ __forceinline__ unsigned xb_add(unsigned* p, unsigned v) { return __hip_atomic_fetch_add(p, v, __ATOMIC_RELAXED, __HIP_MEMORY_SCOPE_AGENT); }
__device__ __forceinline__ unsigned xb_xcc_id() { return (unsigned)__builtin_amdgcn_s_getreg((3 << 11) | 20) & 0xFu; }
#define XB_SPIN(cond, bar) do { unsigned _sp = 0; while (cond) { __builtin_amdgcn_s_sleep(1); \
    if ((++_sp & 255u) == 0u) { if (xb_ld(&(bar)[XB_TMO])) break; if (_sp > XB_SPIN_CAP) { atomicAdd(&(bar)[XB_TMO], 1u); break; } } } } while (0)
struct XcdBarrier { unsigned* bar; unsigned x; volatile LAS unsigned* st; };
__device__ __forceinline__ XcdBarrier xcd_barrier_post(unsigned* bar, volatile LAS unsigned* st) {
    XcdBarrier b; b.bar = bar; b.x = xb_xcc_id(); b.st = st;
    if (threadIdx.x == 0) (void)xb_add(&bar[XB_XCNT(b.x)], 1u);
    return b;
}
__device__ __forceinline__ void xcd_barrier_complete(unsigned* bar, unsigned x, unsigned& nloc, unsigned& nx) {
    const unsigned G = gridDim.x * gridDim.y * gridDim.z;
    unsigned sum, cnt, mine, sp = 0u;
    for (;;) {
        sum = 0u; cnt = 0u; mine = 0u;
#pragma unroll
        for (unsigned j = 0; j < 16; ++j) { const unsigned c = xb_ld(&bar[XB_XCNT(j)]); sum += c; cnt += (c > 0u) ? 1u : 0u; }
        mine = xb_ld(&bar[XB_XCNT(x)]);
        if (sum == G) break;
        __builtin_amdgcn_s_sleep(1);
        if ((++sp & 255u) == 0u) { if (xb_ld(&bar[XB_TMO])) break; if (sp > XB_SPIN_CAP) { atomicAdd(&bar[XB_TMO], 1u); break; } }
    }
    nloc = mine > 0u ? mine : 1u; nx = cnt > 0u ? cnt : 1u;
}
__device__ __forceinline__ void xcd_barrier(const XcdBarrier& b, const int wave_s) {
    asm volatile("s_waitcnt vmcnt(0)" ::: "memory");
    __syncthreads();
    if (wave_s == 0 && lane_id_l() == 0) {
        unsigned* bar = b.bar; asm volatile("" : "+s"(bar));
        __builtin_amdgcn_s_waitcnt(0);
        unsigned nloc = b.st[0], nx = b.st[1];
        if (nloc == 0u) { xcd_barrier_complete(bar, b.x, nloc, nx); b.st[0] = nloc; b.st[1] = nx; }
        const unsigned old = xb_add(&bar[XB_XSUB(b.x)], 1u);
        const unsigned gen = old / nloc;
        if (old + 1u == (gen + 1u) * nloc) {
            __builtin_amdgcn_fence(__ATOMIC_RELEASE, "agent");
            asm volatile("s_waitcnt vmcnt(0)" ::: "memory");
            const unsigned og = xb_add(&bar[XB_TOP], 1u);
            const unsigned tg = og / nx;
            if (og + 1u == (tg + 1u) * nx) xb_add(&bar[XB_TOPGEN], 1u);
            else XB_SPIN(xb_ld(&bar[XB_TOPGEN]) == tg, bar);
            __builtin_amdgcn_fence(__ATOMIC_ACQUIRE, "agent");
            xb_add(&bar[XB_XGEN(b.x)], 1u);
            asm volatile("s_waitcnt vmcnt(0)" ::: "memory");
        } else {
            XB_SPIN(xb_ld(&bar[XB_XGEN(b.x)]) == gen, bar);
            __builtin_amdgcn_fence(__ATOMIC_ACQUIRE, "agent");
            asm volatile("s_waitcnt vmcnt(0)" ::: "memory");
        }
    }
    __syncthreads();
}

struct Args { const float* in[21]; float* out; unsigned char* ws; int ph_lo, ph_hi; };
typedef __attribute__((address_space(4))) const Args CArgs;
__device__ __forceinline__ CArgs* get_args() { CArgs* p = (CArgs*)__builtin_amdgcn_kernarg_segment_ptr(); asm volatile("" : "+s"(p)); return p; }
enum { IN_X = 0, IN_C, IN_RELB, IN_WADA, IN_BADA, IN_WIN, IN_WBR, IN_WOUT, IN_CPE, IN_CW1, IN_CW2, IN_SINK, IN_LNG, IN_LNB, IN_FG, IN_FU, IN_FD, IN_MR, IN_MG, IN_MU, IN_MD };

#define DPPF(v, ctrl) __int_as_float(__builtin_amdgcn_update_dpp(0, __float_as_int(v), (ctrl), 0xF, 0xF, true))
__device__ __forceinline__ float row_sum16(float v) { v += DPPF(v, 0xB1); v += DPPF(v, 0x4E); v += DPPF(v, 0x141); v += DPPF(v, 0x140); return v; }
__device__ __forceinline__ float rows_total(float v) {
    const int i = __float_as_int(v);
    return (__int_as_float(__builtin_amdgcn_readlane(i, 0)) + __int_as_float(__builtin_amdgcn_readlane(i, 16))) + (__int_as_float(__builtin_amdgcn_readlane(i, 32)) + __int_as_float(__builtin_amdgcn_readlane(i, 48)));
}
__device__ __forceinline__ float wave_sum(float v, int) { return rows_total(row_sum16(v)); }
__device__ __forceinline__ unsigned shfl_xor_u(unsigned v, int m, int lane) { return (unsigned)__builtin_amdgcn_ds_bpermute((lane ^ m) << 2, (int)v); }
__device__ __forceinline__ float shfl_f(float v, int src) { return __int_as_float(__builtin_amdgcn_ds_bpermute(src << 2, __float_as_int(v))); }

__device__ __forceinline__ void transpose_item(int mode, const float* src0, const float* src1, int Nsrc, int ldw  , int nblk, bf16* WT, LAS float* scr, int item, int lane) {
    const int kb = item / nblk, nb = item % nblk, k0 = 64 * kb, n0 = 32 * nb;
    const int n = n0 + (lane & 31);
    const float* cb;
    if (mode == 0) cb = src0 + n;
    else if (mode == 1) cb = (n < 640) ? src0 + n : (n < 7296) ? src0 + n + 12 : (n < 7308) ? src0 + (n - 7296 + 640) : nullptr;
    else { const int g = n >> 8, w = n & 255; cb = (w < 128) ? src0 + 128 * g + w : src1 + 128 * g + (w - 128); }
    float tv[32];
#pragma unroll
    for (int i = 0; i < 32; ++i) { const int kk = 2 * i + (lane >> 5); tv[i] = cb ? cb[(size_t)(k0 + kk) * Nsrc] : 0.f; }
#pragma unroll
    for (int i = 0; i < 32; ++i) { const int kk = 2 * i + (lane >> 5); scr[kk * 33 + (lane & 31)] = tv[i]; }
    LDS_WAIT(); asm volatile("" ::: "memory");
    const int c = lane & 7;
#pragma unroll
    for (int j = 0; j < 4; ++j) { const int nn = (lane >> 3) + 8 * j; const LAS float* s = scr + (8 * c) * 33 + nn;
        v4u o; o.x = pk2(s[0 * 33], s[1 * 33]); o.y = pk2(s[2 * 33], s[3 * 33]); o.z = pk2(s[4 * 33], s[5 * 33]); o.w = pk2(s[6 * 33], s[7 * 33]);
        *(GAS v4u*)(WT + (size_t)(n0 + nn) * ldw + k0 + 8 * c) = o; }
    LDS_WAIT(); asm volatile("" ::: "memory");
}

__device__ __forceinline__ int t5_bucket(int d) {
    if (d < 16) return d;
    int b = 16;
    b += (d >= 22); b += (d >= 30); b += (d >= 40); b += (d >= 54); b += (d >= 73); b += (d >= 99); b += (d >= 134); b += (d >= 182);
    b += (d >= 246); b += (d >= 332); b += (d >= 450); b += (d >= 609); b += (d >= 825); b += (d >= 1117); b += (d >= 1513);
    return b;
}

template <bool MOE_ONLY>
__device__ __forceinline__ void p0_prologue(CArgs* a, LAS unsigned char* lds, int G, int c, const int wave) {
    const int lane = lane_id_l(), tid = wave * 64 + lane;
    unsigned char* ws = a->ws; bf16* W = (bf16*)(ws + WS_W);
    LAS float* scr = (LAS float*)(lds + wave * 16384);
    const int gw = c * NWAVES + wave, NGW = G * NWAVES;
    constexpr int I_WIN = 16 * (DINP / 32), I_WBR = 4 * 32, I_WOUT = 16 * 32, I_GU = 16 * (2 * DFF / 32), I_DN = (DFF / 64) * 32, I_MGU = 16 * (2 * DFFE / 32), I_MDN = (DFFE / 64) * 32;
    constexpr int I_C1 = (2048 / 64) * 2;
    constexpr int NITEMS = MOE_ONLY ? (NE * I_MGU + NE * I_MDN) : (2 * I_WIN + 8 * I_WBR + 2 * I_WOUT + I_GU + I_DN + 4 * I_C1);
    for (int it = gw; it < NITEMS; it += NGW) {
        int r = it, mode = 0, Nsrc, K, nblk; const float* s0; const float* s1 = nullptr; bf16* dst;
        if (MOE_ONLY) {
            if (r < NE * I_MGU) { const int e = r / I_MGU; r -= e * I_MGU; mode = 2; s0 = a->in[IN_MG] + (size_t)e * D * DFFE; s1 = a->in[IN_MU] + (size_t)e * D * DFFE; Nsrc = DFFE; K = D; nblk = 2 * DFFE / 32; dst = (bf16*)(ws + A_MGU + e * W_MGU_E); }
            else { r -= NE * I_MGU; const int e = r / I_MDN; r -= e * I_MDN; s0 = a->in[IN_MD] + (size_t)e * DFFE * D; Nsrc = D; K = DFFE; nblk = 32; dst = (bf16*)(ws + A_MDN + e * W_MDN_E); }
        } else {
        if (r < 2 * I_WIN) { const int l = r / I_WIN; r -= l * I_WIN; mode = 1; s0 = a->in[IN_WIN] + (size_t)l * D * DIN; Nsrc = DIN; K = D; nblk = DINP / 32; dst = (bf16*)((char*)W + W_IN + l * W_IN_L); }
        else { r -= 2 * I_WIN;
        if (r < 8 * I_WBR) { const int j = r / I_WBR; r -= j * I_WBR; s0 = a->in[IN_WBR] + (size_t)j * 256 * D; Nsrc = D; K = D; nblk = 32; dst = (bf16*)((char*)W + W_IN + (j >> 2) * W_IN_L + W_BRC) + (j & 3) * 256; }
        else { r -= 8 * I_WBR;
        if (r < 2 * I_WOUT) { const int l = r / I_WOUT; r -= l * I_WOUT; s0 = a->in[IN_WOUT] + (size_t)l * D * D; Nsrc = D; K = D; nblk = 32; dst = (bf16*)((char*)W + W_OUT + l * W_OUT_L); }
        else { r -= 2 * I_WOUT;
        if (r < I_GU) { mode = 2; s0 = a->in[IN_FG]; s1 = a->in[IN_FU]; Nsrc = DFF; K = D; nblk = 2 * DFF / 32; dst = (bf16*)((char*)W + W_GU); }
        else { r -= I_GU;
        if (r < I_DN) { s0 = a->in[IN_FD]; Nsrc = D; K = DFF; nblk = 32; dst = (bf16*)((char*)W + W_DN); }
        else { r -= I_DN; const int j = r / I_C1; r -= j * I_C1; s0 = a->in[IN_CW1] + (size_t)j * 2048 * 64; Nsrc = 64; K = 2048; nblk = 2; dst = (bf16*)(ws + WS_C1) + (size_t)j * 64 * 2048; }
        }}}}
        }
        transpose_item(mode, s0, s1, Nsrc, K, nblk, dst, scr, r, lane);
    }
    __syncthreads();
    if (MOE_ONLY) return;
    if (c < 192) {
        LAS float* sc = (LAS float*)lds;
        LAS float* part = (LAS float*)(lds + 65536);
        for (int i = tid; i < 16 * D; i += 512) { const float v = a->in[IN_C][i]; sc[i] = v * sigm(v); }
        __syncthreads();
        const int l = c / 96, j0 = (c % 96) * 64;
        const float* wa = a->in[IN_WADA] + (size_t)l * D * 6144 + j0 + lane;
        float acc[16];
#pragma unroll
        for (int b = 0; b < 16; ++b) acc[b] = 0.f;
#pragma unroll 1
        for (int k8 = wave * 128; k8 < wave * 128 + 128; k8 += 8) { float wv[8];
#pragma unroll
            for (int e = 0; e < 8; ++e) wv[e] = wa[(size_t)(k8 + e) * 6144];
#pragma unroll
            for (int e = 0; e < 8; ++e) {
#pragma unroll
                for (int b = 0; b < 16; ++b) acc[b] = fmaf(sc[b * D + k8 + e], wv[e], acc[b]);
                asm volatile("" ::: "memory"); } }
#pragma unroll
        for (int b = 0; b < 16; ++b) part[(wave * 16 + b) * 64 + lane] = acc[b];
        __syncthreads();
        float* mod = (float*)(ws + WS_MOD);
        for (int o = tid; o < 16 * 64; o += 512) { const int b = o >> 6, j = o & 63; float s = a->in[IN_BADA][l * 6144 + j0 + j];
#pragma unroll
            for (int w = 0; w < 8; ++w) s += part[(w * 16 + b) * 64 + j];
            mod[((size_t)l * 16 + b) * 6144 + j0 + j] = s; }
        __syncthreads();
    } else {
        float* bt = (float*)(ws + WS_BIAS);
        for (int i = (c - 192) * 512 + tid; i < NBH * 2048; i += (G - 192) * 512) { const int h = i >> 11, d = i & 2047; bt[i] = a->in[IN_RELB][t5_bucket(d) * NBH + h]; }
    }
}

__device__ __forceinline__ void ln_stats(const f32x4 (&v)[4], float& mean, float& rstd, int) {
    float s = 0.f, s2 = 0.f;
#pragma unroll
    for (int j = 0; j < 4; ++j) { s += (v[j].x + v[j].y) + (v[j].z + v[j].w); s2 += (v[j].x * v[j].x + v[j].y * v[j].y) + (v[j].z * v[j].z + v[j].w * v[j].w); }
    s = row_sum16(s); s2 = row_sum16(s2);
    mean = rows_total(s) * (1.f / D);
    const float var = fmaxf(rows_total(s2) * (1.f / D) - mean * mean, 0.f);
    rstd = 1.f / sqrtf(var + LN_EPS);
}
__device__ __forceinline__ void store_bf16_row(bf16* orow, const f32x4 (&v)[4], int lane) {
    GAS unsigned long long* o8 = (GAS unsigned long long*)orow + lane;
#pragma unroll
    for (int j = 0; j < 4; ++j) o8[64 * j] = (unsigned long long)pk2(v[j].x, v[j].y) | ((unsigned long long)pk2(v[j].z, v[j].w) << 32);
}
__device__ __forceinline__ void ln_mod_phase(const float* xsrc, const float* mod_l, bf16* H, int half, int G, int c, int wave, int lane, LAS unsigned char* lds) {
    const int rpb = TH / G, rpw = rpb / NWAVES, rbase = c * rpb, b = (half * TH + rbase) >> 11;
    LAS f32x4* Lsh = (LAS f32x4*)lds; LAS f32x4* Lsc = Lsh + 256;
    { const int tid = wave * 64 + lane; const GAS f32x4* src = (const GAS f32x4*)(mod_l + (size_t)b * 6144); if (tid < 256) Lsh[tid] = src[tid]; else Lsc[tid - 256] = src[tid] + 1.f; }
    __syncthreads();
    const int r0 = rbase + wave * rpw;
    for (int rr = 0; rr < rpw; rr += 4) {
        f32x4 xx[4][4];
#pragma unroll
        for (int q = 0; q < 4; ++q) { const GAS f32x4* xr = (const GAS f32x4*)(xsrc + (size_t)(half * TH + r0 + rr + q) * D) + lane;
#pragma unroll
            for (int j = 0; j < 4; ++j) xx[q][j] = xr[64 * j]; }
#pragma unroll
        for (int q = 0; q < 4; ++q) { const int r = r0 + rr + q;
            f32x4 v[4];
#pragma unroll
            for (int j = 0; j < 4; ++j) v[j] = xx[q][j];
            float mean, rstd; ln_stats(v, mean, rstd, lane);
#pragma unroll
            for (int j = 0; j < 4; ++j) v[j] = (v[j] - mean) * rstd * Lsc[lane + 64 * j] + Lsh[lane + 64 * j];
            store_bf16_row(H + (size_t)r * D, v, lane); }
    }
    __syncthreads();
}
template <int YMODE, bool WRITE_H2, bool ROUTE, int XS = 0, int XD = 0>
__device__ __forceinline__ void post_norm_phase(CArgs* a, const float* xsrc, float* xdst, const bf16* Y, size_t yrow_off, const float* gvec_l  , const float* lng, const float* lnb,
                                                const float* modh  , bf16* H2, int row_lo, int nrows, int G, int c, int wave, int lane, int cbase, LAS unsigned char* lds) {
    unsigned char* ws = a->ws; unsigned* ctl = (unsigned*)(ws + WS_CTL); unsigned* route = (unsigned*)(ws + WS_ROUTE);
    const int rpb = nrows / G, rpw = rpb / NWAVES, rfirst = c * rpb + wave * rpw, bb = (row_lo + c * rpb) >> 11;
    LAS f32x4* Lg = (LAS f32x4*)lds; LAS f32x4* Llg = Lg + 256; LAS f32x4* Llb = Lg + 512; LAS f32x4* Lsh = Lg + 768; LAS f32x4* Lsc = Lg + 1024;
    { const int tid = wave * 64 + lane;
      for (int i = tid; i < 1280; i += 512) { const int wv = i >> 8, k = i & 255; f32x4 val;
          if (wv == 0) val = ((const GAS f32x4*)(gvec_l + (size_t)bb * 6144))[k]; else if (wv == 1) val = ((const GAS f32x4*)lng)[k]; else if (wv == 2) val = ((const GAS f32x4*)lnb)[k];
          else if (wv == 3) val = ((const GAS f32x4*)(modh + (size_t)bb * 6144))[k]; else val = ((const GAS f32x4*)(modh + (size_t)bb * 6144 + 1024))[k] + 1.f;
          Lg[i] = val; } }
    LAS f32x4* Lwr = Lg + 1280;
    if (ROUTE) { const int tid = wave * 64 + lane; const GAS f32x4* wsrc = (const GAS f32x4*)a->in[IN_MR]; for (int i = tid; i < 2048; i += 512) Lwr[i] = wsrc[i]; }
    __syncthreads();
    const int gw = rfirst, NGW = 1; (void)NGW;
    f32x4 nx[4]; unsigned long long ny[4], nxb[4];
    if (YMODE == 0 && rpw > 0) { const GAS f32x4* xr0 = (const GAS f32x4*)(xsrc + (size_t)(row_lo + gw) * D) + lane; const GAS unsigned long long* y0 = (const GAS unsigned long long*)(Y + ((size_t)(row_lo + gw) - yrow_off) * D) + lane;
        const GAS unsigned long long* xb0 = (const GAS unsigned long long*)((const bf16*)xsrc + (size_t)(row_lo + gw) * D) + lane;
#pragma unroll
        for (int j = 0; j < 4; ++j) { if (XS) nxb[j] = xb0[64 * j]; else nx[j] = xr0[64 * j]; ny[j] = y0[64 * j]; } }
    for (int r = gw; r < rfirst + rpw; ++r) { const int row = row_lo + r, b = row >> 11; (void)b;
        const GAS f32x4* xr = (const GAS f32x4*)(xsrc + (size_t)row * D) + lane;
        f32x4 v[4];
        if (YMODE == 0) {
#pragma unroll
            for (int j = 0; j < 4; ++j) { const unsigned long long yy = ny[j]; const unsigned lo = (unsigned)yy, hi = (unsigned)(yy >> 32);
                const f32x4 yv = {bflo(lo), bfhi(lo), bflo(hi), bfhi(hi)};
                f32x4 xv; if (XS) { const unsigned xl = (unsigned)nxb[j], xh = (unsigned)(nxb[j] >> 32); xv = (f32x4){bflo(xl), bfhi(xl), bflo(xh), bfhi(xh)}; } else xv = nx[j];
                v[j] = xv * ALPHA + Lg[lane + 64 * j] * yv; }
            if (r + 1 < rfirst + rpw) { const GAS f32x4* xr1 = (const GAS f32x4*)(xsrc + (size_t)(row + 1) * D) + lane; const GAS unsigned long long* y1 = (const GAS unsigned long long*)(Y + ((size_t)(row + 1) - yrow_off) * D) + lane;
                const GAS unsigned long long* xb1 = (const GAS unsigned long long*)((const bf16*)xsrc + (size_t)(row + 1) * D) + lane;
#pragma unroll
                for (int j = 0; j < 4; ++j) { if (XS) nxb[j] = xb1[64 * j]; else nx[j] = xr1[64 * j]; ny[j] = y1[64 * j]; } }
        } else {
            const unsigned* rt = route + (size_t)row * 8; const int ch = row / TCH;
            const unsigned e1 = rt[0], e2 = rt[1], s1 = rt[2], s2 = rt[3]; const float w1 = __uint_as_float(rt[4]), w2 = __uint_as_float(rt[5]);
            int off1 = 0, off2 = 0;
#pragma unroll
            for (int e = 0; e < NE; ++e) { const int cnt = (int)ctl[cbase + ch * 8 + e]; const int pad = (cnt + 255) & ~255; off1 += (e < (int)e1) ? pad : 0; off2 += (e < (int)e2) ? pad : 0; }
            const GAS unsigned long long* ya = (const GAS unsigned long long*)(Y + (size_t)(off1 + (int)s1) * D) + lane;
            const GAS unsigned long long* yb = (const GAS unsigned long long*)(Y + (size_t)(off2 + (int)s2) * D) + lane;
            unsigned long long yq1[KSPLIT][4], yq2[KSPLIT][4]; f32x4 xq[4];
#pragma unroll
            for (int kq = 0; kq < KSPLIT; ++kq)
#pragma unroll
                for (int j = 0; j < 4; ++j) { yq1[kq][j] = ya[64 * j + (size_t)kq * CH_ROWS * D / 4]; yq2[kq][j] = yb[64 * j + (size_t)kq * CH_ROWS * D / 4]; }
#pragma unroll
            for (int j = 0; j < 4; ++j) xq[j] = xr[64 * j];
            __builtin_amdgcn_sched_barrier(0);
#pragma unroll
            for (int j = 0; j < 4; ++j) { f32x4 s1v = {0.f, 0.f, 0.f, 0.f}, s2v = {0.f, 0.f, 0.f, 0.f};
#pragma unroll
                for (int kq = 0; kq < KSPLIT; ++kq) { const unsigned long long y1 = yq1[kq][j], y2 = yq2[kq][j];
                    const unsigned l1 = (unsigned)y1, h1 = (unsigned)(y1 >> 32), l2 = (unsigned)y2, h2 = (unsigned)(y2 >> 32);
                    s1v = s1v + (f32x4){bflo(l1), bfhi(l1), bflo(h1), bfhi(h1)}; s2v = s2v + (f32x4){bflo(l2), bfhi(l2), bflo(h2), bfhi(h2)}; }
                v[j] = xq[j] * ALPHA + Lg[lane + 64 * j] * (s1v * w1 + s2v * w2); }
        }
        float mean, rstd; ln_stats(v, mean, rstd, lane);
#pragma unroll
        for (int j = 0; j < 4; ++j) v[j] = (v[j] - mean) * rstd * Llg[lane + 64 * j] + Llb[lane + 64 * j];
        if (XD) store_bf16_row((bf16*)xdst + (size_t)row * D, v, lane);
        else { GAS f32x4* xo = (GAS f32x4*)(xdst + (size_t)row * D) + lane;
#pragma unroll
            for (int j = 0; j < 4; ++j) xo[64 * j] = v[j]; }
        if (WRITE_H2) {
            ln_stats(v, mean, rstd, lane);
#pragma unroll
            for (int j = 0; j < 4; ++j) v[j] = (v[j] - mean) * rstd * Lsc[lane + 64 * j] + Lsh[lane + 64 * j];
            store_bf16_row(H2 + (size_t)row * D, v, lane);
            if (ROUTE) {
                float lg[8];
#pragma unroll
                for (int e = 0; e < 8; ++e) lg[e] = 0.f;
#pragma unroll
                for (int j = 0; j < 4; ++j)
#pragma unroll
                    for (int q = 0; q < 4; ++q) { const int k = 4 * lane + 256 * j + q; const f32x4 wa = Lwr[2 * k], wb = Lwr[2 * k + 1]; const float hv = v[j][q];
                        lg[0] = fmaf(hv, wa.x, lg[0]); lg[1] = fmaf(hv, wa.y, lg[1]); lg[2] = fmaf(hv, wa.z, lg[2]); lg[3] = fmaf(hv, wa.w, lg[3]);
                        lg[4] = fmaf(hv, wb.x, lg[4]); lg[5] = fmaf(hv, wb.y, lg[5]); lg[6] = fmaf(hv, wb.z, lg[6]); lg[7] = fmaf(hv, wb.w, lg[7]); if (q == 3) asm volatile("" ::: "memory"); }
#pragma unroll
                for (int e = 0; e < 8; ++e) lg[e] = wave_sum(lg[e], lane);
                int e1 = 0; float v1 = lg[0];
#pragma unroll
                for (int e = 1; e < 8; ++e) if (lg[e] > v1) { v1 = lg[e]; e1 = e; }
                int e2 = -1; float v2 = -3.0e38f;
#pragma unroll
                for (int e = 0; e < 8; ++e) if (e != e1 && lg[e] > v2) { v2 = lg[e]; e2 = e; }
                if (e2 < 0) e2 = (e1 == 0) ? 1 : 0;
                const float p2 = __expf(v2 - v1), w1 = 1.f / (1.f + p2), w2 = p2 / (1.f + p2);
                if (lane == 0) { const int ch = row / TCH;
                    const unsigned s1 = atomicAdd(&ctl[cbase + ch * 8 + e1], 1u), s2 = atomicAdd(&ctl[cbase + ch * 8 + e2], 1u);
                    unsigned* rt = route + (size_t)row * 8; rt[0] = (unsigned)e1; rt[1] = (unsigned)e2; rt[2] = s1; rt[3] = s2; rt[4] = __float_as_uint(w1); rt[5] = __float_as_uint(w2); }
            }
        }
    }
    __syncthreads();
}
__device__ __forceinline__ void moe_sort_phase(CArgs* a, const bf16* H2, bf16* AS, int ch, int gw, int NGW, int lane, int cbase) {
    unsigned* ctl = (unsigned*)(a->ws + WS_CTL); const unsigned* route = (const unsigned*)(a->ws + WS_ROUTE);
    for (int r = gw; r < TCH; r += NGW) { const int row = ch * TCH + r;
        const unsigned* rt = route + (size_t)row * 8; const unsigned e1 = rt[0], e2 = rt[1], s1 = rt[2], s2 = rt[3];
        int off1 = 0, off2 = 0;
#pragma unroll
        for (int e = 0; e < NE; ++e) { const int cnt = (int)ctl[cbase + ch * 8 + e]; const int pad = (cnt + 255) & ~255; off1 += (e < (int)e1) ? pad : 0; off2 += (e < (int)e2) ? pad : 0; }
        const GAS v4u* src = (const GAS v4u*)(H2 + (size_t)row * D) + lane;
        const v4u x0 = src[0], x1 = src[64];
        GAS v4u* d1 = (GAS v4u*)(AS + (size_t)(off1 + (int)s1) * D) + lane; GAS v4u* d2 = (GAS v4u*)(AS + (size_t)(off2 + (int)s2) * D) + lane;
        d1[0] = x0; d1[64] = x1; d2[0] = x0; d2[64] = x1; }
}

typedef short bf16x8 __attribute__((ext_vector_type(8)));
typedef float f32x16 __attribute__((ext_vector_type(16)));
typedef __bf16 bf16x2_t __attribute__((ext_vector_type(2)));
typedef float f32x2_t __attribute__((ext_vector_type(2)));
#define MFMA32(a, b, c) __builtin_amdgcn_mfma_f32_32x32x16_bf16((a), (b), (c), 0, 0, 0)
#define KOFF(r) (((r) & 7) + 16 * ((r) >> 3))
#define PI32(i) (((i) & ~12) | (((i) & 4) << 1) | (((i) & 8) >> 1))
__device__ __forceinline__ unsigned cvtpk(float lo, float hi) { f32x2_t v = {lo, hi}; bf16x2_t b = __builtin_convertvector(v, bf16x2_t); return __builtin_bit_cast(unsigned, b); }
__device__ __forceinline__ float xhalf(float v, int xaddr) { return __int_as_float(__builtin_amdgcn_ds_bpermute(xaddr, __float_as_int(v))); }

constexpr int KV_ROWB = 144, KV_VOFF = 64 * KV_ROWB, KV_BUF = 2 * 64 * KV_ROWB;
struct Stage { v4u k, v; };
__device__ __forceinline__ void stage_load(Stage& st, int tid, const bf16* Kb, size_t kstride, const bf16* Vt, int vstride, int k0) {
    const int row = tid >> 3, c = tid & 7;
    st.k = *(const GAS v4u*)(Kb + (size_t)(k0 + row) * kstride + c * 8);
    st.v = *(const GAS v4u*)(Vt + (size_t)row * vstride + k0 + c * 8);
}
__device__ __forceinline__ void stage_store(const Stage& st, int tid, LAS unsigned char* buf) {
    const int row = tid >> 3, c = tid & 7;
    *(LAS v4u*)(buf + row * KV_ROWB + c * 16) = st.k; *(LAS v4u*)(buf + KV_VOFF + row * KV_ROWB + c * 16) = st.v;
}
struct KVFrag { bf16x8 k[4]; bf16x8 v[4]; };
__device__ __forceinline__ void frag_read(KVFrag& f, const LAS unsigned char* buf, int sub, int ql, int h2) {
    const LAS unsigned char* kp = buf + (32 * sub + PI32(ql)) * KV_ROWB + 16 * h2;
#pragma unroll
    for (int s = 0; s < 4; ++s) f.k[s] = *(const LAS bf16x8*)(kp + 32 * s);
    const LAS unsigned char* vp = buf + KV_VOFF + ql * KV_ROWB + 64 * sub + 16 * h2;
#pragma unroll
    for (int dt = 0; dt < 2; ++dt)
#pragma unroll
        for (int s2 = 0; s2 < 2; ++s2) f.v[dt * 2 + s2] = *(const LAS bf16x8*)(vp + dt * 32 * KV_ROWB + 32 * s2);
}
__device__ __forceinline__ void load_qfrag(bf16x8 (&q)[4], const bf16* qrow, int h2) {
#pragma unroll
    for (int s = 0; s < 4; ++s) q[s] = *(const GAS bf16x8*)(qrow + 16 * s + 8 * h2);
}
__device__ __forceinline__ f32x16 zero16() { f32x16 z;
#pragma unroll
    for (int i = 0; i < 16; ++i) z[i] = 0.f;
    return z; }
__device__ __forceinline__ f32x16 qk_tile(const bf16x8 (&q)[4], const bf16x8 (&k)[4]) {
    f32x16 S = zero16();
#pragma unroll
    for (int s = 0; s < 4; ++s) S = MFMA32(k[s], q[s], S);
    return S;
}
__device__ __forceinline__ void pv_tile(f32x16& O0, f32x16& O1, const float (&p)[16], const bf16x8 (&v)[4]) {
    v4u w0, w1;
    w0.x = cvtpk(p[0], p[1]); w0.y = cvtpk(p[2], p[3]); w0.z = cvtpk(p[4], p[5]); w0.w = cvtpk(p[6], p[7]);
    w1.x = cvtpk(p[8], p[9]); w1.y = cvtpk(p[10], p[11]); w1.z = cvtpk(p[12], p[13]); w1.w = cvtpk(p[14], p[15]);
    const bf16x8 p0 = __builtin_bit_cast(bf16x8, w0), p1 = __builtin_bit_cast(bf16x8, w1);
    O0 = MFMA32(v[0], p0, O0); O0 = MFMA32(v[1], p1, O0);
    O1 = MFMA32(v[2], p0, O1); O1 = MFMA32(v[3], p1, O1);
}
struct AttnAcc { float m, l; f32x16 O0, O1; };
__device__ __forceinline__ void acc_init(AttnAcc& A) { A.m = -1e30f; A.l = 0.f; A.O0 = zero16(); A.O1 = zero16(); }
__device__ __forceinline__ void sm_update(AttnAcc& A, const float (&t)[16], const bf16x8 (&v)[4], int xaddr) {
    float mx = t[0];
#pragma unroll
    for (int r = 1; r < 16; ++r) mx = fmaxf(mx, t[r]);
    mx = fmaxf(mx, xhalf(mx, xaddr));
    const float mnew = fmaxf(A.m, mx);
    if (__any(mnew > A.m)) { const float corr = __expf(A.m - mnew); A.l *= corr; A.O0 = A.O0 * corr; A.O1 = A.O1 * corr; A.m = mnew; }
    float p[16]; float ls = 0.f;
#pragma unroll
    for (int r = 0; r < 16; ++r) { p[r] = (t[r] > -1e29f) ? __expf(t[r] - A.m) : 0.f; ls += p[r]; }
    A.l += ls;
    pv_tile(A.O0, A.O1, p, v);
}
__device__ __forceinline__ void store_ot(bf16* orow, const f32x16& O0, const f32x16& O1, float scale, int h2) {
#pragma unroll
    for (int g = 0; g < 4; ++g) {
        unsigned long long a = (unsigned long long)cvtpk(O0[4 * g] * scale, O0[4 * g + 1] * scale) | ((unsigned long long)cvtpk(O0[4 * g + 2] * scale, O0[4 * g + 3] * scale) << 32);
        unsigned long long b = (unsigned long long)cvtpk(O1[4 * g] * scale, O1[4 * g + 1] * scale) | ((unsigned long long)cvtpk(O1[4 * g + 2] * scale, O1[4 * g + 3] * scale) << 32);
        *(GAS unsigned long long*)(orow + 8 * g + 4 * h2) = a; *(GAS unsigned long long*)(orow + 32 + 8 * g + 4 * h2) = b; }
}
__device__ __forceinline__ void band_subtile(AttnAcc& A, const bf16x8 (&q)[4], const KVFrag& f, int qpos, int k0, int nback, const LAS float* tab, int h2, int xaddr) {
    const f32x16 S = qk_tile(q, f.k);
    const int base = qpos - k0 - 8 * h2;
    float t[16];
#pragma unroll
    for (int r = 0; r < 16; ++r) { const int dd = base - KOFF(r); const float bv = tab[dd]; t[r] = (dd >= 0 && dd <= nback) ? S[r] * 0.125f + bv : -1e30f; }
    sm_update(A, t, f.v, xaddr);
}
__device__ __forceinline__ void band_block(AttnAcc& A, const bf16x8 (&q)[4], LAS unsigned char* kvbuf, int tid, const bf16* Kb, size_t kstride, const bf16* Vt, int vstride,
                                           int q0w, int nback, int kmin, int kmax, const LAS float* tab, int ql, int h2, int xaddr) {
    Stage st; stage_load(st, tid, Kb, kstride, Vt, vstride, kmin); stage_store(st, tid, kvbuf); __syncthreads();
    const int klo = (q0w - nback) & ~31;
    int par = 0;
    for (int k0 = kmin; k0 <= kmax; k0 += 64, par ^= 1) {
        const bool more = k0 + 64 <= kmax;
        if (more) stage_load(st, tid, Kb, kstride, Vt, vstride, k0 + 64);
        const LAS unsigned char* buf = kvbuf + par * KV_BUF;
#pragma unroll
        for (int sub = 0; sub < 2; ++sub) { const int ks = k0 + 32 * sub;
            if (ks >= klo && ks <= q0w) { KVFrag f; frag_read(f, buf, sub, ql, h2); band_subtile(A, q, f, q0w + ql, ks, nback, tab, h2, xaddr); } }
        if (more) stage_store(st, tid, kvbuf + (par ^ 1) * KV_BUF);
        __syncthreads();
    }
}

constexpr int L_BLKA = 2 * KV_BUF + 2048, L_BLKB = L_BLKA + 32768, L_SCK = L_BLKA, L_MASK = L_BLKB + 32768, L_BT = L_MASK + 512, BT_STRIDE = 2176;
static_assert(L_BT + 4 * BT_STRIDE * 4 <= MISC_OFF, "NSA LDS map");
__device__ __forceinline__ void nsa_tables(CArgs* a, LAS unsigned char* lds, int wave) {
    const float* biasT = (const float*)(a->ws + WS_BIAS); LAS float* BT = (LAS float*)(lds + L_BT);
    const int lane = lane_id_l(), tid = wave * 64 + lane;
    for (int i = tid; i < 4 * BT_STRIDE; i += 512) { const int hh = i / BT_STRIDE, e = i - hh * BT_STRIDE; int dist = e - 64; dist = dist < 0 ? 0 : (dist > 2047 ? 2047 : dist); BT[i] = biasT[hh * 2048 + dist]; }
}
__device__ __forceinline__ void nsa_unit(CArgs* a, LAS unsigned char* lds, const int wave, const int b, const int tile, const int lane, const int tid, const int ql, const int h2, const int xaddr) {
    unsigned char* ws = a->ws; const bf16* QKV = (const bf16*)(ws + A_QKV); bf16* O4 = (bf16*)(ws + A_O4);
    const float* NG = (const float*)(ws + WS_NG); const bf16* KCB = (const bf16*)(ws + WS_KC); const bf16* VCT = KCB + (size_t)BH * 128 * 64;
    const int h = wave & 3, qh = wave >> 2;
    LAS float* BLKA = (LAS float*)(lds + L_BLKA); LAS float* BLKB = (LAS float*)(lds + L_BLKB);
    LAS unsigned* SCK = (LAS unsigned*)(lds + L_SCK); LAS unsigned* MASK = (LAS unsigned*)(lds + L_MASK);
    LAS float* BT = (LAS float*)(lds + L_BT);
        const int t0 = tile * 64, qpos0 = t0 + 32 * qh, qpos = qpos0 + ql; const size_t rowb = (size_t)b * SEQ, row = rowb + qpos;
        const int qi = 32 * qh + ql;
        bf16x8 q[4]; load_qfrag(q, QKV + (HT_NSAQ + h) * HT_ELEMS + row * 64, h2);
        const float g0 = sigm(NG[row * 16 + h * 3 + 0]), g1 = sigm(NG[row * 16 + h * 3 + 1]), g2 = sigm(NG[row * 16 + h * 3 + 2]);
        f32x16 T0, T1;
        {
            const bf16* Kb = KCB + (size_t)b * 128 * 64; const bf16* Vt = VCT + (size_t)b * 64 * 128;
            Stage s0, s1; stage_load(s0, tid, Kb, 64, Vt, 128, 0); stage_load(s1, tid, Kb, 64, Vt, 128, 64);
            stage_store(s0, tid, lds); stage_store(s1, tid, lds + KV_BUF);
            __syncthreads();
            const int imax = (qpos >= 31) ? ((qpos - 31) >> 4) : -1;
            const int ntile = (min(qpos0 >> 4, 126) >> 5) + 1;
            float m = -1e30f, l = 0.f;
            for (int kt = 0; kt < ntile; ++kt) { KVFrag f; frag_read(f, lds + (kt >> 1) * KV_BUF, kt & 1, ql, h2);
                const f32x16 S = qk_tile(q, f.k); float mx = -1e30f; float t[16];
#pragma unroll
                for (int r = 0; r < 16; ++r) { const int i = kt * 32 + KOFF(r) + 8 * h2; t[r] = (i <= imax) ? S[r] * 0.125f : -1e30f; mx = fmaxf(mx, t[r]); }
                mx = fmaxf(mx, xhalf(mx, xaddr)); const float mn = fmaxf(m, mx); l *= __expf(m - mn); m = mn;
#pragma unroll
                for (int r = 0; r < 16; ++r) l += (t[r] > -1e29f) ? __expf(t[r] - m) : 0.f; }
            l += xhalf(l, xaddr);
            const float inv = 1.f / fmaxf(l, 1e-30f);
            f32x16 C0 = zero16(), C1 = zero16();
            for (int kt = 0; kt < 4; ++kt) {
                float p[16];
                if (kt < ntile) { KVFrag f; frag_read(f, lds + (kt >> 1) * KV_BUF, kt & 1, ql, h2);
                    const f32x16 S = qk_tile(q, f.k);
#pragma unroll
                    for (int r = 0; r < 16; ++r) { const int i = kt * 32 + KOFF(r) + 8 * h2; p[r] = (i <= imax) ? __expf(S[r] * 0.125f - m) * inv : 0.f; }
                    pv_tile(C0, C1, p, f.v);
                } else {
#pragma unroll
                    for (int r = 0; r < 16; ++r) p[r] = 0.f;
                }
#pragma unroll
                for (int gq = 0; gq < 4; ++gq) { const int j = (32 * kt + KOFF(4 * gq) + 8 * h2) >> 2;
                    BLKA[(h * 32 + j) * 64 + qi] = (p[4 * gq] + p[4 * gq + 1]) + (p[4 * gq + 2] + p[4 * gq + 3]);
                    if (j + 1 < 32) BLKB[(h * 32 + j + 1) * 64 + qi] = p[4 * gq + 3]; }
            }
            if (h2 == 0) BLKB[(h * 32 + 0) * 64 + qi] = 0.f;
            T0 = C0 * g0; T1 = C1 * g0;
        }
        __syncthreads();
        float ssc[4];
        {
            const int sq = tid >> 3, jg = tid & 7;
#pragma unroll
            for (int jj = 0; jj < 4; ++jj) { const int j = jg * 4 + jj; float s = 0.f;
#pragma unroll
                for (int hh = 0; hh < 4; ++hh) s += BLKA[(hh * 32 + j) * 64 + sq] + BLKB[(hh * 32 + j) * 64 + sq];
                if (j == 0 || j == tile || j == tile - 1) s = 1e4f; else if (j > tile) s = -1e30f;
                ssc[jj] = s; }
        }
        __syncthreads();
        {
            const int sq = tid >> 3, jg = tid & 7;
#pragma unroll
            for (int jj = 0; jj < 4; ++jj) { const int j = jg * 4 + jj; const unsigned ub = __float_as_uint(ssc[jj]); const unsigned ord = (ub & 0x80000000u) ? ~ub : (ub | 0x80000000u);
                SCK[sq * 33 + j] = (ord & ~31u) | (unsigned)(31 - j); }
            if (tid == 0) MASK[64] = 0u;
        }
        __syncthreads();
        {
            const int sq = tid >> 3, jg = tid & 7; unsigned bits = 0u;
            const unsigned k0 = SCK[sq * 33 + jg * 4 + 0], k1 = SCK[sq * 33 + jg * 4 + 1], k2 = SCK[sq * 33 + jg * 4 + 2], k3 = SCK[sq * 33 + jg * 4 + 3];
            int r0 = 0, r1 = 0, r2 = 0, r3 = 0;
#pragma unroll 1
            for (int j2 = 0; j2 < 32; ++j2) { const unsigned kk = SCK[sq * 33 + j2]; r0 += (kk > k0) ? 1 : 0; r1 += (kk > k1) ? 1 : 0; r2 += (kk > k2) ? 1 : 0; r3 += (kk > k3) ? 1 : 0; }
            bits = ((r0 < 16) ? 1u : 0u) | ((r1 < 16) ? 2u : 0u) | ((r2 < 16) ? 4u : 0u) | ((r3 < 16) ? 8u : 0u);
            bits <<= (jg * 4);
            bits |= shfl_xor_u(bits, 1, lane); bits |= shfl_xor_u(bits, 2, lane); bits |= shfl_xor_u(bits, 4, lane);
            if (jg == 0) { MASK[sq] = bits; atomicOr((unsigned*)&MASK[64], bits); }
        }
        __syncthreads();
        {
            const unsigned msk = MASK[qi]; unsigned un = MASK[64] & ((tile >= 31) ? 0xffffffffu : ((2u << tile) - 1u));
            const bf16* Kb = QKV + (size_t)HT_KSEL * HT_ELEMS + rowb * 64; const bf16* Vt = QKV + (size_t)HT_VSEL * HT_ELEMS + (size_t)b * 64 * SEQ;
            const LAS float* tab = BT + h * BT_STRIDE + 64;
            AttnAcc A; acc_init(A);
            int j = __builtin_ctz(un); un &= un - 1;
            Stage st; stage_load(st, tid, Kb, 64, Vt, SEQ, 64 * j); stage_store(st, tid, lds); __syncthreads();
            int par = 0;
            for (;;) {
                const bool more = un != 0u; const int jn = more ? __builtin_ctz(un) : 0; un &= un - 1;
                if (more) stage_load(st, tid, Kb, 64, Vt, SEQ, 64 * jn);
                const LAS unsigned char* buf = lds + par * KV_BUF;
                const bool selj = (msk >> j) & 1u;
                if (__any(selj)) {
#pragma unroll
                    for (int sub = 0; sub < 2; ++sub) { const int ks = 64 * j + 32 * sub;
                        if (ks <= qpos0) { KVFrag f; frag_read(f, buf, sub, ql, h2);
                            const f32x16 S = qk_tile(q, f.k);
                            const int base = qpos - ks - 8 * h2;
                            float t[16];
#pragma unroll
                            for (int r = 0; r < 16; ++r) { const int dd = base - KOFF(r); const float bv = tab[dd]; t[r] = (selj && dd >= 0) ? S[r] * 0.125f + bv : -1e30f; }
                            sm_update(A, t, f.v, xaddr); } }
                }
                if (more) stage_store(st, tid, lds + (par ^ 1) * KV_BUF);
                __syncthreads();
                if (!more) break;
                j = jn; par ^= 1;
            }
            const float lt = A.l + xhalf(A.l, xaddr); const float sc = g1 / lt;
            T0 = T0 + A.O0 * sc; T1 = T1 + A.O1 * sc;
        }
        {
            AttnAcc A; acc_init(A);
            int kmin = (t0 - 511) & ~63; if (kmin < 0) kmin = 0;
            band_block(A, q, lds, tid, QKV + (size_t)HT_KWIN * HT_ELEMS + rowb * 64, 64, QKV + (size_t)HT_VWIN * HT_ELEMS + (size_t)b * 64 * SEQ, SEQ, qpos0, 511, kmin, t0, BT + h * BT_STRIDE + 64, ql, h2, xaddr);
            const float lt = A.l + xhalf(A.l, xaddr); const float sc = g2 / lt;
            T0 = T0 + A.O0 * sc; T1 = T1 + A.O1 * sc;
        }
        store_ot(O4 + row * 1024 + 0 * 256 + h * 64, T0, T1, 1.f, h2);
        __syncthreads();
}

constexpr size_t DILO_OFF = 0, DILL_OFF = (size_t)3 * TH * 256 * 2;
constexpr int U_SB = BH * 4 * 8, U_NSA = BH * 32, U_DIL = 3 * BH * 4 * 8, U_SWA = BH * 4 * 8, U_CMP = BH, U_ALL = U_CMP + U_SB + U_NSA + U_DIL + U_SWA;
constexpr int LQ_OFF = 2 * KV_BUF, LTAB_OFF = LQ_OFF + 64;
__device__ __forceinline__ void attn_queue_phase(CArgs* a, int layer, int inst, LAS unsigned char* lds, int wave) {
    unsigned char* ws = a->ws; const bf16* QKV = (const bf16*)(ws + A_QKV); bf16* O4 = (bf16*)(ws + A_O4); const float* biasT = (const float*)(ws + WS_BIAS);
    bf16* DILO = (bf16*)(ws + A_DIL + DILO_OFF); float* DILL = (float*)(ws + A_DIL + DILL_OFF);
    unsigned* qctr = (unsigned*)(ws + WS_CTL) + CW_QUEUE + inst * 64;
    LAS unsigned* LQ = (LAS unsigned*)(lds + LQ_OFF); LAS float* tabw = (LAS float*)(lds + LTAB_OFF);
    unsigned* cflag = (unsigned*)(ws + WS_CTL) + CW_CMPF + inst * 64;
    nsa_tables(a, lds, wave);
    if (wave == 0 && lane_id_l() == 0) LQ[0] = atomicAdd(qctr, 1u);
    __syncthreads();
    for (;;) {
        const int lane = lane_id_l(), tid = wave * 64 + lane, ql = lane & 31, h2 = lane >> 5, xaddr = (lane ^ 32) << 2;
        const int u = (int)LQ[0];
        __syncthreads();
        if (u >= U_ALL) break;
        unsigned nxt_u = 0u; if (tid == 0) nxt_u = atomicAdd(qctr, 1u);
        const int uu = u - U_CMP;
        if (uu >= 0 && uu < U_SB) {
            const int bh = uu % (4 * BH), h = bh & 3, b = bh >> 2, Qb = 7 - uu / (4 * BH);
            const int q0w = Qb * 256 + 32 * wave; const size_t rowb = (size_t)b * SEQ;
            bf16x8 q[4]; load_qfrag(q, QKV + (HT_SBQ + h) * HT_ELEMS + (rowb + q0w + ql) * 64, h2);
            const bf16* Kb = QKV + (HT_SBK + h) * HT_ELEMS + rowb * 64;
            const bf16* Vt = QKV + (HT_SBV + h) * HT_ELEMS + (size_t)b * 64 * SEQ;
            f32x16 O0 = zero16(), O1 = zero16(); float R = 0.f;
            const int ktop = Qb * 256 + 192;
            Stage st; stage_load(st, tid, Kb, 64, Vt, SEQ, ktop); stage_store(st, tid, lds); __syncthreads();
            int par = 0;
            for (int k0 = ktop; k0 >= 0; k0 -= 64, par ^= 1) {
                const bool more = k0 >= 64;
                if (more) stage_load(st, tid, Kb, 64, Vt, SEQ, k0 - 64);
                const LAS unsigned char* buf = lds + par * KV_BUF;
#pragma unroll
                for (int sub = 1; sub >= 0; --sub) { const int ks = k0 + 32 * sub;
                    if (ks <= q0w) { KVFrag f; frag_read(f, buf, sub, ql, h2);
                        const f32x16 S = qk_tile(q, f.k);
                        float ls[16], lf[16];
                        if (ks == q0w) {
                            const int base = ql - 8 * h2;
#pragma unroll
                            for (int r = 0; r < 16; ++r) { const float z2 = S[r] * (0.125f * 1.4426950408889634f); const bool valid = (base - KOFF(r)) >= 1;
                                const float L2 = __builtin_amdgcn_logf(1.f + __builtin_amdgcn_exp2f(-fabsf(z2)));
                                ls[r] = valid ? fminf(z2, 0.f) - L2 : -1e30f; lf[r] = valid ? -fmaxf(z2, 0.f) - L2 : 0.f; }
                        } else {
#pragma unroll
                            for (int r = 0; r < 16; ++r) { const float z2 = S[r] * (0.125f * 1.4426950408889634f);
                                const float L2 = __builtin_amdgcn_logf(1.f + __builtin_amdgcn_exp2f(-fabsf(z2)));
                                ls[r] = fminf(z2, 0.f) - L2; lf[r] = -fmaxf(z2, 0.f) - L2; }
                        }
                        float G0 = 0.f, G1 = 0.f;
#pragma unroll
                        for (int r = 0; r < 8; ++r) { G0 += lf[r]; G1 += lf[8 + r]; }
                        const float P0 = xhalf(G0, xaddr), P1 = xhalf(G1, xaddr);
                        const float aft0 = (h2 == 0) ? (P0 + G1 + P1) : (P1 + G1), aft1 = (h2 == 0) ? P1 : 0.f;
                        float p[16]; float w = aft0 + R;
#pragma unroll
                        for (int r = 7; r >= 0; --r) { p[r] = __builtin_amdgcn_exp2f(ls[r] + w); w += lf[r]; }
                        w = aft1 + R;
#pragma unroll
                        for (int r = 15; r >= 8; --r) { p[r] = __builtin_amdgcn_exp2f(ls[r] + w); w += lf[r]; }
                        R += (G0 + P0) + (G1 + P1);
                        pv_tile(O0, O1, p, f.v); } }
                if (more) stage_store(st, tid, lds + (par ^ 1) * KV_BUF);
                __syncthreads();
            }
            store_ot(O4 + (rowb + q0w + ql) * 1024 + 3 * 256 + h * 64, O0, O1, 1.f, h2);
        } else if (uu >= U_SB && uu < U_SB + U_NSA) {
            const int un = uu - U_SB, b = un % BH, tile = 31 - un / BH;
            if (tid == 0) { unsigned sp = 0;
                while (__hip_atomic_load(cflag + b, __ATOMIC_RELAXED, __HIP_MEMORY_SCOPE_AGENT) == 0u) { __builtin_amdgcn_s_sleep(2); if (++sp > (1u << 22)) break; }
                __builtin_amdgcn_fence(__ATOMIC_ACQUIRE, "agent"); asm volatile("s_waitcnt vmcnt(0)" ::: "memory"); }
            __syncthreads();
            nsa_unit(a, lds, wave, b, tile, lane, tid, ql, h2, xaddr);
        } else if (uu >= U_SB + U_NSA && uu < U_SB + U_NSA + U_DIL) {
            const int r0 = uu - U_SB - U_NSA; const int h = r0 & 3, b = (r0 >> 2) % BH, pb = (r0 / (4 * BH)) & 7, g = r0 / (32 * BH);
            const int dil = (g == 0) ? 1 : (g == 1) ? 4 : 16, L = SEQ / dil;
            const int p0 = pb * 256 + 32 * wave, res = p0 / L, i0 = p0 - res * L;
            const size_t rowb = (size_t)b * SEQ;
            const float* bsrc = biasT + (8 + g * 4 + h) * 2048;
            for (int e = tid; e < 320; e += 512) { const int dd = e - 32; int dist = dd * dil; dist = dist < 0 ? 0 : (dist > 2047 ? 2047 : dist); tabw[e] = bsrc[dist]; }
            const int tq = (i0 + ql) * dil + res;
            bf16x8 q[4]; load_qfrag(q, QKV + (HT_DILQ + g * 4 + h) * HT_ELEMS + (rowb + tq) * 64, h2);
            const int vslot = (g == 0) ? (HT_DILV + h) : (50 + h * 2 + (g - 1));
            AttnAcc A; acc_init(A);
            if (L >= 256) {
                const int res_b = (pb * 256) / L, ib = pb * 256 - res_b * L;
                const bf16* Kb = QKV + (HT_DILK + h) * HT_ELEMS + (rowb + res_b) * 64; const bf16* Vt = QKV + (size_t)vslot * HT_ELEMS + (size_t)b * 64 * SEQ + res_b * L;
                int kmin = (ib - 128) & ~63; if (kmin < 0) kmin = 0;
                band_block(A, q, lds, tid, Kb, (size_t)dil * 64, Vt, SEQ, i0, 128, kmin, ib + 192, tabw + 32, ql, h2, xaddr);
            } else {
#pragma unroll 1
                for (int half = 0; half < 2; ++half) { const int res_b = 2 * pb + half;
                    const bf16* Kb = QKV + (HT_DILK + h) * HT_ELEMS + (rowb + res_b) * 64; const bf16* Vt = QKV + (size_t)vslot * HT_ELEMS + (size_t)b * 64 * SEQ + res_b * L;
                    const bool mine = (wave >> 2) == half;
                    band_block(A, q, lds, tid, Kb, (size_t)dil * 64, Vt, SEQ, mine ? i0 : -4096, 128, 0, 64, tabw + 32, ql, h2, xaddr); }
            }
            const float lt = A.l + xhalf(A.l, xaddr);
            store_ot(DILO + ((size_t)g * TH + rowb + tq) * 256 + h * 64, A.O0, A.O1, 1.f / lt, h2);
            if (h2 == 0) DILL[((size_t)g * TH + rowb + tq) * 4 + h] = A.m + __logf(lt);
        } else if (uu >= U_SB + U_NSA + U_DIL) {
            const int r0 = uu - U_SB - U_NSA - U_DIL; const int h = r0 & 3, b = (r0 >> 2) % BH, Qb = r0 / (4 * BH);
            const int q0w = Qb * 256 + 32 * wave; const size_t rowb = (size_t)b * SEQ;
            const float* bsrc = biasT + (4 + h) * 2048;
            for (int e = tid; e < 320; e += 512) { int dist = e - 32; dist = dist < 0 ? 0 : dist; tabw[e] = bsrc[dist]; }
            bf16x8 q[4]; load_qfrag(q, QKV + (HT_SWAQ + h) * HT_ELEMS + (rowb + q0w + ql) * 64, h2);
            AttnAcc A; acc_init(A);
            int kmin = (Qb * 256 - 127) & ~63; if (kmin < 0) kmin = 0;
            band_block(A, q, lds, tid, QKV + (HT_SWAK + (h >> 1)) * HT_ELEMS + rowb * 64, 64, QKV + (HT_SWAV + (h >> 1)) * HT_ELEMS + (size_t)b * 64 * SEQ, SEQ, q0w, 127, kmin, Qb * 256 + 192, tabw + 32, ql, h2, xaddr);
            const float lt = A.l + xhalf(A.l, xaddr);
            const float sk = a->in[IN_SINK][layer * 4 + h]; const float mf = fmaxf(A.m, sk); const float c0 = __expf(A.m - mf); const float den = lt * c0 + __expf(sk - mf);
            store_ot(O4 + (rowb + q0w + ql) * 1024 + 1 * 256 + h * 64, A.O0, A.O1, c0 / den, h2);
        } else {
            const int it = u * 8 + wave; const int rt = it & 3, which = (it >> 2) & 1, b = it >> 3;
            bf16* kcb = (bf16*)(ws + WS_KC); bf16* vct = kcb + (size_t)BH * 128 * 64;
            const int i = rt * 32 + ql, ic = i > 126 ? 126 : i;
            const bf16* src = QKV + (HT_KCMP + which) * HT_ELEMS + ((size_t)b * SEQ + 16 * ic) * 64;
            const float* pe = a->in[IN_CPE] + ((size_t)layer * 2 + which) * 32 * 64;
            const bf16* w1t = (const bf16*)(ws + WS_C1) + ((size_t)layer * 2 + which) * 64 * 2048 + (size_t)ql * 2048;
            f32x16 H0 = zero16(), H1 = zero16();
#pragma unroll 1
            for (int ks0 = 0; ks0 < 128; ks0 += 4) {
                v4u xa[4]; f32x4 pa[4], pb2[4]; bf16x8 a0[4], a1[4];
#pragma unroll
                for (int e = 0; e < 4; ++e) { const int k = 16 * (ks0 + e) + 8 * h2;
                    xa[e] = *(const GAS v4u*)(src + k); pa[e] = *(const GAS f32x4*)(pe + k); pb2[e] = *(const GAS f32x4*)(pe + k + 4);
                    a0[e] = *(const GAS bf16x8*)(w1t + k); a1[e] = *(const GAS bf16x8*)(w1t + 32 * 2048 + k); }
                __builtin_amdgcn_sched_barrier(0);
#pragma unroll
                for (int e = 0; e < 4; ++e) {
                    v4u xb; xb.x = cvtpk(bflo(xa[e].x) + pa[e].x, bfhi(xa[e].x) + pa[e].y); xb.y = cvtpk(bflo(xa[e].y) + pa[e].z, bfhi(xa[e].y) + pa[e].w);
                    xb.z = cvtpk(bflo(xa[e].z) + pb2[e].x, bfhi(xa[e].z) + pb2[e].y); xb.w = cvtpk(bflo(xa[e].w) + pb2[e].z, bfhi(xa[e].w) + pb2[e].w);
                    const bf16x8 bfr = __builtin_bit_cast(bf16x8, xb);
                    H0 = MFMA32(a0[e], bfr, H0); H1 = MFMA32(a1[e], bfr, H1); }
            }
            float g[32];
#pragma unroll
            for (int r = 0; r < 16; ++r) { const float x0 = H0[r], x1 = H1[r];
                g[r] = 0.5f * x0 * (1.f + tanhf(0.7978845608028654f * (x0 + 0.044715f * x0 * x0 * x0))); g[16 + r] = 0.5f * x1 * (1.f + tanhf(0.7978845608028654f * (x1 + 0.044715f * x1 * x1 * x1))); }
            const float* w2 = a->in[IN_CW2] + ((size_t)layer * 2 + which) * 64 * 64;
            f32x16 E0 = zero16(), E1 = zero16();
#pragma unroll
            for (int s = 0; s < 4; ++s) { v4u gw_; gw_.x = cvtpk(g[8 * s], g[8 * s + 1]); gw_.y = cvtpk(g[8 * s + 2], g[8 * s + 3]); gw_.z = cvtpk(g[8 * s + 4], g[8 * s + 5]); gw_.w = cvtpk(g[8 * s + 6], g[8 * s + 7]);
                const bf16x8 gb = __builtin_bit_cast(bf16x8, gw_);
                float wa[8], wb[8];
#pragma unroll
                for (int j = 0; j < 8; ++j) { const int n = 16 * s + 8 * (j >> 2) + 4 * h2 + (j & 3); wa[j] = w2[(size_t)n * 64 + ql]; wb[j] = w2[(size_t)n * 64 + 32 + ql]; }
                v4u ua, ub; ua.x = cvtpk(wa[0], wa[1]); ua.y = cvtpk(wa[2], wa[3]); ua.z = cvtpk(wa[4], wa[5]); ua.w = cvtpk(wa[6], wa[7]);
                ub.x = cvtpk(wb[0], wb[1]); ub.y = cvtpk(wb[2], wb[3]); ub.z = cvtpk(wb[4], wb[5]); ub.w = cvtpk(wb[6], wb[7]);
                E0 = MFMA32(__builtin_bit_cast(bf16x8, ua), gb, E0); E1 = MFMA32(__builtin_bit_cast(bf16x8, ub), gb, E1); }
            const float zs = (i > 126) ? 0.f : 1.f;
            if (which == 0) store_ot(kcb + ((size_t)b * 128 + i) * 64, E0, E1, zs, h2);
            else {
#pragma unroll
                for (int r = 0; r < 16; ++r) { const int m = (r & 3) + 8 * (r >> 2) + 4 * h2;
                    vct[((size_t)b * 64 + m) * 128 + i] = (bf16)f2bf(E0[r] * zs); vct[((size_t)b * 64 + 32 + m) * 128 + i] = (bf16)f2bf(E1[r] * zs); } }
        }
        if (u < U_CMP) {
            asm volatile("s_waitcnt vmcnt(0)" ::: "memory"); __syncthreads();
            if (tid == 0) { __builtin_amdgcn_fence(__ATOMIC_RELEASE, "agent"); asm volatile("s_waitcnt vmcnt(0)" ::: "memory"); __hip_atomic_store(cflag + u, 1u, __ATOMIC_RELAXED, __HIP_MEMORY_SCOPE_AGENT); } }
        if (tid == 0) LQ[0] = nxt_u;
        __syncthreads();
    }
}


__device__ __forceinline__ void dil_merge_phase(CArgs* a, int G, int c, const int wave) {
    unsigned char* ws = a->ws; bf16* O4 = (bf16*)(ws + A_O4);
    {
        const bf16* DILO = (const bf16*)(ws + A_DIL + DILO_OFF); const float* DILL = (const float*)(ws + A_DIL + DILL_OFF);
        const int lane = lane_id_l(), gw = c * NWAVES + wave, NGW = G * NWAVES, hh = lane >> 4;
        for (int r = gw; r < TH; r += NGW) {
            const float l0 = DILL[((size_t)0 * TH + r) * 4 + hh], l1 = DILL[((size_t)1 * TH + r) * 4 + hh], l2 = DILL[((size_t)2 * TH + r) * 4 + hh];
            const float mx = fmaxf(l0, fmaxf(l1, l2)); const float e0 = __expf(l0 - mx), e1 = __expf(l1 - mx), e2 = __expf(l2 - mx); const float inv = 1.f / (e0 + e1 + e2);
            const unsigned long long y0 = *((const GAS unsigned long long*)(DILO + ((size_t)0 * TH + r) * 256) + lane), y1 = *((const GAS unsigned long long*)(DILO + ((size_t)1 * TH + r) * 256) + lane),
                                     y2 = *((const GAS unsigned long long*)(DILO + ((size_t)2 * TH + r) * 256) + lane);
            const float w0 = e0 * inv, w1 = e1 * inv, w2 = e2 * inv;
            const unsigned a0 = (unsigned)y0, b0 = (unsigned)(y0 >> 32), a1 = (unsigned)y1, b1 = (unsigned)(y1 >> 32), a2 = (unsigned)y2, b2 = (unsigned)(y2 >> 32);
            const unsigned o_lo = pk2(w0 * bflo(a0) + w1 * bflo(a1) + w2 * bflo(a2), w0 * bfhi(a0) + w1 * bfhi(a1) + w2 * bfhi(a2));
            const unsigned o_hi = pk2(w0 * bflo(b0) + w1 * bflo(b1) + w2 * bflo(b2), w0 * bfhi(b0) + w1 * bfhi(b1) + w2 * bfhi(b2));
            *((GAS unsigned long long*)(O4 + (size_t)r * 1024 + 2 * 256) + lane) = (unsigned long long)o_lo | ((unsigned long long)o_hi << 32);
        }
    }
}

#ifndef PROBE_REP
#define PROBE_REP 0
#endif
#define NREP(k) ((PROBE_REP == (k) || (PROBE_REP == 20 && (k) == 20)) ? 2 : 1)
#ifndef PROBE_SKIP
#define PROBE_SKIP 0
#endif
#define SKIP(k) (PROBE_REP == 20 && PROBE_SKIP == (k) && pass_ == 0)
constexpr int PH_PER_LAYER = 27, PH_END = 1 + 2 * PH_PER_LAYER;
__global__ void __launch_bounds__(NWAVES * 64, 2) fwd(Args args_unused) {
    extern __shared__ __attribute__((aligned(16))) unsigned char lds_raw[];
    LAS unsigned char* lds = (LAS unsigned char*)lds_raw;
    volatile LAS unsigned* MISC = (volatile LAS unsigned*)(lds + MISC_OFF);
    const int GK = gridDim.x, cK = blockIdx.x;
    const int wave_s = __builtin_amdgcn_readfirstlane(threadIdx.x >> 6);
    for (int u = threadIdx.x; u < (LDS_BYTES - MISC_OFF) / 4; u += NWAVES * 64) ((LAS unsigned*)(lds + MISC_OFF))[u] = 0u;
    __syncthreads();
    int lo, hi;
    XcdBarrier bar;
    { CArgs* a = get_args(); lo = a->ph_lo; hi = a->ph_hi; unsigned* ctl0 = (unsigned*)(a->ws + WS_CTL);
      bar.bar = ctl0 + CW_BAR; bar.x = 0; bar.st = MISC + 8;
      if (hi - lo > 1) bar = xcd_barrier_post(ctl0 + CW_BAR, MISC + 8); }
#define IN(k) ({ int l_ = lo, h_ = hi; asm volatile("" : "+s"(l_), "+s"(h_)); (l_ <= (k)) && ((k) < h_); })
#define SEAM(k) do { int h_ = hi; asm volatile("" : "+s"(h_)); if ((k) + 1 < h_) { xcd_barrier(bar, wave_s); if (PROBE_REP == 10) xcd_barrier(bar, wave_s); } } while (0)
#define PHASE_VARS CArgs* a = get_args(); unsigned char* ws = a->ws; int G = GK, c = cK; asm volatile("" : "+s"(G), "+s"(c)); \
    const int NGW = G * NWAVES, lane = lane_id_l(), wave = wave_s, tid = wave_s * 64 + lane, gw = c * NWAVES + wave; (void)lane; (void)gw; (void)ws; (void)tid; (void)NGW;
#define SKIPSEAM(k, id) if (SKIP(k) && IN(id)) { SEAM(id); }
#define WPTR(off) ((const bf16*)(ws + WS_W + (off)))

    if (IN(0)) { _Pragma("unroll") for (int rep_ = 0; rep_ < NREP(1); ++rep_) { PHASE_VARS p0_prologue<false>(a, lds, G, c, wave_s); } SEAM(0); }

    for (int pass_ = 0; pass_ < NREP(20); ++pass_)
    for (int layer = 0; layer < 2; ++layer) {
        const int pb = 1 + layer * PH_PER_LAYER;
        for (int hf = 0; hf < NHALF; ++hf) {
            const int p = pb + 7 * hf;
            if (layer == 0 && IN(p + 0) && !SKIP(11)) { _Pragma("unroll") for (int rep_ = 0; rep_ < NREP(11); ++rep_) { PHASE_VARS
                ln_mod_phase((layer == 0) ? a->in[IN_X] : a->out, (const float*)(ws + WS_MOD) + (size_t)layer * 16 * 6144, (bf16*)(ws + A_HY), hf, G, c, wave, lane, lds); } SEAM(p + 0); }
            if (layer == 0) { SKIPSEAM(11, p + 0) }
            if (IN(p + 1) && !SKIP(4)) { _Pragma("unroll") for (int rep_ = 0; rep_ < NREP(4); ++rep_) { PHASE_VARS
                pg8::Gemm g{(const bf16*)(ws + A_HY), WPTR(W_IN + layer * W_IN_L), TH, D, D}; pg8::InProjOrder S; S.init(TH, 14 * 256, G, c, D);
                pg8::EpiInProj E{(bf16*)(ws + A_QKV), (float*)(ws + WS_NG), HT_ELEMS};
                pg8::gemm_phase<pg8::EpiInProj, pg8::InProjOrder, true, true>(lds, g, S, E, wave_s); }
                SEAM(p + 1);
            }
            SKIPSEAM(4, p + 1)
            if (IN(p + 2) && !SKIP(2)) { _Pragma("unroll") for (int rep_ = 0; rep_ < NREP(2); ++rep_) { PHASE_VARS attn_queue_phase(a, layer, layer + 4 * rep_ + 8 * pass_, lds, wave_s); } SEAM(p + 2); }
            SKIPSEAM(2, p + 2)
            if (IN(p + 3) && !SKIP(3)) { _Pragma("unroll") for (int rep_ = 0; rep_ < NREP(3); ++rep_) { PHASE_VARS dil_merge_phase(a, G, c, wave_s); } SEAM(p + 3); }
            SKIPSEAM(3, p + 3)
            if (IN(p + 4) && !SKIP(5)) { _Pragma("unroll") for (int rep_ = 0; rep_ < NREP(5); ++rep_) { PHASE_VARS
                pg8::Gemm g{(const bf16*)(ws + A_HY), WPTR(W_IN + layer * W_IN_L + W_GATE), TH, D, D};
                const int vc = (G % 8 == 0) ? (c % 8) * (G / 8) + c / 8 : c;
                pg8::MergeOrder S{(TH / 256) * 4, G, vc, (int)((A_O4 - A_HY) / TILE_B), 17};
                pg8::EpiMerge E{(bf16*)(ws + A_MERGED), (bf16*)(ws + A_PS) + (size_t)c * 65536, (int)((A_O4 - A_HY) / TILE_B), 17};
                pg8::gemm_phase<pg8::EpiMerge, pg8::MergeOrder, true, true>(lds, g, S, E, wave_s); }
                SEAM(p + 4);
            }
            SKIPSEAM(5, p + 4)
            if (IN(p + 5) && !SKIP(6)) { _Pragma("unroll") for (int rep_ = 0; rep_ < NREP(6); ++rep_) { PHASE_VARS
                pg8::Gemm g{(const bf16*)(ws + A_MERGED), WPTR(W_OUT + layer * W_OUT_L), TH, D, D}; pg8::StaticOrder S; S.init(TH, D, G, c, D);
                pg8::EpiBf16 E{(bf16*)(ws + A_HY), D, 1 << 20, 1 << 30, 0};
                pg8::gemm_phase<pg8::EpiBf16, pg8::StaticOrder, true, true>(lds, g, S, E, wave_s); }
                SEAM(p + 5);
            }
            SKIPSEAM(6, p + 5)
            if (IN(p + 6) && !(SKIP(12) && layer == 0)) { PHASE_VARS
                const float* mod_l = (const float*)(ws + WS_MOD) + (size_t)layer * 16 * 6144;
                const float* lng = a->in[IN_LNG] + (size_t)(layer * 2 + 0) * D; const float* lnb = a->in[IN_LNB] + (size_t)(layer * 2 + 0) * D;
                if (layer == 0) post_norm_phase<0, true, false, 0, 1>(a, a->in[IN_X], a->out  , (const bf16*)(ws + A_HY), (size_t)hf * TH, mod_l + 2048, lng, lnb, mod_l + 3072, (bf16*)(ws + A_H2), hf * TH, TH, G, c, wave, lane, CW_CNT + 32 * pass_, lds);
                else            post_norm_phase<0, true, true, 1, 0>(a, (const float*)(ws + A_H2)  , a->out, (const bf16*)(ws + A_HY), (size_t)hf * TH, mod_l + 2048, lng, lnb, mod_l + 3072, (bf16*)(ws + A_H2), hf * TH, TH, G, c, wave, lane, CW_CNT + 32 * pass_, lds);
                SEAM(p + 6);
            }
            if (SKIP(12) && layer == 0 && IN(p + 6)) { SEAM(p + 6); }
        }
        const int pf = pb + 14;
        if (layer == 0) {
            if (IN(pf + 0) && !SKIP(7)) { _Pragma("unroll") for (int rep_ = 0; rep_ < NREP(7); ++rep_) { PHASE_VARS
                pg8::Gemm g{(const bf16*)(ws + A_H2), WPTR(W_GU), T, D, D}; pg8::StaticOrder S; S.init(T, 2 * DFF, G, c, D);
                pg8::EpiSwiGLU E{(bf16*)(ws + A_ACT), DFF, 1 << 20};
                pg8::gemm_phase<pg8::EpiSwiGLU, pg8::StaticOrder, true, true>(lds, g, S, E, wave_s); }
                SEAM(pf + 0);
            }
            SKIPSEAM(7, pf + 0)
            if (IN(pf + 1) && !SKIP(7)) { _Pragma("unroll") for (int rep_ = 0; rep_ < NREP(7); ++rep_) { PHASE_VARS
                pg8::Gemm g{(const bf16*)(ws + A_ACT), WPTR(W_DN), T, DFF, DFF}; pg8::StaticOrder S; S.init(T, D, G, c, DFF);
                pg8::EpiBf16 E{(bf16*)(ws + A_Y2), D, 1 << 20, 1 << 30, 0};
                pg8::gemm_phase<pg8::EpiBf16, pg8::StaticOrder, true, true>(lds, g, S, E, wave_s); }
                SEAM(pf + 1);
            }
            SKIPSEAM(7, pf + 1)
            if (IN(pf + 2) && !SKIP(13)) { PHASE_VARS
                const float* mod_l = (const float*)(ws + WS_MOD) + (size_t)layer * 16 * 6144;
                const float* lng = a->in[IN_LNG] + (size_t)(layer * 2 + 1) * D; const float* lnb = a->in[IN_LNB] + (size_t)(layer * 2 + 1) * D;
                post_norm_phase<0, true, false, 1, 1>(a, a->out  , (float*)(ws + A_H2)  , (const bf16*)(ws + A_Y2), 0, mod_l + 5120, lng, lnb, mod_l + 16 * 6144  , (bf16*)(ws + A_HY), 0, T, G, c, wave, lane, CW_CNT + 32 * pass_, lds);
                SEAM(pf + 2);
            }
            SKIPSEAM(13, pf + 2)
        } else {
            if (IN(pf + 0) && !SKIP(13)) { PHASE_VARS p0_prologue<true>(a, lds, G, c, wave_s); moe_sort_phase(a, (const bf16*)(ws + A_H2), (bf16*)(ws + A_AS), 0, gw, NGW, lane, CW_CNT + 32 * pass_); SEAM(pf + 0); }
            SKIPSEAM(13, pf + 0)
            for (int ch = 0; ch < NCHUNK; ++ch) {
                const int pc = pf + 1 + 3 * ch;
#define LOAD_NT int nt[8]; { const unsigned* cnt = (const unsigned*)(ws + WS_CTL) + CW_CNT + 32 * pass_ + ch * 8; _Pragma("unroll") for (int e = 0; e < 8; ++e) nt[e] = ((int)__builtin_amdgcn_readfirstlane(cnt[e]) + 255) >> 8; }
                if (IN(pc + 0) && !SKIP(8)) { _Pragma("unroll") for (int rep_ = 0; rep_ < NREP(8); ++rep_) { PHASE_VARS LOAD_NT
                    pg8::Gemm g{(const bf16*)(ws + A_AS), (const bf16*)(ws + A_MGU), CH_ROWS, D, D};
                    pg8::GroupedOrder S{nt[0], nt[1], nt[2], nt[3], nt[4], nt[5], nt[6], nt[7], 2 * DFFE / 256, G, (G % 8 == 0) ? (c % 8) * (G / 8) + c / 8 : c, 1, D};
                    pg8::EpiSwiGLU E{(bf16*)(ws + A_ACTE), DFFE, 2 * DFFE / 256};
                    pg8::gemm_phase<pg8::EpiSwiGLU, pg8::GroupedOrder, true, true>(lds, g, S, E, wave_s); }
                    SEAM(pc + 0);
                }
                SKIPSEAM(8, pc + 0)
                if (IN(pc + 1) && !SKIP(9)) { _Pragma("unroll") for (int rep_ = 0; rep_ < NREP(9); ++rep_) { PHASE_VARS LOAD_NT
                    pg8::Gemm g{(const bf16*)(ws + A_ACTE), (const bf16*)(ws + A_MDN), CH_ROWS, DFFE / KSPLIT, DFFE};
                    pg8::GroupedOrder S{nt[0], nt[1], nt[2], nt[3], nt[4], nt[5], nt[6], nt[7], D / 256, G, (G % 8 == 0) ? (c % 8) * (G / 8) + c / 8 : c, KSPLIT, DFFE / KSPLIT};
                    pg8::EpiBf16 E{(bf16*)(ws + A_YP), D, D / 256, DFFE / KSPLIT, (size_t)CH_ROWS * D};
                    pg8::gemm_phase<pg8::EpiBf16, pg8::GroupedOrder, true, true>(lds, g, S, E, wave_s); }
                    SEAM(pc + 1);
                }
                SKIPSEAM(9, pc + 1)
                if (IN(pc + 2) && !SKIP(13)) { PHASE_VARS
                    const float* mod_l = (const float*)(ws + WS_MOD) + (size_t)layer * 16 * 6144;
                    const float* lng = a->in[IN_LNG] + (size_t)(layer * 2 + 1) * D; const float* lnb = a->in[IN_LNB] + (size_t)(layer * 2 + 1) * D;
                    post_norm_phase<1, false, false>(a, a->out, a->out, (const bf16*)(ws + A_YP), 0, mod_l + 5120, lng, lnb, mod_l, nullptr, ch * TCH, TCH, G, c, wave, lane, CW_CNT + 32 * pass_, lds);
                    if (ch + 1 < NCHUNK) { moe_sort_phase(a, (const bf16*)(ws + A_H2), (bf16*)(ws + A_AS), ch + 1, gw, NGW, lane, CW_CNT + 32 * pass_); SEAM(pc + 2); }
                }
                if (SKIP(13) && IN(pc + 2) && ch + 1 < NCHUNK) { SEAM(pc + 2); }
            }
        }
    }
#undef IN
#undef SEAM
}

#ifndef MK_PER_PHASE
#define MK_PER_PHASE 0
#endif
extern "C" void kernel_launch(void* const* d_in, const int* in_sizes, int n_in, void* d_out, int out_size, void* d_ws, size_t ws_size, hipStream_t stream) {
    static int grid = 0;
    if (grid == 0) {
        if (n_in != 21 || out_size != T * D || ws_size < WS_END) { fprintf(stderr, "kernel_launch: unexpected shapes (n_in %d out %d ws %zu need %zu)\n", n_in, out_size, ws_size, (size_t)WS_END); grid = -1; return; }
        int dev = 0, cus = 0, per_cu = 0;
        if (hipGetDevice(&dev) != hipSuccess || hipDeviceGetAttribute(&cus, hipDeviceAttributeMultiprocessorCount, dev) != hipSuccess) { grid = -1; return; }
        if (hipFuncSetAttribute((const void*)fwd, hipFuncAttributeMaxDynamicSharedMemorySize, LDS_BYTES) != hipSuccess) { fprintf(stderr, "kernel_launch: hipFuncSetAttribute failed\n"); grid = -1; return; }
        if (hipOccupancyMaxActiveBlocksPerMultiprocessor(&per_cu, (const void*)fwd, NWAVES * 64, LDS_BYTES) != hipSuccess || per_cu < 1) fprintf(stderr, "kernel_launch: occupancy query reports %d\n", per_cu);
        (void)hipGetLastError();
        grid = cus;
    }
    if (grid < 0) return;
    if (hipMemsetAsync((char*)d_ws + WS_CTL, 0, CTL_ZERO_BYTES, stream) != hipSuccess) return;
    Args a{};
    for (int i = 0; i < 21; ++i) a.in[i] = (const float*)d_in[i];
    a.out = (float*)d_out; a.ws = (unsigned char*)d_ws;
#if MK_PER_PHASE
    for (int ph = 0; ph < PH_END; ++ph) {
        const int k = (ph - 1) % PH_PER_LAYER, layer = (ph - 1) / PH_PER_LAYER;
        if (ph > 0 && layer == 0 && k > 16) continue;
        a.ph_lo = ph; a.ph_hi = ph + 1;
        hipLaunchKernelGGL(fwd, dim3(grid), dim3(NWAVES * 64), LDS_BYTES, stream, a);
    }
#else
    a.ph_lo = 0; a.ph_hi = PH_END;
    hipLaunchKernelGGL(fwd, dim3(grid), dim3(NWAVES * 64), LDS_BYTES, stream, a);
#endif
}
```

```cpp
#include <hip/hip_runtime.h>
#include <cstdio>
#include <cstdint>

namespace pg8 {
#define PG8_LAS __attribute__((address_space(3)))
typedef unsigned short bf16_t;
typedef short bf16x8 __attribute__((ext_vector_type(8)));
typedef float f32x4 __attribute__((ext_vector_type(4)));
typedef unsigned u32x4 __attribute__((ext_vector_type(4)));
constexpr int BM = 256, BK = 64, HALF = 128, HTB = HALF * BK * 2  , STAGE_BYTES = 8 * HTB, NXCD = 8, WGM = 8;

__host__ __device__ __forceinline__ int lds_byte(int r, int c) { const int st = (r >> 4) * 2 + (c >> 5), rr = r & 15, cc = c & 31, ob = rr * 64 + cc * 2; return st * 1024 + (ob ^ (((ob >> 9) & 1) << 5)); }
__host__ __device__ __forceinline__ void stage_rc(int b, int& R, int& C) { const int st = b / 1024, sb = b % 1024, swz = sb ^ (((sb >> 9) & 1) << 5); R = (st >> 1) * 16 + swz / 64; C = (st & 1) * 32 + (swz % 64) / 2; }
__host__ __device__ __forceinline__ int perm32(int rho) { const int n = rho >> 4, i = rho & 15; return 8 * (i >> 2) + 4 * n + (i & 3); }

struct Unit { int pm, pn, ko, kl; };
struct Gemm { const bf16_t* A; const bf16_t* Bt; int M, N, K; };

struct StaticOrder {
    int nM, nN, nwg, G, c, kl;
    __host__ __device__ void init(int M, int N, int G_, int c_, int kl_) { nM = M / BM; nN = N / BM; nwg = nM * nN; G = G_; c = c_; kl = kl_; }
    __host__ __device__ bool next(int i, Unit& u) const {
        const long L = (long)i * G + c; if (L >= nwg) return false;
        int wgid = (int)L; { const int q = nwg / NXCD, r = nwg % NXCD, xcd = wgid % NXCD, off = wgid / NXCD; wgid = (xcd < r ? xcd * (q + 1) : r * (q + 1) + (xcd - r) * q) + off; }
        const int nig = WGM * nN, gid = wgid / nig, fm = gid * WGM, gsz = (nM - fm) < WGM ? (nM - fm) : WGM;
        u.pm = fm + ((wgid % nig) % gsz); u.pn = (wgid % nig) / gsz; u.ko = 0; u.kl = kl; return true;
    }
    __device__ __forceinline__ void a_ready(const Unit&) const {}
    __device__ __forceinline__ void done(const Unit&) const {}
};

struct InProjOrder : StaticOrder {
    __device__ __forceinline__ bool next(int i, Unit& u) const { if (!StaticOrder::next(i, u)) return false; if (u.pn == 13) u.pn = 28; return true; }
};

__device__ __forceinline__ unsigned cvt_pk_bf16(float lo, float hi) { unsigned r; asm volatile("v_cvt_pk_bf16_f32 %0, %1, %2" : "=v"(r) : "v"(lo), "v"(hi)); return r; }
__device__ __forceinline__ int lane_now() { int l; asm volatile("v_mbcnt_lo_u32_b32 %0, -1, 0\n\tv_mbcnt_hi_u32_b32 %0, -1, %0" : "=v"(l)); return l; }
__device__ __forceinline__ float sigmoidf_(float v) { return __builtin_amdgcn_rcpf(1.f + __expf(-v)); }
__device__ __forceinline__ float bflo(unsigned u) { return __uint_as_float(u << 16); }
__device__ __forceinline__ float bfhi(unsigned u) { return __uint_as_float(u & 0xffff0000u); }

__device__ __forceinline__ void st16(void* ubase, unsigned voff, u32x4 w) { *(u32x4*)((char*)ubase + voff) = w; }
__device__ __forceinline__ u32x4 ld16(const void* ubase, unsigned voff) { return *(const u32x4*)((const char*)ubase + voff); }
__device__ __forceinline__ u32x4 pack8(const f32x4 v0, const f32x4 v1) { u32x4 w; w.x = cvt_pk_bf16(v0[0], v0[1]); w.y = cvt_pk_bf16(v0[2], v0[3]); w.z = cvt_pk_bf16(v1[0], v1[1]); w.w = cvt_pk_bf16(v1[2], v1[3]); return w; }
struct EpiBf16 {
    static constexpr bool PERM = true, AFTER_DRAIN = false;
    bf16_t* O; int ldc; int pn_mod; int klen; size_t kstride;
    __device__ __forceinline__ void operator()(const f32x4 (&acc)[2][2][4][2], const Unit& u, int wr, int wc, int, int) const {
        const int ln_ = lane_now(), fr = ln_ & 15, fq = ln_ >> 4;
        const unsigned voff = (unsigned)((wr * 64 + fr) * ldc + wc * 32 + 8 * fq) * 2u;
        char* tb = (char*)O + ((size_t)(u.ko / klen) * kstride + (size_t)u.pm * BM * ldc + (size_t)(u.pn % pn_mod) * BM) * 2;
#pragma unroll
        for (int ai = 0; ai < 2; ++ai)
#pragma unroll
            for (int m = 0; m < 4; ++m)
#pragma unroll
                for (int bj = 0; bj < 2; ++bj) st16(tb + ((size_t)(ai * HALF + m * 16) * ldc + bj * HALF) * 2, voff, pack8(acc[ai][bj][m][0], acc[ai][bj][m][1]));
    }
};
struct EpiBf16P {
    static constexpr bool PERM = true, AFTER_DRAIN = false;
    bf16_t* O; bf16_t* X; int ldc; int nt0, nt1, nt2, nt3, nt4, nt5, nt6, nt7; int ncol, cut, lft, kpiece;
    __device__ __forceinline__ void operator()(const f32x4 (&acc)[2][2][4][2], const Unit& u, int wr, int wc, int, int) const {
        const int ln_ = lane_now(), fr = ln_ & 15, fq = ln_ >> 4;
        char* tb; unsigned voff; int ld;
        if (u.ko == 0) { ld = ldc; voff = (unsigned)((wr * 64 + fr) * ldc + wc * 32 + 8 * fq) * 2u; tb = (char*)O + ((size_t)u.pm * BM * ldc + (size_t)(u.pn % ncol) * BM) * 2; }
        else { const int e = u.pn / ncol, pnl = u.pn - e * ncol; int to = 0, nte = nt0;
            if (e >= 1) { to += nt0; nte = nt1; } if (e >= 2) { to += nt1; nte = nt2; } if (e >= 3) { to += nt2; nte = nt3; } if (e >= 4) { to += nt3; nte = nt4; }
            if (e >= 5) { to += nt4; nte = nt5; } if (e >= 6) { to += nt5; nte = nt6; } if (e >= 7) { to += nt6; nte = nt7; }
            const int t = to * ncol + pnl * nte + (u.pm - to), kq = u.ko / kpiece;
            ld = BM; voff = (unsigned)((wr * 64 + fr) * BM + wc * 32 + 8 * fq) * 2u; tb = (char*)X + (size_t)((kq - 1) * lft + (t - cut)) * (BM * BM * 2); }
#pragma unroll
        for (int ai = 0; ai < 2; ++ai)
#pragma unroll
            for (int m = 0; m < 4; ++m)
#pragma unroll
                for (int bj = 0; bj < 2; ++bj) st16(tb + ((size_t)(ai * HALF + m * 16) * ld + bj * HALF) * 2, voff, pack8(acc[ai][bj][m][0], acc[ai][bj][m][1]));
    }
};
struct EpiBf16SK {
    static constexpr bool PERM = true, AFTER_DRAIN = false;
    bf16_t* O; int ldc; int pn_mod; int kfull; size_t kstride;
    __device__ __forceinline__ void operator()(const f32x4 (&acc)[2][2][4][2], const Unit& u, int wr, int wc, int, int) const {
        const int ln_ = lane_now(), fr = ln_ & 15, fq = ln_ >> 4;
        const unsigned voff = (unsigned)((wr * 64 + fr) * ldc + wc * 32 + 8 * fq) * 2u;
        char* tb = (char*)O + ((u.ko ? kstride : (size_t)0) + (size_t)u.pm * BM * ldc + (size_t)(u.pn % pn_mod) * BM) * 2;
#pragma unroll
        for (int ai = 0; ai < 2; ++ai)
#pragma unroll
            for (int m = 0; m < 4; ++m)
#pragma unroll
                for (int bj = 0; bj < 2; ++bj) st16(tb + ((size_t)(ai * HALF + m * 16) * ldc + bj * HALF) * 2, voff, pack8(acc[ai][bj][m][0], acc[ai][bj][m][1]));
        if (u.ko == 0 && u.kl == kfull) { const u32x4 z = {0u, 0u, 0u, 0u};
#pragma unroll
            for (int ai = 0; ai < 2; ++ai)
#pragma unroll
                for (int m = 0; m < 4; ++m)
#pragma unroll
                    for (int bj = 0; bj < 2; ++bj) st16(tb + (kstride + (size_t)(ai * HALF + m * 16) * ldc + bj * HALF) * 2, voff, z); }
    }
};
struct EpiSwiGLU {
    static constexpr bool PERM = true, AFTER_DRAIN = false;
    bf16_t* O; int ldc; int pn_mod;
    __device__ __forceinline__ void operator()(const f32x4 (&acc)[2][2][4][2], const Unit& u, int wr, int wc, int, int) const {
        const int ln_ = lane_now(), fr = ln_ & 15, fq = ln_ >> 4;
        const unsigned voff = (unsigned)((wr * 64 + fr) * ldc + wc * 32 + 8 * fq) * 2u;
        char* tb = (char*)O + ((size_t)u.pm * BM * ldc + (size_t)(u.pn % pn_mod) * HALF) * 2;
#pragma unroll
        for (int ai = 0; ai < 2; ++ai)
#pragma unroll
            for (int m = 0; m < 4; ++m) {
                f32x4 r0, r1;
#pragma unroll
                for (int j = 0; j < 4; ++j) { const float g0 = acc[ai][0][m][0][j], u0 = acc[ai][1][m][0][j], g1 = acc[ai][0][m][1][j], u1 = acc[ai][1][m][1][j];
                    r0[j] = g0 * sigmoidf_(g0) * u0; r1[j] = g1 * sigmoidf_(g1) * u1; }
                st16(tb + (size_t)(ai * HALF + m * 16) * ldc * 2, voff, pack8(r0, r1)); }
    }
};
struct EpiInProj {
    static constexpr bool PERM = true, AFTER_DRAIN = false;
    bf16_t* qkv; float* ng; size_t ht;
    __device__ __forceinline__ void operator()(const f32x4 (&acc)[2][2][4][2], const Unit& u, int wr, int wc, int, int) const {
        const int ln_ = lane_now(), fr = ln_ & 15, fq = ln_ >> 4;
        const int rl = wr * 64 + fr;
#pragma unroll
        for (int bj = 0; bj < 2; ++bj) {
            const int colblk = u.pn * BM + bj * HALF + wc * 32;
            const int hb = colblk >> 6, cin = (colblk & 63) + 8 * fq;
            if (hb < 50) {
                const bool vt = (hb == 7) | (hb == 9) | (hb == 16) | (hb == 17) | (hb >= 34 && hb < 38) | (hb >= 46);
                if (!vt) {
                    char* tb = (char*)qkv + ((size_t)hb * ht + (size_t)u.pm * BM * 64) * 2; const unsigned voff = (unsigned)(rl * 64 + cin) * 2u;
#pragma unroll
                    for (int ai = 0; ai < 2; ++ai)
#pragma unroll
                        for (int m = 0; m < 4; ++m) st16(tb + (size_t)(ai * HALF + m * 16) * 64 * 2, voff, pack8(acc[ai][bj][m][0], acc[ai][bj][m][1]));
                } else {
                    const int bb = u.pm >> 3, s0 = (u.pm & 7) * BM + rl;
                    char* tb = (char*)qkv + ((size_t)hb * ht + ((size_t)bb * 64 + (colblk & 63)) * 2048) * 2;
                    const bool dilv = (hb >= 34 && hb < 38);
                    char* t4 = (char*)qkv + ((size_t)(50 + (hb - 34) * 2) * ht + ((size_t)bb * 64 + (colblk & 63)) * 2048) * 2; char* t16 = t4 + ht * 2;
#pragma unroll
                    for (int ai = 0; ai < 2; ++ai)
#pragma unroll
                        for (int m = 0; m < 4; ++m) { const int s = s0 + ai * HALF + m * 16; const u32x4 w = pack8(acc[ai][bj][m][0], acc[ai][bj][m][1]);
                            {
                                const int j = fr & 7; u32x4 t = w;
#define PG8_SWZ(v, m) ((unsigned)__builtin_amdgcn_ds_swizzle((int)(v), ((m) << 10) | 0x1f))
                                { const unsigned s0 = (j & 4) ? t.x : t.z, s1 = (j & 4) ? t.y : t.w; const unsigned r0 = PG8_SWZ(s0, 4), r1 = PG8_SWZ(s1, 4);
                                  if (j & 4) { t.x = r0; t.y = r1; } else { t.z = r0; t.w = r1; } }
                                { const unsigned s0 = (j & 2) ? t.x : t.y, s1 = (j & 2) ? t.z : t.w; const unsigned r0 = PG8_SWZ(s0, 2), r1 = PG8_SWZ(s1, 2);
                                  if (j & 2) { t.x = r0; t.z = r1; } else { t.y = r0; t.w = r1; } }
                                { const unsigned p0 = PG8_SWZ(t.x, 1), p1 = PG8_SWZ(t.y, 1), p2 = PG8_SWZ(t.z, 1), p3 = PG8_SWZ(t.w, 1);
                                  if (j & 1) { t.x = (p0 >> 16) | (t.x & 0xffff0000u); t.y = (p1 >> 16) | (t.y & 0xffff0000u); t.z = (p2 >> 16) | (t.z & 0xffff0000u); t.w = (p3 >> 16) | (t.w & 0xffff0000u); }
                                  else       { t.x = (t.x & 0xffffu) | (p0 << 16); t.y = (t.y & 0xffffu) | (p1 << 16); t.z = (t.z & 0xffffu) | (p2 << 16); t.w = (t.w & 0xffffu) | (p3 << 16); } }
#undef PG8_SWZ
                                st16(tb, (unsigned)((8 * fq + j) * 2048 + (s - j)) * 2u, t);
                            }
                            if (dilv) {
                                const unsigned v4 = (unsigned)(8 * fq * 2048 + (s & 3) * 512 + (s >> 2)) * 2u, v16 = (unsigned)(8 * fq * 2048 + (s & 15) * 128 + (s >> 4)) * 2u;
                                *(unsigned short*)(t4 + v4) = (unsigned short)w.x; *(unsigned short*)(t4 + v4 + 4096) = (unsigned short)(w.x >> 16);
                                *(unsigned short*)(t4 + v4 + 2 * 4096) = (unsigned short)w.y; *(unsigned short*)(t4 + v4 + 3 * 4096) = (unsigned short)(w.y >> 16);
                                *(unsigned short*)(t4 + v4 + 4 * 4096) = (unsigned short)w.z; *(unsigned short*)(t4 + v4 + 5 * 4096) = (unsigned short)(w.z >> 16);
                                *(unsigned short*)(t4 + v4 + 6 * 4096) = (unsigned short)w.w; *(unsigned short*)(t4 + v4 + 7 * 4096) = (unsigned short)(w.w >> 16);
                                *(unsigned short*)(t16 + v16) = (unsigned short)w.x; *(unsigned short*)(t16 + v16 + 4096) = (unsigned short)(w.x >> 16);
                                *(unsigned short*)(t16 + v16 + 2 * 4096) = (unsigned short)w.y; *(unsigned short*)(t16 + v16 + 3 * 4096) = (unsigned short)(w.y >> 16);
                                *(unsigned short*)(t16 + v16 + 4 * 4096) = (unsigned short)w.z; *(unsigned short*)(t16 + v16 + 5 * 4096) = (unsigned short)(w.z >> 16);
                                *(unsigned short*)(t16 + v16 + 6 * 4096) = (unsigned short)w.w; *(unsigned short*)(t16 + v16 + 7 * 4096) = (unsigned short)(w.w >> 16);
                            } }
                }
            } else if (hb == 114) {
                if (cin < 16) {
                    char* tb = (char*)ng + (size_t)u.pm * BM * 16 * 4; const unsigned voff = (unsigned)(rl * 16 + cin) * 4u;
#pragma unroll
                    for (int ai = 0; ai < 2; ++ai)
#pragma unroll
                        for (int m = 0; m < 4; ++m) { char* p = tb + (size_t)(ai * HALF + m * 16) * 16 * 4;
                            *(f32x4*)(p + voff) = acc[ai][bj][m][0]; *(f32x4*)(p + 16 + voff) = acc[ai][bj][m][1]; }
                }
            }
        }
    }
};
struct MergeOrder {
    int ntile, G, c, pm_off, pn_off;
    __device__ __forceinline__ bool next(int i, Unit& u) const {
        const int tl = (i >> 3) * G + c, sub = i & 7, br = sub >> 1; if (tl >= ntile) return false;
        const int pml = tl >> 2, pnl = tl & 3;
        if (sub & 1) { u.pm = pml; u.pn = br * 4 + pnl; u.ko = 0; u.kl = 1024; }
        else         { u.pm = pm_off + pml; u.pn = pn_off + pnl; u.ko = br * 256; u.kl = 256; }
        return true;
    }
    __device__ __forceinline__ void a_ready(const Unit&) const {}
    __device__ __forceinline__ void done(const Unit&) const {}
};
struct EpiMerge {
    static constexpr bool PERM = true, AFTER_DRAIN = false;
    bf16_t* merged; bf16_t* scratch; int pm_off, pn_off;
    __device__ __forceinline__ void operator()(const f32x4 (&acc)[2][2][4][2], const Unit& u, int wr, int wc, int, int) const {
        const int ln_ = lane_now(), fr = ln_ & 15, fq = ln_ >> 4;
        const int rl = wr * 64 + fr, cl = wc * 32 + 8 * fq;
        const unsigned voffs = (unsigned)ln_ * 16u;
        char* sbase = (char*)scratch + (size_t)((wr * 4 + wc) * 16) * 1024;
        if (u.kl == 256) {
#pragma unroll
            for (int ai = 0; ai < 2; ++ai)
#pragma unroll
                for (int m = 0; m < 4; ++m)
#pragma unroll
                    for (int bj = 0; bj < 2; ++bj) st16(sbase + ((ai * 4 + m) * 2 + bj) * 1024, voffs, pack8(acc[ai][bj][m][0], acc[ai][bj][m][1]));
        } else {
            const int br = u.pn >> 2, pml = u.pm, pnl = u.pn & 3;
            const unsigned voffm = (unsigned)(rl * 1024 + cl) * 2u;
            char* tm = (char*)merged + ((size_t)pml * BM * 1024 + (size_t)pnl * BM) * 2;
#pragma unroll
            for (int ai = 0; ai < 2; ++ai)
#pragma unroll
            for (int bj = 0; bj < 2; ++bj) {
                u32x4 pz[4], om[4];
#pragma unroll
                for (int m = 0; m < 4; ++m) { pz[m] = ld16(sbase + ((ai * 4 + m) * 2 + bj) * 1024, voffs);
                    if (br != 0) om[m] = ld16(sbase + 131072 + ((ai * 4 + m) * 2 + bj) * 1024, voffs); else om[m] = (u32x4){0u, 0u, 0u, 0u}; }
                __builtin_amdgcn_sched_barrier(0);
                f32x4 sg[4][2];
#pragma unroll
                for (int m = 0; m < 4; ++m)
#pragma unroll
                    for (int n = 0; n < 2; ++n)
#pragma unroll
                        for (int j = 0; j < 4; ++j) sg[m][n][j] = sigmoidf_(acc[ai][bj][m][n][j]);
                __builtin_amdgcn_sched_barrier(0);
                const unsigned keep = (br != 0) ? 0xffffffffu : 0u;
#pragma unroll
                for (int m = 0; m < 4; ++m) { const f32x4 v0 = sg[m][0], v1 = sg[m][1]; const u32x4 z = pz[m]; u32x4 o = om[m]; o.x &= keep; o.y &= keep; o.z &= keep; o.w &= keep;
                    f32x4 r0, r1;
                    r0[0] = bflo(z.x) * v0[0] + bflo(o.x); r0[1] = bfhi(z.x) * v0[1] + bfhi(o.x); r0[2] = bflo(z.y) * v0[2] + bflo(o.y); r0[3] = bfhi(z.y) * v0[3] + bfhi(o.y);
                    r1[0] = bflo(z.z) * v1[0] + bflo(o.z); r1[1] = bfhi(z.z) * v1[1] + bfhi(o.z); r1[2] = bflo(z.w) * v1[2] + bflo(o.w); r1[3] = bfhi(z.w) * v1[3] + bfhi(o.w);
                    if (br == 3) st16(tm + ((size_t)(ai * HALF + m * 16) * 1024 + bj * HALF) * 2, voffm, pack8(r0, r1));
                    else st16(sbase + 131072 + ((ai * 4 + m) * 2 + bj) * 1024, voffs, pack8(r0, r1)); }
            }
        }
    }
};
struct GroupedOrder {
    int nt0, nt1, nt2, nt3, nt4, nt5, nt6, nt7; int ncol, G, c, ksplit, klen;
    __device__ __forceinline__ bool next(int i, Unit& u) const {
        const int Lq = i * G + c; int L = Lq / ksplit; u.ko = (Lq - L * ksplit) * klen; u.kl = klen; int to = 0;
#define PG8_GO(e, nte) { const int n = (nte) * ncol; if (L < n) { u.pn = (e) * ncol + L / (nte); u.pm = to + L % (nte); return true; } L -= n; to += (nte); }
        PG8_GO(0, nt0) PG8_GO(1, nt1) PG8_GO(2, nt2) PG8_GO(3, nt3) PG8_GO(4, nt4) PG8_GO(5, nt5) PG8_GO(6, nt6) PG8_GO(7, nt7)
#undef PG8_GO
        return false;
    }
    __device__ __forceinline__ void a_ready(const Unit&) const {}
    __device__ __forceinline__ void done(const Unit&) const {}
};
struct TailSplitOrder {
    int nt0, nt1, nt2, nt3, nt4, nt5, nt6, nt7; int ncol, G, c, kfull, kpiece, R, lft, npieces;
    __device__ __forceinline__ bool next(int i, Unit& u) const {
        const bool whole = i < R; const int p = (i - R) * G + c;
        if (!whole && p >= npieces) return false;
        const int kq = whole ? 0 : p / (lft > 0 ? lft : 1); int L = whole ? i * G + c : R * G + (p - kq * lft);
        u.kl = whole ? kfull : kpiece; u.ko = kq * kpiece;
        int to = 0;
#define PG8_GO(e, nte) { const int n = (nte) * ncol; if (L < n) { u.pn = (e) * ncol + L / (nte); u.pm = to + L % (nte); return true; } L -= n; to += (nte); }
        PG8_GO(0, nt0) PG8_GO(1, nt1) PG8_GO(2, nt2) PG8_GO(3, nt3) PG8_GO(4, nt4) PG8_GO(5, nt5) PG8_GO(6, nt6) PG8_GO(7, nt7)
#undef PG8_GO
        return false;
    }
    __device__ __forceinline__ void a_ready(const Unit&) const {}
    __device__ __forceinline__ void done(const Unit&) const {}
};
struct StreamKOrder {
    int nt0, nt1, nt2, nt3, nt4, nt5, nt6, nt7; int ncol, G, c, ppt, q2, total;
    __device__ __forceinline__ int bound(int b) const { int x = b * q2; if (x >= total) return total; const int r = x % ppt; if (r == 1) x -= 1; else if (r == ppt - 1) x += 1; return x; }
    __device__ __forceinline__ bool next(int i, Unit& u) const {
        const int Bs = bound(c), Be = bound(c + 1), t = Bs / ppt + i, t0 = t * ppt, lo = Bs > t0 ? Bs : t0, hi = Be < t0 + ppt ? Be : t0 + ppt;
        if (lo >= hi) return false;
        u.ko = (lo - t0) * 128; u.kl = (hi - lo) * 128; int L = t, to = 0;
#define PG8_GO(e, nte) { const int n = (nte) * ncol; if (L < n) { u.pn = (e) * ncol + L / (nte); u.pm = to + L % (nte); return true; } L -= n; to += (nte); }
        PG8_GO(0, nt0) PG8_GO(1, nt1) PG8_GO(2, nt2) PG8_GO(3, nt3) PG8_GO(4, nt4) PG8_GO(5, nt5) PG8_GO(6, nt6) PG8_GO(7, nt7)
#undef PG8_GO
        return false;
    }
    __device__ __forceinline__ void a_ready(const Unit&) const {}
    __device__ __forceinline__ void done(const Unit&) const {}
};

template <class Epi, class Sched, bool ALIGN_EPI = false, bool SP2 = false>
__device__ __forceinline__ void gemm_phase(PG8_LAS unsigned char* lds, const Gemm g, const Sched& S, const Epi& E, const int wave_s  ) {
    const int tid_l = lane_now() + 64 * wave_s;
    const int tid = tid_l, wid = wave_s, lane = tid & 63, wr = wid >> 2, wc = wid & 3, fr = lane & 15, fq = lane >> 4;
    const int K = g.K;
    unsigned voffA[2], voffB[2];
#pragma unroll
    for (int i = 0; i < 2; ++i) { int R, C; stage_rc(tid * 16 + i * 8192, R, C); const int Rb = Epi::PERM ? ((R & ~31) + perm32(R & 31)) : R;
        voffA[i] = (unsigned)(R * K + C) * 2u; voffB[i] = (unsigned)(Rb * K + C) * 2u; }
    const size_t kstep = (size_t)(BK * 2);
    const size_t hstep = (size_t)HALF * K * 2;
    const size_t tstep = 2 * hstep;
    const unsigned ldsw = (unsigned)wid * 1024u;
    const int aoff = lds_byte(wr * 64 + fr, fq * 8), boff = lds_byte(wc * 32 + fr, fq * 8);
#define PG8_SA(b, h) (((b) * 2 + (h)) * HTB)
#define PG8_SB(b, h) ((4 + (b) * 2 + (h)) * HTB)
#define PG8_STAGE(bufoff, gbase, voff) do { _Pragma("unroll") for (int _i = 0; _i < 2; ++_i) \
        __builtin_amdgcn_global_load_lds((const unsigned*)((const char*)(gbase) + (voff)[_i]), (PG8_LAS unsigned*)(lds + (bufoff) + ldsw + _i * 8192), 16, 0, 0); } while (0)
#define PG8_LDA(dst, b, h) do { _Pragma("unroll") for (int m = 0; m < 4; ++m) _Pragma("unroll") for (int k = 0; k < 2; ++k) dst[m][k] = *(const PG8_LAS bf16x8*)(lds + PG8_SA(b, h) + aoff + m * 2048 + k * 1024); } while (0)
#define PG8_LDB(dst, b, h) do { _Pragma("unroll") for (int n = 0; n < 2; ++n) _Pragma("unroll") for (int k = 0; k < 2; ++k) dst[n][k] = *(const PG8_LAS bf16x8*)(lds + PG8_SB(b, h) + boff + n * 2048 + k * 1024); } while (0)
#define PG8_MMA(ai, bj, At, Bt) do { __builtin_amdgcn_s_setprio(1); _Pragma("unroll") for (int m = 0; m < 4; ++m) _Pragma("unroll") for (int n = 0; n < 2; ++n) _Pragma("unroll") for (int k = 0; k < 2; ++k) \
        acc[ai][bj][m][n] = __builtin_amdgcn_mfma_f32_16x16x32_bf16(Bt[n][k], At[m][k], acc[ai][bj][m][n], 0, 0, 0); __builtin_amdgcn_s_setprio(0); } while (0)
#define PG8_WAIT_V(n) asm volatile("s_waitcnt vmcnt(" #n ")" ::: "memory")
#define PG8_WAIT_L(n) asm volatile("s_waitcnt lgkmcnt(" #n ")" ::: "memory")
#define PG8_BAR __builtin_amdgcn_s_barrier()
#define PG8_SCHED __builtin_amdgcn_sched_barrier(0)
    Unit cur, nxt; int ui = 0;
    if (!S.next(0, cur)) return;
    f32x4 acc[2][2][4][2];
#pragma unroll
    for (int a = 0; a < 2; ++a)
#pragma unroll
        for (int b = 0; b < 2; ++b)
#pragma unroll
            for (int m = 0; m < 4; ++m)
#pragma unroll
                for (int n = 0; n < 2; ++n) acc[a][b][m][n] = (f32x4){0.f, 0.f, 0.f, 0.f};
    bf16x8 At[4][2], B0[2][2], B1[2][2];
    const char* cA = (const char*)g.A + (size_t)cur.pm * tstep + (size_t)cur.ko * 2; const char* cB = (const char*)g.Bt + (size_t)cur.pn * tstep + (size_t)cur.ko * 2;
    S.a_ready(cur);
    if constexpr (SP2) {
        PG8_STAGE(PG8_SB(0, 0), cB, voffB); PG8_STAGE(PG8_SB(0, 1), cB + hstep, voffB); PG8_STAGE(PG8_SA(0, 0), cA, voffA); PG8_STAGE(PG8_SA(0, 1), cA + hstep, voffA);
        if (wr == 1) PG8_BAR;
        PG8_WAIT_V(2); PG8_BAR;
        PG8_STAGE(PG8_SB(1, 0), cB + kstep, voffB); PG8_STAGE(PG8_SA(1, 0), cA + kstep, voffA); PG8_STAGE(PG8_SB(1, 1), cB + hstep + kstep, voffB);
        PG8_WAIT_V(6); PG8_BAR;
    } else {
        PG8_STAGE(PG8_SB(0, 0), cB, voffB); PG8_STAGE(PG8_SA(0, 0), cA, voffA); PG8_STAGE(PG8_SB(0, 1), cB + hstep, voffB); PG8_STAGE(PG8_SA(0, 1), cA + hstep, voffA);
        if (wr == 1) PG8_BAR;
        PG8_WAIT_V(4); PG8_BAR;
        PG8_STAGE(PG8_SB(1, 0), cB + kstep, voffB); PG8_STAGE(PG8_SA(1, 0), cA + kstep, voffA); PG8_STAGE(PG8_SB(1, 1), cB + hstep + kstep, voffB);
        PG8_WAIT_V(6); PG8_BAR;
    }
    for (;;) {
        const bool has_next = S.next(ui + 1, nxt);
        const char* nA = has_next ? (const char*)g.A + (size_t)nxt.pm * tstep + (size_t)nxt.ko * 2 : cA; const char* nB = has_next ? (const char*)g.Bt + (size_t)nxt.pn * tstep + (size_t)nxt.ko * 2 : cB;
        const int nt = cur.kl / BK;
        for (int t = 0; t < nt; t += 2) {
            const bool last = (t == nt - 2);
            const char* a1 = cA + (size_t)(t + 1) * kstep;
            const char* a2 = last ? nA : cA + (size_t)(t + 2) * kstep; const char* b2 = last ? nB : cB + (size_t)(t + 2) * kstep;
            const char* a3 = a2 + kstep; const char* b3 = b2 + kstep;
            if (last && has_next) S.a_ready(nxt);
            if constexpr (SP2) {
            PG8_LDB(B0, 0, 0); PG8_LDB(B1, 0, 1); PG8_SCHED; PG8_LDA(At, 0, 0); PG8_STAGE(PG8_SA(1, 1), a1 + hstep, voffA);
            PG8_WAIT_V(8); PG8_WAIT_L(0); PG8_BAR; PG8_MMA(0, 0, At, B0); PG8_MMA(0, 1, At, B1); PG8_BAR; PG8_SCHED;
            PG8_LDA(At, 0, 1); PG8_STAGE(PG8_SB(0, 0), b2, voffB); PG8_STAGE(PG8_SB(0, 1), b2 + hstep, voffB); PG8_STAGE(PG8_SA(0, 0), a2, voffA);
            PG8_WAIT_V(8); PG8_WAIT_L(0); PG8_BAR; PG8_MMA(1, 0, At, B0); PG8_MMA(1, 1, At, B1); PG8_BAR; PG8_SCHED;
            PG8_LDB(B0, 1, 0); PG8_LDB(B1, 1, 1); PG8_SCHED; PG8_LDA(At, 1, 0); PG8_STAGE(PG8_SA(0, 1), a2 + hstep, voffA);
            PG8_WAIT_V(8); PG8_WAIT_L(0); PG8_BAR; PG8_MMA(0, 0, At, B0); PG8_MMA(0, 1, At, B1); PG8_BAR; PG8_SCHED;
            PG8_LDA(At, 1, 1); PG8_STAGE(PG8_SB(1, 0), b3, voffB); PG8_STAGE(PG8_SB(1, 1), b3 + hstep, voffB); PG8_STAGE(PG8_SA(1, 0), a3, voffA);
            PG8_WAIT_V(8); PG8_WAIT_L(0); PG8_BAR; PG8_MMA(1, 0, At, B0); PG8_MMA(1, 1, At, B1); PG8_BAR; PG8_SCHED;
            } else {
            PG8_LDB(B0, 0, 0); PG8_SCHED; PG8_LDA(At, 0, 0); PG8_STAGE(PG8_SA(1, 1), a1 + hstep, voffA);
            PG8_WAIT_L(8); PG8_BAR; PG8_WAIT_L(0); PG8_MMA(0, 0, At, B0); PG8_BAR; PG8_SCHED;
            PG8_LDB(B1, 0, 1); PG8_STAGE(PG8_SB(0, 0), b2, voffB);
            PG8_BAR; PG8_WAIT_L(0); PG8_MMA(0, 1, At, B1); PG8_BAR;
            PG8_LDA(At, 0, 1); PG8_STAGE(PG8_SA(0, 0), a2, voffA);
            PG8_BAR; PG8_WAIT_L(0); PG8_MMA(1, 0, At, B0); PG8_BAR; PG8_SCHED;
            PG8_STAGE(PG8_SB(0, 1), b2 + hstep, voffB);
            PG8_WAIT_V(6); PG8_BAR; PG8_MMA(1, 1, At, B1); PG8_BAR;
            PG8_LDB(B0, 1, 0); PG8_SCHED; PG8_LDA(At, 1, 0); PG8_STAGE(PG8_SA(0, 1), a2 + hstep, voffA);
            PG8_WAIT_L(8); PG8_BAR; PG8_WAIT_L(0); PG8_MMA(0, 0, At, B0); PG8_BAR; PG8_SCHED;
            PG8_LDB(B1, 1, 1); PG8_STAGE(PG8_SB(1, 0), b3, voffB);
            PG8_BAR; PG8_WAIT_L(0); PG8_MMA(0, 1, At, B1); PG8_BAR;
            PG8_LDA(At, 1, 1); PG8_STAGE(PG8_SA(1, 0), a3, voffA);
            PG8_BAR; PG8_WAIT_L(0); PG8_MMA(1, 0, At, B0); PG8_BAR; PG8_SCHED;
            PG8_STAGE(PG8_SB(1, 1), b3 + hstep, voffB);
            PG8_WAIT_V(6); PG8_BAR; PG8_MMA(1, 1, At, B1); PG8_BAR;
            }
        }
        if constexpr (ALIGN_EPI) { if (wr == 0) PG8_BAR; }
        if constexpr (!Epi::AFTER_DRAIN) { E(acc, cur, wr, wc, fr, fq); S.done(cur); }
        if (!has_next) break;
#pragma unroll
        for (int a = 0; a < 2; ++a)
#pragma unroll
            for (int b = 0; b < 2; ++b)
#pragma unroll
                for (int m = 0; m < 4; ++m)
#pragma unroll
                    for (int n = 0; n < 2; ++n) acc[a][b][m][n] = (f32x4){0.f, 0.f, 0.f, 0.f};
        cur = nxt; cA = nA; cB = nB; ++ui;
        if constexpr (ALIGN_EPI) { if (wr == 1) PG8_BAR; }
    }
    PG8_WAIT_V(0);
    if constexpr (!ALIGN_EPI) { if (wr == 0) PG8_BAR; }
    PG8_BAR;
    if constexpr (Epi::AFTER_DRAIN) { E.fused(acc, cur, wr, wc, fr, fq, lds, wid, lane); S.done(cur); }
#undef PG8_SA
#undef PG8_SB
#undef PG8_STAGE
#undef PG8_LDA
#undef PG8_LDB
#undef PG8_MMA
#undef PG8_WAIT_V
#undef PG8_WAIT_L
#undef PG8_BAR
#undef PG8_SCHED
}
}

constexpr int NWAVES = 8;
constexpr int D = 1024, BATCH = 16, SEQ = 2048, T = BATCH * SEQ, NHALF = 1, TH = T / NHALF, BH = BATCH / NHALF;
constexpr int DIN = 7308, DINP = 7424;
constexpr int DFF = 2816, DFFE = 3584, NE = 8;
constexpr int KSPLIT = 7;
constexpr size_t YPX_OFF = (size_t)36 * 1048576;
constexpr int NCHUNK = 4, TCH = T / NCHUNK, CH_ROWS = 2 * TCH + NE * 256;
constexpr float ALPHA = 1.4142135623730951f, LN_EPS = 1e-5f;
constexpr int NBH = 20;
constexpr int HT_NSAQ = 0, HT_KCMP = 4, HT_VCMP = 5, HT_KSEL = 6, HT_VSEL = 7, HT_KWIN = 8, HT_VWIN = 9, HT_SWAQ = 10, HT_SWAK = 14, HT_SWAV = 16,
              HT_DILQ = 18, HT_DILK = 30, HT_DILV = 34, HT_SBQ = 38, HT_SBK = 42, HT_SBV = 46, NHT = 58;
constexpr size_t HT_ELEMS = (size_t)TH * 64;

constexpr size_t MiB = 1u << 20;
constexpr size_t WS_CTL = 0, CTL_ZERO_BYTES = 1 * MiB;
constexpr size_t WS_MOD = 1 * MiB;
constexpr size_t WS_BIAS = 2 * MiB;
constexpr size_t WS_ROUTE = 3 * MiB;
constexpr size_t WS_KC = 4 * MiB;
constexpr size_t WS_C1 = 5 * MiB;
constexpr size_t WS_NG = 6 * MiB;
constexpr size_t WS_W = 8 * MiB;
constexpr size_t TILE_B = (size_t)256 * D * 2;
constexpr size_t W_IN = 0, W_IN_L = 34 * TILE_B;
constexpr size_t W_GATE = (size_t)3200 * D * 2, W_BRC = W_GATE + 17 * TILE_B;
constexpr size_t W_OUT = W_IN + 2 * W_IN_L, W_OUT_L = (size_t)D * D * 2;
constexpr size_t W_GU = W_OUT + 2 * W_OUT_L;
constexpr size_t W_DN = W_GU + (size_t)2 * DFF * D * 2;
constexpr size_t W_END = W_DN + (size_t)D * DFF * 2;
static_assert(WS_W + W_END <= 64 * MiB, "weights");
constexpr size_t WS_ACT = 64 * MiB;
constexpr size_t A_H2 = WS_ACT;
constexpr size_t A_HY = WS_ACT + 64 * MiB;
constexpr size_t A_QKV = WS_ACT + 128 * MiB, A_MERGED = A_QKV;
constexpr size_t A_O4 = WS_ACT + 360 * MiB;
constexpr size_t A_DIL = WS_ACT + 424 * MiB;
constexpr size_t A_PS = WS_ACT + 474 * MiB;
constexpr size_t A_ACT = WS_ACT + 64 * MiB, A_Y2 = WS_ACT + 240 * MiB;
constexpr size_t A_MGU = WS_ACT + 64 * MiB, W_MGU_E = (size_t)2 * DFFE * D * 2;
constexpr size_t A_MDN = WS_ACT + 176 * MiB, W_MDN_E = (size_t)D * DFFE * 2;
constexpr size_t A_AS = WS_ACT + 232 * MiB, A_ACTE = WS_ACT + 268 * MiB, A_YP = WS_ACT + 394 * MiB;
constexpr size_t WS_END = WS_ACT + 556 * MiB;
static_assert((A_O4 - A_HY) % TILE_B == 0, "tile offsets");
static_assert(NHT * HT_ELEMS * 2 <= 232 * MiB && (size_t)CH_ROWS * D * 2 <= 36 * MiB && (size_t)CH_ROWS * DFFE * 2 <= 126 * MiB && A_YP + YPX_OFF + (size_t)(KSPLIT - 1) * 128 * 131072 <= WS_END
              && A_DIL + (size_t)3 * TH * 256 * 2 + (size_t)3 * TH * 16 <= A_PS && A_MGU + NE * W_MGU_E <= A_MDN && A_MDN + NE * W_MDN_E <= A_AS, "arena");
constexpr int CW_BAR = 4096, CW_CNT = 16384, CW_QUEUE = 20480, CW_CMPF = 24576, CW_DYN = 40960;

constexpr int RING_BYTES = 131072, LDS_BYTES = 155648, MISC_OFF = LDS_BYTES - 512;

#define GAS __attribute__((address_space(1)))
#define LAS __attribute__((address_space(3)))
typedef unsigned short bf16;
typedef unsigned v4u __attribute__((ext_vector_type(4)));
typedef float f32x4 __attribute__((ext_vector_type(4)));
#define LDS_WAIT() asm volatile("s_waitcnt lgkmcnt(0)" ::: "memory")
__device__ __forceinline__ unsigned f2bf(float f) { unsigned u = __builtin_bit_cast(unsigned, f); return (u + 0x7fffu + ((u >> 16) & 1u)) >> 16; }
__device__ __forceinline__ unsigned pk2(float lo, float hi) { return f2bf(lo) | (f2bf(hi) << 16); }
__device__ __forceinline__ float bflo(unsigned u) { return __uint_as_float(u << 16); }
__device__ __forceinline__ float bfhi(unsigned u) { return __uint_as_float(u & 0xffff0000u); }
__device__ __forceinline__ float sigm(float v) { return 1.f / (1.f + __expf(-v)); }

__device__ __forceinline__ int lane_id_l() { return pg8::lane_now(); }
#define XB_TMO      128
#define XB_XCNT(j)  (256  + 64 * (j))
#define XB_XSUB(j)  (1280 + 64 * (j))
#define XB_XGEN(j)  (2304 + 64 * (j))
#define XB_TOP      3328
#define XB_TOPGEN   3392
#define XCD_BAR_WORDS 3456
#define XB_SPIN_CAP (1u << 18)
__device__ __forceinline__ unsigned xb_ld(unsigned* p)              { return __hip_atomic_load(p, __ATOMIC_RELAXED, __HIP_MEMORY_SCOPE_AGENT); }
__device__ __forceinline__ unsigned xb_add(unsigned* p, unsigned v) { return __hip_atomic_fetch_add(p, v, __ATOMIC_RELAXED, __HIP_MEMORY_SCOPE_AGENT); }
__device__ __forceinline__ unsigned xb_xcc_id() { return (unsigned)__builtin_amdgcn_s_getreg((3 << 11) | 20) & 0xFu; }
#define XB_SPIN(cond, bar) do { unsigned _sp = 0; while (cond) { __builtin_amdgcn_s_sleep(1); \
    if ((++_sp & 255u) == 0u) { if (xb_ld(&(bar)[XB_TMO])) break; if (_sp > XB_SPIN_CAP) { atomicAdd(&(bar)[XB_TMO], 1u); break; } } } } while (0)
struct XcdBarrier { unsigned* bar; unsigned x; volatile LAS unsigned* st; };
__device__ __forceinline__ XcdBarrier xcd_barrier_post(unsigned* bar, volatile LAS unsigned* st) {
    XcdBarrier b; b.bar = bar; b.x = xb_xcc_id(); b.st = st;
    if (threadIdx.x == 0) (void)xb_add(&bar[XB_XCNT(b.x)], 1u);
    return b;
}
__device__ __forceinline__ void xcd_barrier_complete(unsigned* bar, unsigned x, unsigned& nloc, unsigned& nx) {
    const unsigned G = gridDim.x * gridDim.y * gridDim.z;
    unsigned sum, cnt, mine, sp = 0u;
    for (;;) {
        sum = 0u; cnt = 0u; mine = 0u;
#pragma unroll
        for (unsigned j = 0; j < 16; ++j) { const unsigned c = xb_ld(&bar[XB_XCNT(j)]); sum += c; cnt += (c > 0u) ? 1u : 0u; }
        mine = xb_ld(&bar[XB_XCNT(x)]);
        if (sum == G) break;
        __builtin_amdgcn_s_sleep(1);
        if ((++sp & 255u) == 0u) { if (xb_ld(&bar[XB_TMO])) break; if (sp > XB_SPIN_CAP) { atomicAdd(&bar[XB_TMO], 1u); break; } }
    }
    nloc = mine > 0u ? mine : 1u; nx = cnt > 0u ? cnt : 1u;
}
__device__ __forceinline__ void xcd_barrier(const XcdBarrier& b, const int wave_s) {
    asm volatile("s_waitcnt vmcnt(0)" ::: "memory");
    __syncthreads();
    if (wave_s == 0 && lane_id_l() == 0) {
        unsigned* bar = b.bar; asm volatile("" : "+s"(bar));
        __builtin_amdgcn_s_waitcnt(0);
        unsigned nloc = b.st[0], nx = b.st[1];
        if (nloc == 0u) { xcd_barrier_complete(bar, b.x, nloc, nx); b.st[0] = nloc; b.st[1] = nx; }
        const unsigned old = xb_add(&bar[XB_XSUB(b.x)], 1u);
        const unsigned gen = old / nloc;
        if (old + 1u == (gen + 1u) * nloc) {
            __builtin_amdgcn_fence(__ATOMIC_RELEASE, "agent");
            asm volatile("s_waitcnt vmcnt(0)" ::: "memory");
            const unsigned og = xb_add(&bar[XB_TOP], 1u);
            const unsigned tg = og / nx;
            if (og + 1u == (tg + 1u) * nx) xb_add(&bar[XB_TOPGEN], 1u);
            else XB_SPIN(xb_ld(&bar[XB_TOPGEN]) == tg, bar);
            __builtin_amdgcn_fence(__ATOMIC_ACQUIRE, "agent");
            xb_add(&bar[XB_XGEN(b.x)], 1u);
            asm volatile("s_waitcnt vmcnt(0)" ::: "memory");
        } else {
            XB_SPIN(xb_ld(&bar[XB_XGEN(b.x)]) == gen, bar);
            __builtin_amdgcn_fence(__ATOMIC_ACQUIRE, "agent");
            asm volatile("s_waitcnt vmcnt(0)" ::: "memory");
        }
    }
    __syncthreads();
}

struct Args { const float* in[21]; float* out; unsigned char* ws; int ph_lo, ph_hi; };
typedef __attribute__((address_space(4))) const Args CArgs;
__device__ __forceinline__ CArgs* get_args() { CArgs* p = (CArgs*)__builtin_amdgcn_kernarg_segment_ptr(); asm volatile("" : "+s"(p)); return p; }
enum { IN_X = 0, IN_C, IN_RELB, IN_WADA, IN_BADA, IN_WIN, IN_WBR, IN_WOUT, IN_CPE, IN_CW1, IN_CW2, IN_SINK, IN_LNG, IN_LNB, IN_FG, IN_FU, IN_FD, IN_MR, IN_MG, IN_MU, IN_MD };

#define DPPF(v, ctrl) __int_as_float(__builtin_amdgcn_update_dpp(0, __float_as_int(v), (ctrl), 0xF, 0xF, true))
__device__ __forceinline__ float row_sum16(float v) { v += DPPF(v, 0xB1); v += DPPF(v, 0x4E); v += DPPF(v, 0x141); v += DPPF(v, 0x140); return v; }
__device__ __forceinline__ float rows_total(float v) {
    const int i = __float_as_int(v);
    return (__int_as_float(__builtin_amdgcn_readlane(i, 0)) + __int_as_float(__builtin_amdgcn_readlane(i, 16))) + (__int_as_float(__builtin_amdgcn_readlane(i, 32)) + __int_as_float(__builtin_amdgcn_readlane(i, 48)));
}
__device__ __forceinline__ float wave_sum(float v, int) { return rows_total(row_sum16(v)); }
__device__ __forceinline__ unsigned shfl_xor_u(unsigned v, int m, int lane) { return (unsigned)__builtin_amdgcn_ds_bpermute((lane ^ m) << 2, (int)v); }
__device__ __forceinline__ float shfl_f(float v, int src) { return __int_as_float(__builtin_amdgcn_ds_bpermute(src << 2, __float_as_int(v))); }

__device__ __forceinline__ void transpose_item(int mode, const float* src0, const float* src1, int Nsrc, int ldw  , int nblk, bf16* WT, LAS float* scr, int item, int lane) {
    const int kb = item / nblk, nb = item % nblk, k0 = 64 * kb, n0 = 32 * nb;
    const int n = n0 + (lane & 31);
    const float* cb;
    if (mode == 0) cb = src0 + n;
    else if (mode == 1) cb = (n < 640) ? src0 + n : (n < 7296) ? src0 + n + 12 : (n < 7308) ? src0 + (n - 7296 + 640) : nullptr;
    else { const int g = n >> 8, w = n & 255; cb = (w < 128) ? src0 + 128 * g + w : src1 + 128 * g + (w - 128); }
    float tv[32];
#pragma unroll
    for (int i = 0; i < 32; ++i) { const int kk = 2 * i + (lane >> 5); tv[i] = cb ? cb[(size_t)(k0 + kk) * Nsrc] : 0.f; }
#pragma unroll
    for (int i = 0; i < 32; ++i) { const int kk = 2 * i + (lane >> 5); scr[kk * 33 + (lane & 31)] = tv[i]; }
    LDS_WAIT(); asm volatile("" ::: "memory");
    const int c = lane & 7;
#pragma unroll
    for (int j = 0; j < 4; ++j) { const int nn = (lane >> 3) + 8 * j; const LAS float* s = scr + (8 * c) * 33 + nn;
        v4u o; o.x = pk2(s[0 * 33], s[1 * 33]); o.y = pk2(s[2 * 33], s[3 * 33]); o.z = pk2(s[4 * 33], s[5 * 33]); o.w = pk2(s[6 * 33], s[7 * 33]);
        *(GAS v4u*)(WT + (size_t)(n0 + nn) * ldw + k0 + 8 * c) = o; }
    LDS_WAIT(); asm volatile("" ::: "memory");
}

__device__ __forceinline__ int t5_bucket(int d) {
    if (d < 16) return d;
    int b = 16;
    b += (d >= 22); b += (d >= 30); b += (d >= 40); b += (d >= 54); b += (d >= 73); b += (d >= 99); b += (d >= 134); b += (d >= 182);
    b += (d >= 246); b += (d >= 332); b += (d >= 450); b += (d >= 609); b += (d >= 825); b += (d >= 1117); b += (d >= 1513);
    return b;
}

template <int MOE_ONLY>
__device__ __forceinline__ void p0_prologue(CArgs* a, LAS unsigned char* lds, int G, int c, const int wave) {
    const int lane = lane_id_l(), tid = wave * 64 + lane;
    unsigned char* ws = a->ws; bf16* W = (bf16*)(ws + WS_W);
    LAS float* scr = (LAS float*)(lds + wave * 16384);
    const int gw = c * NWAVES + wave, NGW = G * NWAVES;
    constexpr int I_WIN = 16 * (DINP / 32), I_WBR = 4 * 32, I_WOUT = 16 * 32, I_GU = 16 * (2 * DFF / 32), I_DN = (DFF / 64) * 32, I_MGU = 16 * (2 * DFFE / 32), I_MDN = (DFFE / 64) * 32;
    constexpr int I_C1 = (2048 / 64) * 2;
    constexpr int NITEMS = MOE_ONLY == 1 ? NE * I_MGU : MOE_ONLY == 2 ? NE * I_MDN : (2 * I_WIN + 8 * I_WBR + 2 * I_WOUT + I_GU + I_DN + 4 * I_C1);
    for (int it = gw; it < NITEMS; it += NGW) {
        int r = it, mode = 0, Nsrc, K, nblk; const float* s0; const float* s1 = nullptr; bf16* dst;
        if (MOE_ONLY) {
            if (MOE_ONLY == 1) { const int e = r / I_MGU; r -= e * I_MGU; mode = 2; s0 = a->in[IN_MG] + (size_t)e * D * DFFE; s1 = a->in[IN_MU] + (size_t)e * D * DFFE; Nsrc = DFFE; K = D; nblk = 2 * DFFE / 32; dst = (bf16*)(ws + A_MGU + e * W_MGU_E); }
            else { const int e = r / I_MDN; r -= e * I_MDN; s0 = a->in[IN_MD] + (size_t)e * DFFE * D; Nsrc = D; K = DFFE; nblk = 32; dst = (bf16*)(ws + A_MDN + e * W_MDN_E); }
        } else {
        if (r < 2 * I_WIN) { const int l = r / I_WIN; r -= l * I_WIN; mode = 1; s0 = a->in[IN_WIN] + (size_t)l * D * DIN; Nsrc = DIN; K = D; nblk = DINP / 32; dst = (bf16*)((char*)W + W_IN + l * W_IN_L); }
        else { r -= 2 * I_WIN;
        if (r < 8 * I_WBR) { const int j = r / I_WBR; r -= j * I_WBR; s0 = a->in[IN_WBR] + (size_t)j * 256 * D; Nsrc = D; K = D; nblk = 32; dst = (bf16*)((char*)W + W_IN + (j >> 2) * W_IN_L + W_BRC) + (j & 3) * 256; }
        else { r -= 8 * I_WBR;
        if (r < 2 * I_WOUT) { const int l = r / I_WOUT; r -= l * I_WOUT; s0 = a->in[IN_WOUT] + (size_t)l * D * D; Nsrc = D; K = D; nblk = 32; dst = (bf16*)((char*)W + W_OUT + l * W_OUT_L); }
        else { r -= 2 * I_WOUT;
        if (r < I_GU) { mode = 2; s0 = a->in[IN_FG]; s1 = a->in[IN_FU]; Nsrc = DFF; K = D; nblk = 2 * DFF / 32; dst = (bf16*)((char*)W + W_GU); }
        else { r -= I_GU;
        if (r < I_DN) { s0 = a->in[IN_FD]; Nsrc = D; K = DFF; nblk = 32; dst = (bf16*)((char*)W + W_DN); }
        else { r -= I_DN; const int j = r / I_C1; r -= j * I_C1; s0 = a->in[IN_CW1] + (size_t)j * 2048 * 64; Nsrc = 64; K = 2048; nblk = 2; dst = (bf16*)(ws + WS_C1) + (size_t)j * 64 * 2048; }
        }}}}
        }
        transpose_item(mode, s0, s1, Nsrc, K, nblk, dst, scr, r, lane);
    }
    __syncthreads();
    if (MOE_ONLY) return;
    if (c < 192) {
        LAS float* sc = (LAS float*)lds;
        LAS float* part = (LAS float*)(lds + 65536);
        for (int i = tid; i < 16 * D; i += 512) { const float v = a->in[IN_C][i]; sc[i] = v * sigm(v); }
        __syncthreads();
        const int l = c / 96, j0 = (c % 96) * 64;
        const float* wa = a->in[IN_WADA] + (size_t)l * D * 6144 + j0 + lane;
        float acc[16];
#pragma unroll
        for (int b = 0; b < 16; ++b) acc[b] = 0.f;
#pragma unroll 1
        for (int k8 = wave * 128; k8 < wave * 128 + 128; k8 += 32) { float wv[32];
#pragma unroll
            for (int e = 0; e < 32; ++e) wv[e] = wa[(size_t)(k8 + e) * 6144];
            __builtin_amdgcn_sched_barrier(0);
#pragma unroll
            for (int e = 0; e < 32; ++e) {
#pragma unroll
                for (int b = 0; b < 16; ++b) acc[b] = fmaf(sc[b * D + k8 + e], wv[e], acc[b]);
                asm volatile("" ::: "memory"); } }
#pragma unroll
        for (int b = 0; b < 16; ++b) part[(wave * 16 + b) * 64 + lane] = acc[b];
        __syncthreads();
        float* mod = (float*)(ws + WS_MOD);
        for (int o = tid; o < 16 * 64; o += 512) { const int b = o >> 6, j = o & 63; float s = a->in[IN_BADA][l * 6144 + j0 + j];
#pragma unroll
            for (int w = 0; w < 8; ++w) s += part[(w * 16 + b) * 64 + j];
            mod[((size_t)l * 16 + b) * 6144 + j0 + j] = s; }
        __syncthreads();
    } else {
        float* bt = (float*)(ws + WS_BIAS);
        for (int i = (c - 192) * 512 + tid; i < NBH * 2048; i += (G - 192) * 512) { const int h = i >> 11, d = i & 2047; bt[i] = a->in[IN_RELB][t5_bucket(d) * NBH + h]; }
    }
}

__device__ __forceinline__ void ln_stats(const f32x4 (&v)[4], float& mean, float& rstd, int) {
    float s = 0.f, s2 = 0.f;
#pragma unroll
    for (int j = 0; j < 4; ++j) { s += (v[j].x + v[j].y) + (v[j].z + v[j].w); s2 += (v[j].x * v[j].x + v[j].y * v[j].y) + (v[j].z * v[j].z + v[j].w * v[j].w); }
    s = row_sum16(s); s2 = row_sum16(s2);
    mean = rows_total(s) * (1.f / D);
    const float var = fmaxf(rows_total(s2) * (1.f / D) - mean * mean, 0.f);
    rstd = 1.f / sqrtf(var + LN_EPS);
}
__device__ __forceinline__ void store_bf16_row(bf16* orow, const f32x4 (&v)[4], int lane) {
    GAS unsigned long long* o8 = (GAS unsigned long long*)orow + lane;
#pragma unroll
    for (int j = 0; j < 4; ++j) o8[64 * j] = (unsigned long long)pk2(v[j].x, v[j].y) | ((unsigned long long)pk2(v[j].z, v[j].w) << 32);
}
__device__ __forceinline__ void ln_mod_phase(const float* xsrc, const float* mod_l, bf16* H, int half, int G, int c, int wave, int lane, LAS unsigned char* lds) {
    const int rpb = TH / G, rpw = rpb / NWAVES, rbase = c * rpb, b = (half * TH + rbase) >> 11;
    LAS f32x4* Lsh = (LAS f32x4*)lds; LAS f32x4* Lsc = Lsh + 256;
    { const int tid = wave * 64 + lane; const GAS f32x4* src = (const GAS f32x4*)(mod_l + (size_t)b * 6144); if (tid < 256) Lsh[tid] = src[tid]; else Lsc[tid - 256] = src[tid] + 1.f; }
    __syncthreads();
    const int r0 = rbase + wave * rpw;
    for (int rr = 0; rr < rpw; rr += 4) {
        f32x4 xx[4][4];
#pragma unroll
        for (int q = 0; q < 4; ++q) { const GAS f32x4* xr = (const GAS f32x4*)(xsrc + (size_t)(half * TH + r0 + rr + q) * D) + lane;
#pragma unroll
            for (int j = 0; j < 4; ++j) xx[q][j] = xr[64 * j]; }
#pragma unroll
        for (int q = 0; q < 4; ++q) { const int r = r0 + rr + q;
            f32x4 v[4];
#pragma unroll
            for (int j = 0; j < 4; ++j) v[j] = xx[q][j];
            float mean, rstd; ln_stats(v, mean, rstd, lane);
#pragma unroll
            for (int j = 0; j < 4; ++j) v[j] = (v[j] - mean) * rstd * Lsc[lane + 64 * j] + Lsh[lane + 64 * j];
            store_bf16_row(H + (size_t)r * D, v, lane); }
    }
    __syncthreads();
}
template <int YMODE, bool WRITE_H2, bool ROUTE>
__device__ __forceinline__ void post_norm_phase(CArgs* a, const float* xsrc, float* xdst, const bf16* Y, size_t yrow_off, const float* gvec_l  , const float* lng, const float* lnb,
                                                const float* modh  , bf16* H2, int row_lo, int nrows, int G, int c, int wave, int lane, int cbase, LAS unsigned char* lds, int Ggrid = 0  ) {
    unsigned char* ws = a->ws; unsigned* ctl = (unsigned*)(ws + WS_CTL); unsigned* route = (unsigned*)(ws + WS_ROUTE);
    const int rpb = nrows / G, rpw = rpb / NWAVES, rfirst = c * rpb + wave * rpw, bb = (row_lo + c * rpb) >> 11;
    LAS f32x4* Lg = (LAS f32x4*)lds; LAS f32x4* Llg = Lg + 256; LAS f32x4* Llb = Lg + 512; LAS f32x4* Lsh = Lg + 768; LAS f32x4* Lsc = Lg + 1024;
    { const int tid = wave * 64 + lane;
      for (int i = tid; i < 1280; i += 512) { const int wv = i >> 8, k = i & 255; f32x4 val;
          if (wv == 0) val = ((const GAS f32x4*)(gvec_l + (size_t)bb * 6144))[k]; else if (wv == 1) val = ((const GAS f32x4*)lng)[k]; else if (wv == 2) val = ((const GAS f32x4*)lnb)[k];
          else if (wv == 3) val = ((const GAS f32x4*)(modh + (size_t)bb * 6144))[k]; else val = ((const GAS f32x4*)(modh + (size_t)bb * 6144 + 1024))[k] + 1.f;
          Lg[i] = val; } }
    LAS f32x4* Lwr = Lg + 1280;
    LAS unsigned* Lcnt = (LAS unsigned*)(Lwr + 2048);
    if (ROUTE) { const int tid = wave * 64 + lane; if (tid < 16) Lcnt[tid] = 0u; const GAS f32x4* wsrc = (const GAS f32x4*)a->in[IN_MR]; for (int i = tid; i < 2048; i += 512) { const int k = i >> 1, jq = ((k >> 8) << 2) | (k & 3); Lwr[((jq * 2 + (i & 1)) << 6) + ((k & 255) >> 2)] = wsrc[i]; } }
    __syncthreads();
    const int gw = rfirst, NGW = 1; (void)NGW;
    f32x4 nx[4], nx2[4]; unsigned long long ny[4], ny2[4];
    if (YMODE == 0 && rpw > 0) { const GAS f32x4* xr0 = (const GAS f32x4*)(xsrc + (size_t)(row_lo + gw) * D) + lane; const GAS unsigned long long* y0 = (const GAS unsigned long long*)(Y + ((size_t)(row_lo + gw) - yrow_off) * D) + lane;
#pragma unroll
        for (int j = 0; j < 4; ++j) { nx[j] = xr0[64 * j]; ny[j] = y0[64 * j]; }
        if (rpw > 1) {
#pragma unroll
            for (int j = 0; j < 4; ++j) { nx2[j] = xr0[64 * j + D / 4]; ny2[j] = y0[64 * j + D / 4]; } } }
    for (int r = gw; r < rfirst + rpw; ++r) { const int row = row_lo + r, b = row >> 11; (void)b;
        const GAS f32x4* xr = (const GAS f32x4*)(xsrc + (size_t)row * D) + lane;
        f32x4 v[4];
        if (YMODE == 0) {
#pragma unroll
            for (int j = 0; j < 4; ++j) { const unsigned long long yy = ny[j]; const unsigned lo = (unsigned)yy, hi = (unsigned)(yy >> 32);
                const f32x4 yv = {bflo(lo), bfhi(lo), bflo(hi), bfhi(hi)}; v[j] = nx[j] * ALPHA + Lg[lane + 64 * j] * yv; }
#pragma unroll
            for (int j = 0; j < 4; ++j) { nx[j] = nx2[j]; ny[j] = ny2[j]; }
            if (r + 2 < rfirst + rpw) { const GAS f32x4* xr1 = (const GAS f32x4*)(xsrc + (size_t)(row + 2) * D) + lane; const GAS unsigned long long* y1 = (const GAS unsigned long long*)(Y + ((size_t)(row + 2) - yrow_off) * D) + lane;
#pragma unroll
                for (int j = 0; j < 4; ++j) { nx2[j] = xr1[64 * j]; ny2[j] = y1[64 * j]; } }
        } else {
            const unsigned* rt = route + (size_t)row * 8; const int ch = row / TCH;
            const unsigned e1 = rt[0], e2 = rt[1], s1 = rt[2], s2 = rt[3]; const float w1 = __uint_as_float(rt[4]), w2 = __uint_as_float(rt[5]);
            int off1 = 0, off2 = 0, nt1 = 0, nt2 = 0, ntl = 0;
#pragma unroll
            for (int e = 0; e < NE; ++e) { const int cnt = (int)ctl[cbase + ch * 8 + e]; const int pad = (cnt + 255) & ~255; off1 += (e < (int)e1) ? pad : 0; off2 += (e < (int)e2) ? pad : 0;
                nt1 = (e == (int)e1) ? (pad >> 8) : nt1; nt2 = (e == (int)e2) ? (pad >> 8) : nt2; ntl += pad >> 8; }
            const int Gd = Ggrid > 0 ? Ggrid : G, cut = (ntl * (D / 256) / Gd) * Gd, lft = ntl * (D / 256) - cut, tb1 = (off1 >> 8) * (D / 256) + ((int)s1 >> 8), tb2 = (off2 >> 8) * (D / 256) + ((int)s2 >> 8);
            const GAS unsigned long long* ya = (const GAS unsigned long long*)(Y + (size_t)(off1 + (int)s1) * D) + lane;
            const GAS unsigned long long* yb = (const GAS unsigned long long*)(Y + (size_t)(off2 + (int)s2) * D) + lane;
            unsigned long long yq1[4], yq2[4]; f32x4 xq[4];
#pragma unroll
            for (int j = 0; j < 4; ++j) { yq1[j] = ya[64 * j]; yq2[j] = yb[64 * j]; }
#pragma unroll
            for (int j = 0; j < 4; ++j) xq[j] = xr[64 * j];
            __builtin_amdgcn_sched_barrier(0);
#pragma unroll
            for (int j = 0; j < 4; ++j) { const unsigned long long y1 = yq1[j], y2 = yq2[j];
                const unsigned l1 = (unsigned)y1, h1 = (unsigned)(y1 >> 32), l2 = (unsigned)y2, h2 = (unsigned)(y2 >> 32);
                f32x4 s1v = {bflo(l1), bfhi(l1), bflo(h1), bfhi(h1)}, s2v = {bflo(l2), bfhi(l2), bflo(h2), bfhi(h2)};
                if (tb1 + j * nt1 >= cut) { const GAS unsigned long long* px = (const GAS unsigned long long*)(Y + YPX_OFF / 2 + (size_t)(tb1 + j * nt1 - cut) * 65536 + ((int)s1 & 255) * 256) + lane;
                    unsigned long long yy[KSPLIT - 1];
#pragma unroll
                    for (int kq = 1; kq < KSPLIT; ++kq) yy[kq - 1] = px[(size_t)(kq - 1) * lft * 16384];
#pragma unroll
                    for (int kq = 1; kq < KSPLIT; ++kq) { const unsigned l = (unsigned)yy[kq - 1], h = (unsigned)(yy[kq - 1] >> 32); s1v = s1v + (f32x4){bflo(l), bfhi(l), bflo(h), bfhi(h)}; } }
                if (tb2 + j * nt2 >= cut) { const GAS unsigned long long* px = (const GAS unsigned long long*)(Y + YPX_OFF / 2 + (size_t)(tb2 + j * nt2 - cut) * 65536 + ((int)s2 & 255) * 256) + lane;
                    unsigned long long yy[KSPLIT - 1];
#pragma unroll
                    for (int kq = 1; kq < KSPLIT; ++kq) yy[kq - 1] = px[(size_t)(kq - 1) * lft * 16384];
#pragma unroll
                    for (int kq = 1; kq < KSPLIT; ++kq) { const unsigned l = (unsigned)yy[kq - 1], h = (unsigned)(yy[kq - 1] >> 32); s2v = s2v + (f32x4){bflo(l), bfhi(l), bflo(h), bfhi(h)}; } }
                v[j] = xq[j] * ALPHA + Lg[lane + 64 * j] * (s1v * w1 + s2v * w2); }
        }
        float mean, rstd; ln_stats(v, mean, rstd, lane);
#pragma unroll
        for (int j = 0; j < 4; ++j) v[j] = (v[j] - mean) * rstd * Llg[lane + 64 * j] + Llb[lane + 64 * j];
        GAS f32x4* xo = (GAS f32x4*)(xdst + (size_t)row * D) + lane;
#pragma unroll
        for (int j = 0; j < 4; ++j) xo[64 * j] = v[j];
        if (WRITE_H2) {
            ln_stats(v, mean, rstd, lane);
#pragma unroll
            for (int j = 0; j < 4; ++j) v[j] = (v[j] - mean) * rstd * Lsc[lane + 64 * j] + Lsh[lane + 64 * j];
            store_bf16_row(H2 + (size_t)row * D, v, lane);
            if (ROUTE) {
                float lg[8];
#pragma unroll
                for (int e = 0; e < 8; ++e) lg[e] = 0.f;
#pragma unroll
                for (int j = 0; j < 4; ++j)
#pragma unroll
                    for (int q = 0; q < 4; ++q) { const f32x4 wa = Lwr[((j * 4 + q) * 2) * 64 + lane], wb = Lwr[((j * 4 + q) * 2 + 1) * 64 + lane]; const float hv = v[j][q];
                        lg[0] = fmaf(hv, wa.x, lg[0]); lg[1] = fmaf(hv, wa.y, lg[1]); lg[2] = fmaf(hv, wa.z, lg[2]); lg[3] = fmaf(hv, wa.w, lg[3]);
                        lg[4] = fmaf(hv, wb.x, lg[4]); lg[5] = fmaf(hv, wb.y, lg[5]); lg[6] = fmaf(hv, wb.z, lg[6]); lg[7] = fmaf(hv, wb.w, lg[7]); if (q == 3) asm volatile("" ::: "memory"); }
#pragma unroll
                for (int e = 0; e < 8; ++e) lg[e] = wave_sum(lg[e], lane);
                int e1 = 0; float v1 = lg[0];
#pragma unroll
                for (int e = 1; e < 8; ++e) if (lg[e] > v1) { v1 = lg[e]; e1 = e; }
                int e2 = -1; float v2 = -3.0e38f;
#pragma unroll
                for (int e = 0; e < 8; ++e) if (e != e1 && lg[e] > v2) { v2 = lg[e]; e2 = e; }
                if (e2 < 0) e2 = (e1 == 0) ? 1 : 0;
                const float p2 = __expf(v2 - v1), w1 = 1.f / (1.f + p2), w2 = p2 / (1.f + p2);
                if (lane == 0) {
                    const unsigned s1 = __hip_atomic_fetch_add(Lcnt + e1, 1u, __ATOMIC_RELAXED, __HIP_MEMORY_SCOPE_WORKGROUP), s2 = __hip_atomic_fetch_add(Lcnt + e2, 1u, __ATOMIC_RELAXED, __HIP_MEMORY_SCOPE_WORKGROUP);
                    LAS unsigned* rt = Lcnt + 16 + (r - c * rpb) * 8; rt[0] = (unsigned)e1; rt[1] = (unsigned)e2; rt[2] = s1; rt[3] = s2; rt[4] = __float_as_uint(w1); rt[5] = __float_as_uint(w2); }
            }
        }
    }
    __syncthreads();
    if (ROUTE) { const int tid = wave * 64 + lane; const int ch = (row_lo + c * rpb) / TCH;
        if (tid < 8) Lcnt[8 + tid] = atomicAdd(&ctl[cbase + ch * 8 + tid], Lcnt[tid]);
        __syncthreads();
        for (int t = tid; t < rpb; t += NWAVES * 64) { LAS unsigned* lr = Lcnt + 16 + t * 8; const unsigned e1 = lr[0], e2 = lr[1];
            unsigned* rt = route + (size_t)(row_lo + c * rpb + t) * 8; rt[0] = e1; rt[1] = e2; rt[2] = lr[2] + Lcnt[8 + e1]; rt[3] = lr[3] + Lcnt[8 + e2]; rt[4] = lr[4]; rt[5] = lr[5]; }
        __syncthreads(); }
}
__device__ __forceinline__ void moe_sort_phase(CArgs* a, const bf16* H2, bf16* AS, int ch, int gw, int NGW, int lane, int cbase) {
    unsigned* ctl = (unsigned*)(a->ws + WS_CTL); const unsigned* route = (const unsigned*)(a->ws + WS_ROUTE);
    for (int r = gw; r < TCH; r += NGW) { const int row = ch * TCH + r;
        const unsigned* rt = route + (size_t)row * 8; const unsigned e1 = rt[0], e2 = rt[1], s1 = rt[2], s2 = rt[3];
        int off1 = 0, off2 = 0;
#pragma unroll
        for (int e = 0; e < NE; ++e) { const int cnt = (int)ctl[cbase + ch * 8 + e]; const int pad = (cnt + 255) & ~255; off1 += (e < (int)e1) ? pad : 0; off2 += (e < (int)e2) ? pad : 0; }
        const GAS v4u* src = (const GAS v4u*)(H2 + (size_t)row * D) + lane;
        const v4u x0 = src[0], x1 = src[64];
        GAS v4u* d1 = (GAS v4u*)(AS + (size_t)(off1 + (int)s1) * D) + lane; GAS v4u* d2 = (GAS v4u*)(AS + (size_t)(off2 + (int)s2) * D) + lane;
        d1[0] = x0; d1[64] = x1; d2[0] = x0; d2[64] = x1; }
    { int off = 0; const v4u z = {0u, 0u, 0u, 0u};
#pragma unroll
      for (int e = 0; e < NE; ++e) { const int cnt = (int)ctl[cbase + ch * 8 + e]; const int pad = (cnt + 255) & ~255;
          for (int r = cnt + gw; r < pad; r += NGW) { GAS v4u* d = (GAS v4u*)(AS + (size_t)(off + r) * D) + lane; d[0] = z; d[64] = z; }
          off += pad; } }
}

typedef short bf16x8 __attribute__((ext_vector_type(8)));
typedef float f32x16 __attribute__((ext_vector_type(16)));
typedef __bf16 bf16x2_t __attribute__((ext_vector_type(2)));
typedef float f32x2_t __attribute__((ext_vector_type(2)));
#define MFMA32(a, b, c) __builtin_amdgcn_mfma_f32_32x32x16_bf16((a), (b), (c), 0, 0, 0)
#define KOFF(r) (((r) & 7) + 16 * ((r) >> 3))
#define PI32(i) (((i) & ~12) | (((i) & 4) << 1) | (((i) & 8) >> 1))
__device__ __forceinline__ unsigned cvtpk(float lo, float hi) { f32x2_t v = {lo, hi}; bf16x2_t b = __builtin_convertvector(v, bf16x2_t); return __builtin_bit_cast(unsigned, b); }
__device__ __forceinline__ float xhalf(float v, int xaddr) { return __int_as_float(__builtin_amdgcn_ds_bpermute(xaddr, __float_as_int(v))); }
__device__ __forceinline__ float xmax_half(float v) { const auto r = __builtin_amdgcn_permlane32_swap(__float_as_uint(v), __float_as_uint(v), false, false); return fmaxf(__uint_as_float(r[0]), __uint_as_float(r[1])); }
__device__ __forceinline__ float xsum_half(float v) { const auto r = __builtin_amdgcn_permlane32_swap(__float_as_uint(v), __float_as_uint(v), false, false); return __uint_as_float(r[0]) + __uint_as_float(r[1]); }
__device__ __forceinline__ float xpart_half(float v, int h2) { const auto r = __builtin_amdgcn_permlane32_swap(__float_as_uint(v), __float_as_uint(v), false, false); return __uint_as_float(h2 ? r[0] : r[1]); }

constexpr int KV_ROWB = 144, KV_VOFF = 64 * KV_ROWB, KV_BUF = 2 * 64 * KV_ROWB;
struct Stage { v4u k, v; };
__device__ __forceinline__ void stage_load(Stage& st, int tid, const bf16* Kb, size_t kstride, const bf16* Vt, int vstride, int k0) {
    const int row = tid >> 3, c = tid & 7;
    st.k = *(const GAS v4u*)(Kb + (size_t)(k0 + row) * kstride + c * 8);
    st.v = *(const GAS v4u*)(Vt + (size_t)row * vstride + k0 + c * 8);
}
__device__ __forceinline__ void stage_store(const Stage& st, int tid, LAS unsigned char* buf) {
    const int row = tid >> 3, c = tid & 7;
    *(LAS v4u*)(buf + row * KV_ROWB + c * 16) = st.k; *(LAS v4u*)(buf + KV_VOFF + row * KV_ROWB + c * 16) = st.v;
}
struct KVFrag { bf16x8 k[4]; bf16x8 v[4]; };
__device__ __forceinline__ void frag_read(KVFrag& f, const LAS unsigned char* buf, int sub, int ql, int h2) {
    const LAS unsigned char* kp = buf + (32 * sub + PI32(ql)) * KV_ROWB + 16 * h2;
#pragma unroll
    for (int s = 0; s < 4; ++s) f.k[s] = *(const LAS bf16x8*)(kp + 32 * s);
    const LAS unsigned char* vp = buf + KV_VOFF + ql * KV_ROWB + 64 * sub + 16 * h2;
#pragma unroll
    for (int dt = 0; dt < 2; ++dt)
#pragma unroll
        for (int s2 = 0; s2 < 2; ++s2) f.v[dt * 2 + s2] = *(const LAS bf16x8*)(vp + dt * 32 * KV_ROWB + 32 * s2);
}
__device__ __forceinline__ void load_qfrag(bf16x8 (&q)[4], const bf16* qrow, int h2) {
#pragma unroll
    for (int s = 0; s < 4; ++s) q[s] = *(const GAS bf16x8*)(qrow + 16 * s + 8 * h2);
}
__device__ __forceinline__ f32x16 zero16() { f32x16 z;
#pragma unroll
    for (int i = 0; i < 16; ++i) z[i] = 0.f;
    return z; }
__device__ __forceinline__ f32x16 qk_tile(const bf16x8 (&q)[4], const bf16x8 (&k)[4]) {
    f32x16 S = zero16();
#pragma unroll
    for (int s = 0; s < 4; ++s) S = MFMA32(k[s], q[s], S);
    return S;
}
__device__ __forceinline__ void pv_tile(f32x16& O0, f32x16& O1, const float (&p)[16], const bf16x8 (&v)[4]) {
    v4u w0, w1;
    w0.x = cvtpk(p[0], p[1]); w0.y = cvtpk(p[2], p[3]); w0.z = cvtpk(p[4], p[5]); w0.w = cvtpk(p[6], p[7]);
    w1.x = cvtpk(p[8], p[9]); w1.y = cvtpk(p[10], p[11]); w1.z = cvtpk(p[12], p[13]); w1.w = cvtpk(p[14], p[15]);
    const bf16x8 p0 = __builtin_bit_cast(bf16x8, w0), p1 = __builtin_bit_cast(bf16x8, w1);
    O0 = MFMA32(v[0], p0, O0); O0 = MFMA32(v[1], p1, O0);
    O1 = MFMA32(v[2], p0, O1); O1 = MFMA32(v[3], p1, O1);
}
struct AttnAcc { float m, l; f32x16 O0, O1; };
__device__ __forceinline__ void acc_init(AttnAcc& A) { A.m = -1e20f; A.l = 0.f; A.O0 = zero16(); A.O1 = zero16(); }
__device__ __forceinline__ void sm_update(AttnAcc& A, const float (&t)[16], const bf16x8 (&v)[4], int xaddr) {
    float mx = fmaxf(fmaxf(t[0], t[1]), t[2]);
#pragma unroll
    for (int r = 3; r < 15; r += 2) mx = fmaxf(fmaxf(mx, t[r]), t[r + 1]);
    mx = fmaxf(mx, t[15]);
    mx = xmax_half(mx);
    const float mnew = fmaxf(A.m, mx);
    if (__any(mnew > A.m + 8.f)) { const float corr = __builtin_amdgcn_exp2f(A.m - mnew); A.l *= corr; A.O0 = A.O0 * corr; A.O1 = A.O1 * corr; A.m = mnew; }
    float p[16]; float ls = 0.f;
#pragma unroll
    for (int r = 0; r < 16; ++r) { p[r] = __builtin_amdgcn_exp2f(t[r] - A.m); ls += p[r]; }
    A.l += ls;
    pv_tile(A.O0, A.O1, p, v);
}
__device__ __forceinline__ void store_ot(bf16* orow, const f32x16& O0, const f32x16& O1, float scale, int h2) {
#pragma unroll
    for (int gp = 0; gp < 4; gp += 2) {
#pragma unroll
        for (int half = 0; half < 2; ++half) { const f32x16& O = half ? O1 : O0;
            const unsigned x0 = cvtpk(O[4 * gp] * scale, O[4 * gp + 1] * scale), x1 = cvtpk(O[4 * gp + 2] * scale, O[4 * gp + 3] * scale);
            const unsigned y0 = cvtpk(O[4 * gp + 4] * scale, O[4 * gp + 5] * scale), y1 = cvtpk(O[4 * gp + 6] * scale, O[4 * gp + 7] * scale);
            const auto s0 = __builtin_amdgcn_permlane32_swap(x0, y0, false, false), s1 = __builtin_amdgcn_permlane32_swap(x1, y1, false, false);
            v4u w; w.x = s0[0]; w.y = s1[0]; w.z = s0[1]; w.w = s1[1];
            *(GAS v4u*)(orow + 32 * half + 8 * (gp + h2)) = w; } }
}
__device__ __forceinline__ void band_subtile(AttnAcc& A, const bf16x8 (&q)[4], const KVFrag& f, int qpos, int q0w, int k0, int nback, const LAS float* tab, int h2, int xaddr) {
    const f32x16 S = qk_tile(q, f.k);
    const int base = qpos - k0 - 8 * h2;
    float t[16];
    if (q0w - k0 >= 31 && q0w + 31 - k0 <= nback) {
#pragma unroll
        for (int r = 0; r < 16; ++r) { const int dd = base - KOFF(r); t[r] = fmaf(S[r], 0.125f * 1.4426950408889634f, tab[dd]); }
    } else {
#pragma unroll
        for (int r = 0; r < 16; ++r) { const int dd = base - KOFF(r); const float bv = tab[dd]; t[r] = (dd >= 0 && dd <= nback) ? fmaf(S[r], 0.125f * 1.4426950408889634f, bv) : -1e30f; }
    }
    sm_update(A, t, f.v, xaddr);
}
__device__ __forceinline__ void band_block(AttnAcc& A, const bf16x8 (&q)[4], LAS unsigned char* kvbuf, int tid, const bf16* Kb, size_t kstride, const bf16* Vt, int vstride,
                                           int q0w, int nback, int kmin, int kmax, const LAS float* tab, int ql, int h2, int xaddr) {
    Stage st; stage_load(st, tid, Kb, kstride, Vt, vstride, kmin); stage_store(st, tid, kvbuf); __syncthreads();
    const int klo = (q0w - nback) & ~31;
    int par = 0;
    for (int k0 = kmin; k0 <= kmax; k0 += 64, par ^= 1) {
        const bool more = k0 + 64 <= kmax;
        if (more) stage_load(st, tid, Kb, kstride, Vt, vstride, k0 + 64);
        const LAS unsigned char* buf = kvbuf + par * KV_BUF;
#pragma unroll
        for (int sub = 0; sub < 2; ++sub) { const int ks = k0 + 32 * sub;
            if (ks >= klo && ks <= q0w) { KVFrag f; frag_read(f, buf, sub, ql, h2); band_subtile(A, q, f, q0w + ql, q0w, ks, nback, tab, h2, xaddr); } }
        if (more) stage_store(st, tid, kvbuf + (par ^ 1) * KV_BUF);
        __syncthreads();
    }
}

constexpr int L_BLKA = 2 * KV_BUF + 2048, L_BLKB = L_BLKA + 32768, L_SCK = L_BLKA, L_MASK = L_BLKB + 32768, L_BT = L_MASK + 512, BT_STRIDE = 2176;
constexpr int L_TABS = L_BT + 4 * BT_STRIDE * 4, TABS_N = 224;
static_assert(L_TABS + 16 * TABS_N * 4 <= MISC_OFF, "NSA LDS map");
__device__ __forceinline__ void nsa_tables(CArgs* a, LAS unsigned char* lds, int wave) {
    const float* biasT = (const float*)(a->ws + WS_BIAS); LAS float* BT = (LAS float*)(lds + L_BT);
    const int lane = lane_id_l(), tid = wave * 64 + lane;
    for (int i = tid; i < 4 * BT_STRIDE; i += 512) { const int hh = i / BT_STRIDE, e = i - hh * BT_STRIDE; int dist = e - 64; dist = dist < 0 ? 0 : (dist > 2047 ? 2047 : dist); BT[i] = biasT[hh * 2048 + dist] * 1.4426950408889634f; }
    LAS float* TB = (LAS float*)(lds + L_TABS);
    for (int i = tid; i < 16 * TABS_N; i += 512) { const int t = i / TABS_N, e = i - t * TABS_N, dil = (t < 8) ? 1 : (t < 12) ? 4 : 16; int dist = (e - 32) * dil; dist = dist < 0 ? 0 : (dist > 2047 ? 2047 : dist);
        TB[i] = biasT[(4 + t) * 2048 + dist] * 1.4426950408889634f; }
}
__device__ __forceinline__ void nsa_unit(CArgs* a, LAS unsigned char* lds, const int wave, const int b, const int tile, const int lane, const int tid, const int ql, const int h2, const int xaddr) {
    unsigned char* ws = a->ws; const bf16* QKV = (const bf16*)(ws + A_QKV); bf16* O4 = (bf16*)(ws + A_O4);
    const float* NG = (const float*)(ws + WS_NG); const bf16* KCB = (const bf16*)(ws + WS_KC); const bf16* VCT = KCB + (size_t)BH * 128 * 64;
    const int h = wave & 3, qh = wave >> 2;
    LAS float* BLKA = (LAS float*)(lds + L_BLKA); LAS float* BLKB = (LAS float*)(lds + L_BLKB);
    LAS unsigned* SCK = (LAS unsigned*)(lds + L_SCK); LAS unsigned* MASK = (LAS unsigned*)(lds + L_MASK);
    LAS float* BT = (LAS float*)(lds + L_BT);
        const int t0 = tile * 64, qpos0 = t0 + 32 * qh, qpos = qpos0 + ql; const size_t rowb = (size_t)b * SEQ, row = rowb + qpos;
        const int qi = 32 * qh + ql;
        bf16x8 q[4]; load_qfrag(q, QKV + (HT_NSAQ + h) * HT_ELEMS + row * 64, h2);
        const float g0 = sigm(NG[row * 16 + h * 3 + 0]), g1 = sigm(NG[row * 16 + h * 3 + 1]), g2 = sigm(NG[row * 16 + h * 3 + 2]);
        f32x16 T0, T1;
        {
            const bf16* Kb = KCB + (size_t)b * 128 * 64; const bf16* Vt = VCT + (size_t)b * 64 * 128;
            Stage s0, s1; stage_load(s0, tid, Kb, 64, Vt, 128, 0); stage_load(s1, tid, Kb, 64, Vt, 128, 64);
            stage_store(s0, tid, lds); stage_store(s1, tid, lds + KV_BUF);
            __syncthreads();
            const int imax = (qpos >= 31) ? ((qpos - 31) >> 4) : -1;
            const int ntile = (min(qpos0 >> 4, 126) >> 5) + 1;
            float m = -1e20f, l = 0.f;
            for (int kt = 0; kt < ntile; ++kt) { KVFrag f; frag_read(f, lds + (kt >> 1) * KV_BUF, kt & 1, ql, h2);
                const f32x16 S = qk_tile(q, f.k); float mx = -1e30f; float t[16];
#pragma unroll
                for (int r = 0; r < 16; ++r) { const int i = kt * 32 + KOFF(r) + 8 * h2; t[r] = (i <= imax) ? S[r] * (0.125f * 1.4426950408889634f) : -1e30f; mx = fmaxf(mx, t[r]); }
                mx = xmax_half(mx); const float mn = fmaxf(m, mx); l *= __builtin_amdgcn_exp2f(m - mn); m = mn;
#pragma unroll
                for (int r = 0; r < 16; ++r) l += __builtin_amdgcn_exp2f(t[r] - m); }
            l = xsum_half(l);
            const float inv = 1.f / fmaxf(l, 1e-30f);
            f32x16 C0 = zero16(), C1 = zero16();
            for (int kt = 0; kt < 4; ++kt) {
                float p[16];
                if (kt < ntile) { KVFrag f; frag_read(f, lds + (kt >> 1) * KV_BUF, kt & 1, ql, h2);
                    const f32x16 S = qk_tile(q, f.k);
#pragma unroll
                    for (int r = 0; r < 16; ++r) { const int i = kt * 32 + KOFF(r) + 8 * h2; p[r] = (i <= imax) ? __builtin_amdgcn_exp2f(fmaf(S[r], 0.125f * 1.4426950408889634f, -m)) * inv : 0.f; }
                    pv_tile(C0, C1, p, f.v);
                } else {
#pragma unroll
                    for (int r = 0; r < 16; ++r) p[r] = 0.f;
                }
#pragma unroll
                for (int gq = 0; gq < 4; ++gq) { const int j = (32 * kt + KOFF(4 * gq) + 8 * h2) >> 2;
                    BLKA[(h * 32 + j) * 64 + qi] = (p[4 * gq] + p[4 * gq + 1]) + (p[4 * gq + 2] + p[4 * gq + 3]);
                    if (j + 1 < 32) BLKB[(h * 32 + j + 1) * 64 + qi] = p[4 * gq + 3]; }
            }
            if (h2 == 0) BLKB[(h * 32 + 0) * 64 + qi] = 0.f;
            T0 = C0 * g0; T1 = C1 * g0;
        }
        __syncthreads();
        float ssc[4];
        {
            const int sq = tid >> 3, jg = tid & 7;
#pragma unroll
            for (int jj = 0; jj < 4; ++jj) { const int j = jg * 4 + jj; float s = 0.f;
#pragma unroll
                for (int hh = 0; hh < 4; ++hh) s += BLKA[(hh * 32 + j) * 64 + sq] + BLKB[(hh * 32 + j) * 64 + sq];
                if (j == 0 || j == tile || j == tile - 1) s = 1e4f; else if (j > tile) s = -1e30f;
                ssc[jj] = s; }
        }
        __syncthreads();
        {
            const int sq = tid >> 3, jg = tid & 7;
#pragma unroll
            for (int jj = 0; jj < 4; ++jj) { const int j = jg * 4 + jj; const unsigned ub = __float_as_uint(ssc[jj]); const unsigned ord = (ub & 0x80000000u) ? ~ub : (ub | 0x80000000u);
                SCK[sq * 33 + j] = (ord & ~31u) | (unsigned)(31 - j); }
            if (tid == 0) MASK[64] = 0u;
        }
        __syncthreads();
        {
            const int sq = tid >> 3, jg = tid & 7; unsigned bits = 0u;
            const unsigned k0 = SCK[sq * 33 + jg * 4 + 0], k1 = SCK[sq * 33 + jg * 4 + 1], k2 = SCK[sq * 33 + jg * 4 + 2], k3 = SCK[sq * 33 + jg * 4 + 3];
            int r0 = 0, r1 = 0, r2 = 0, r3 = 0;
#pragma unroll 4
            for (int j2 = 0; j2 < 32; ++j2) { const unsigned kk = SCK[sq * 33 + j2]; r0 += (kk > k0) ? 1 : 0; r1 += (kk > k1) ? 1 : 0; r2 += (kk > k2) ? 1 : 0; r3 += (kk > k3) ? 1 : 0; }
            bits = ((r0 < 16) ? 1u : 0u) | ((r1 < 16) ? 2u : 0u) | ((r2 < 16) ? 4u : 0u) | ((r3 < 16) ? 8u : 0u);
            bits <<= (jg * 4);
            bits |= shfl_xor_u(bits, 1, lane); bits |= shfl_xor_u(bits, 2, lane); bits |= shfl_xor_u(bits, 4, lane);
            if (jg == 0) { MASK[sq] = bits; atomicOr((unsigned*)&MASK[64], bits); }
        }
        __syncthreads();
        {
            const unsigned msk = MASK[qi]; unsigned un = MASK[64] & ((tile >= 31) ? 0xffffffffu : ((2u << tile) - 1u));
            const bf16* Kb = QKV + (size_t)HT_KSEL * HT_ELEMS + rowb * 64; const bf16* Vt = QKV + (size_t)HT_VSEL * HT_ELEMS + (size_t)b * 64 * SEQ;
            const LAS float* tab = BT + h * BT_STRIDE + 64;
            AttnAcc A; acc_init(A);
            int j = __builtin_ctz(un); un &= un - 1;
            Stage st; stage_load(st, tid, Kb, 64, Vt, SEQ, 64 * j); stage_store(st, tid, lds); __syncthreads();
            int par = 0;
            for (;;) {
                const bool more = un != 0u; const int jn = more ? __builtin_ctz(un) : 0; un &= un - 1;
                if (more) stage_load(st, tid, Kb, 64, Vt, SEQ, 64 * jn);
                const LAS unsigned char* buf = lds + par * KV_BUF;
                const bool selj = (msk >> j) & 1u;
                const bool allsel = __all(selj);
                if (__any(selj)) {
#pragma unroll
                    for (int sub = 0; sub < 2; ++sub) { const int ks = 64 * j + 32 * sub;
                        if (ks <= qpos0) { KVFrag f; frag_read(f, buf, sub, ql, h2);
                            const f32x16 S = qk_tile(q, f.k);
                            const int base = qpos - ks - 8 * h2;
                            float t[16];
                            if (allsel && qpos0 - ks >= 31) {
#pragma unroll
                                for (int r = 0; r < 16; ++r) { const int dd = base - KOFF(r); t[r] = fmaf(S[r], 0.125f * 1.4426950408889634f, tab[dd]); }
                            } else {
#pragma unroll
                                for (int r = 0; r < 16; ++r) { const int dd = base - KOFF(r); const float bv = tab[dd]; t[r] = (selj && dd >= 0) ? fmaf(S[r], 0.125f * 1.4426950408889634f, bv) : -1e30f; }
                            }
                            sm_update(A, t, f.v, xaddr); } }
                }
                if (more) stage_store(st, tid, lds + (par ^ 1) * KV_BUF);
                __syncthreads();
                if (!more) break;
                j = jn; par ^= 1;
            }
            const float lt = xsum_half(A.l); const float sc = g1 / lt;
            T0 = T0 + A.O0 * sc; T1 = T1 + A.O1 * sc;
        }
        {
            AttnAcc A; acc_init(A);
            int kmin = (t0 - 511) & ~63; if (kmin < 0) kmin = 0;
            band_block(A, q, lds, tid, QKV + (size_t)HT_KWIN * HT_ELEMS + rowb * 64, 64, QKV + (size_t)HT_VWIN * HT_ELEMS + (size_t)b * 64 * SEQ, SEQ, qpos0, 511, kmin, t0, BT + h * BT_STRIDE + 64, ql, h2, xaddr);
            const float lt = xsum_half(A.l); const float sc = g2 / lt;
            T0 = T0 + A.O0 * sc; T1 = T1 + A.O1 * sc;
        }
        store_ot(O4 + row * 1024 + 0 * 256 + h * 64, T0, T1, 1.f, h2);
        __syncthreads();
}

constexpr size_t DILO_OFF = 0, DILL_OFF = (size_t)3 * TH * 256 * 2;
constexpr int U_SB = BH * 4 * 8, U_NSA = BH * 32, U_DIL = 3 * BH * 4 * 8, U_SWA = BH * 4 * 8, U_CMP = BH * 8, U_ALL = U_CMP + U_SB + U_NSA + U_DIL + U_SWA;
constexpr int LQ_OFF = 2 * KV_BUF, LTAB_OFF = LQ_OFF + 64;
__device__ __forceinline__ void attn_queue_phase(CArgs* a, int layer, int inst, LAS unsigned char* lds, int wave) {
    unsigned char* ws = a->ws; const bf16* QKV = (const bf16*)(ws + A_QKV); bf16* O4 = (bf16*)(ws + A_O4); const float* biasT = (const float*)(ws + WS_BIAS);
    bf16* DILO = (bf16*)(ws + A_DIL + DILO_OFF); float* DILL = (float*)(ws + A_DIL + DILL_OFF);
    unsigned* qctr = (unsigned*)(ws + WS_CTL) + CW_QUEUE + inst * 64;
    LAS unsigned* LQ = (LAS unsigned*)(lds + LQ_OFF); LAS float* tabw = (LAS float*)(lds + LTAB_OFF);
    unsigned* cflag = (unsigned*)(ws + WS_CTL) + CW_CMPF + inst * 64;
    if (wave >= 4) __builtin_amdgcn_s_setprio(1);
    nsa_tables(a, lds, wave);
    if (wave == 0 && lane_id_l() == 0) LQ[0] = atomicAdd(qctr, 1u);
    __syncthreads();
    for (;;) {
        const int lane = lane_id_l(), tid = wave * 64 + lane, ql = lane & 31, h2 = lane >> 5, xaddr = (lane ^ 32) << 2;
        const int u = (int)LQ[0];
        __syncthreads();
        if (u >= U_ALL) break;
        unsigned nxt_u = 0u; if (tid == 0) nxt_u = atomicAdd(qctr, 1u);
        const int uu = u - U_CMP;
        if (uu >= 0 && uu < U_SB) {
            const int bh = uu % (4 * BH), h = bh & 3, b = bh >> 2, Qb = 7 - uu / (4 * BH);
            const int q0w = Qb * 256 + 32 * wave; const size_t rowb = (size_t)b * SEQ;
            bf16x8 q[4]; load_qfrag(q, QKV + (HT_SBQ + h) * HT_ELEMS + (rowb + q0w + ql) * 64, h2);
            const bf16* Kb = QKV + (HT_SBK + h) * HT_ELEMS + rowb * 64;
            const bf16* Vt = QKV + (HT_SBV + h) * HT_ELEMS + (size_t)b * 64 * SEQ;
            LAS unsigned* SBF = LQ + 336;
            f32x16 O0 = zero16(), O1 = zero16(); float R = 1.f;
            const int ktop = Qb * 256 + 192;
            Stage st; stage_load(st, tid, Kb, 64, Vt, SEQ, ktop); stage_store(st, tid, lds); __syncthreads();
            int par = 0;
            for (int k0 = ktop; k0 >= 0; k0 -= 64, par ^= 1) {
                const bool more = k0 >= 64;
                if (more) stage_load(st, tid, Kb, 64, Vt, SEQ, k0 - 64);
                const LAS unsigned char* buf = lds + par * KV_BUF;
#pragma unroll
                for (int sub = 1; sub >= 0; --sub) { const int ks = k0 + 32 * sub;
                    if (ks <= q0w) { KVFrag f; frag_read(f, buf, sub, ql, h2);
                        const f32x16 S = qk_tile(q, f.k);
                        float sg[16], om[16];
                        if (ks == q0w) {
                            const int base = ql - 8 * h2;
#pragma unroll
                            for (int r = 0; r < 16; ++r) { const float z2 = S[r] * (0.125f * 1.4426950408889634f); const bool valid = (base - KOFF(r)) >= 1, pos = z2 >= 0.f;
                                const float e = __builtin_amdgcn_exp2f(-fabsf(z2)), rr = __builtin_amdgcn_rcpf(1.f + e), er = e * rr;
                                sg[r] = valid ? (pos ? rr : er) : 0.f; om[r] = valid ? (pos ? er : rr) : 1.f; }
                        } else {
#pragma unroll
                            for (int r = 0; r < 16; ++r) { const float z2 = S[r] * (0.125f * 1.4426950408889634f); const bool pos = z2 >= 0.f;
                                const float e = __builtin_amdgcn_exp2f(-fabsf(z2)), rr = __builtin_amdgcn_rcpf(1.f + e), er = e * rr;
                                sg[r] = pos ? rr : er; om[r] = pos ? er : rr; }
                        }
                        float G0 = om[0], G1 = om[8];
#pragma unroll
                        for (int r = 1; r < 8; ++r) { G0 *= om[r]; G1 *= om[8 + r]; }
                        const float P0 = xpart_half(G0, h2), P1 = xpart_half(G1, h2);
                        const float aft0 = (h2 == 0) ? (P0 * G1 * P1) : (P1 * G1), aft1 = (h2 == 0) ? P1 : 1.f;
                        float p[16]; float w = aft0 * R;
#pragma unroll
                        for (int r = 7; r >= 0; --r) { p[r] = sg[r] * w; w *= om[r]; }
                        w = aft1 * R;
#pragma unroll
                        for (int r = 15; r >= 8; --r) { p[r] = sg[r] * w; w *= om[r]; }
                        R *= (G0 * P0) * (G1 * P1);
                        pv_tile(O0, O1, p, f.v); } }
                if (lane == 0) SBF[par * 8 + wave] = (k0 <= q0w && __all(R == 0.f)) ? 1u : 0u;
                if (more) stage_store(st, tid, lds + (par ^ 1) * KV_BUF);
                __syncthreads();
                { const LAS v4u* fv = (const LAS v4u*)(SBF + par * 8); const v4u fa = fv[0], fb = fv[1];
                  if ((fa.x & fa.y & fa.z & fa.w & fb.x & fb.y & fb.z & fb.w) != 0u) break; }
            }
            store_ot(O4 + (rowb + q0w + ql) * 1024 + 3 * 256 + h * 64, O0, O1, 1.f, h2);
        } else if (uu >= U_SB && uu < U_SB + U_NSA) {
            const int un = uu - U_SB, b = un % BH, tile = 31 - un / BH;
            if (tid == 0) { unsigned sp = 0;
                while (__hip_atomic_load(cflag + b, __ATOMIC_RELAXED, __HIP_MEMORY_SCOPE_AGENT) < 8u) { __builtin_amdgcn_s_sleep(2); if (++sp > (1u << 22)) break; }
                __builtin_amdgcn_fence(__ATOMIC_ACQUIRE, "agent"); asm volatile("s_waitcnt vmcnt(0)" ::: "memory"); }
            __syncthreads();
            nsa_unit(a, lds, wave, b, tile, lane, tid, ql, h2, xaddr);
        } else if (uu >= U_SB + U_NSA && uu < U_SB + U_NSA + U_DIL) {
            const int r0 = uu - U_SB - U_NSA; const int h = r0 & 3, b = (r0 >> 2) % BH, pb = (r0 / (4 * BH)) & 7, g = r0 / (32 * BH);
            const int dil = (g == 0) ? 1 : (g == 1) ? 4 : 16, L = SEQ / dil;
            const int p0 = pb * 256 + 32 * wave, res = p0 / L, i0 = p0 - res * L;
            const size_t rowb = (size_t)b * SEQ;
            const LAS float* tabd = (const LAS float*)(lds + L_TABS) + (4 + g * 4 + h) * TABS_N;
            const int tq = (i0 + ql) * dil + res;
            bf16x8 q[4]; load_qfrag(q, QKV + (HT_DILQ + g * 4 + h) * HT_ELEMS + (rowb + tq) * 64, h2);
            const int vslot = (g == 0) ? (HT_DILV + h) : (50 + h * 2 + (g - 1));
            AttnAcc A; acc_init(A);
            if (L >= 256) {
                const int res_b = (pb * 256) / L, ib = pb * 256 - res_b * L;
                const bf16* Kb = QKV + (HT_DILK + h) * HT_ELEMS + (rowb + res_b) * 64; const bf16* Vt = QKV + (size_t)vslot * HT_ELEMS + (size_t)b * 64 * SEQ + res_b * L;
                int kmin = (ib - 128) & ~63; if (kmin < 0) kmin = 0;
                band_block(A, q, lds, tid, Kb, (size_t)dil * 64, Vt, SEQ, i0, 128, kmin, ib + 192, tabd + 32, ql, h2, xaddr);
            } else {
#pragma unroll 1
                for (int half = 0; half < 2; ++half) { const int res_b = 2 * pb + half;
                    const bf16* Kb = QKV + (HT_DILK + h) * HT_ELEMS + (rowb + res_b) * 64; const bf16* Vt = QKV + (size_t)vslot * HT_ELEMS + (size_t)b * 64 * SEQ + res_b * L;
                    const bool mine = (wave >> 2) == half;
                    band_block(A, q, lds, tid, Kb, (size_t)dil * 64, Vt, SEQ, mine ? i0 : -4096, 128, 0, 64, tabd + 32, ql, h2, xaddr); }
            }
            const float lt = xsum_half(A.l);
            store_ot(DILO + ((size_t)g * TH + rowb + tq) * 256 + h * 64, A.O0, A.O1, 1.f / lt, h2);
            if (h2 == 0) DILL[((size_t)g * TH + rowb + tq) * 4 + h] = A.m * 0.6931471805599453f + __logf(lt);
        } else if (uu >= U_SB + U_NSA + U_DIL) {
            const int r0 = uu - U_SB - U_NSA - U_DIL; const int h = r0 & 3, b = (r0 >> 2) % BH, Qb = r0 / (4 * BH);
            const int q0w = Qb * 256 + 32 * wave; const size_t rowb = (size_t)b * SEQ;
            const LAS float* tabs = (const LAS float*)(lds + L_TABS) + h * TABS_N;
            bf16x8 q[4]; load_qfrag(q, QKV + (HT_SWAQ + h) * HT_ELEMS + (rowb + q0w + ql) * 64, h2);
            AttnAcc A; acc_init(A);
            int kmin = (Qb * 256 - 127) & ~63; if (kmin < 0) kmin = 0;
            band_block(A, q, lds, tid, QKV + (HT_SWAK + (h >> 1)) * HT_ELEMS + rowb * 64, 64, QKV + (HT_SWAV + (h >> 1)) * HT_ELEMS + (size_t)b * 64 * SEQ, SEQ, q0w, 127, kmin, Qb * 256 + 192, tabs + 32, ql, h2, xaddr);
            const float lt = xsum_half(A.l);
            const float sk = a->in[IN_SINK][layer * 4 + h] * 1.4426950408889634f; const float mf = fmaxf(A.m, sk); const float c0 = __builtin_amdgcn_exp2f(A.m - mf); const float den = lt * c0 + __builtin_amdgcn_exp2f(sk - mf);
            store_ot(O4 + (rowb + q0w + ql) * 1024 + 1 * 256 + h * 64, A.O0, A.O1, c0 / den, h2);
        } else {
            const int it = u; const int rt = it & 3, which = (it >> 2) & 1, b = it >> 3;
            bf16* kcb = (bf16*)(ws + WS_KC); bf16* vct = kcb + (size_t)BH * 128 * 64;
            const int i = rt * 32 + ql, ic = i > 126 ? 126 : i;
            const bf16* src = QKV + (HT_KCMP + which) * HT_ELEMS + ((size_t)b * SEQ + 16 * ic) * 64;
            const float* pe = a->in[IN_CPE] + ((size_t)layer * 2 + which) * 32 * 64;
            const bf16* w1t = (const bf16*)(ws + WS_C1) + ((size_t)layer * 2 + which) * 64 * 2048 + (size_t)ql * 2048;
            f32x16 H0 = zero16(), H1 = zero16();
#pragma unroll 1
            for (int ks0 = 16 * wave; ks0 < 16 * wave + 16; ks0 += 4) {
                v4u xa[4]; f32x4 pa[4], pb2[4]; bf16x8 a0[4], a1[4];
#pragma unroll
                for (int e = 0; e < 4; ++e) { const int k = 16 * (ks0 + e) + 8 * h2;
                    xa[e] = *(const GAS v4u*)(src + k); pa[e] = *(const GAS f32x4*)(pe + k); pb2[e] = *(const GAS f32x4*)(pe + k + 4);
                    a0[e] = *(const GAS bf16x8*)(w1t + k); a1[e] = *(const GAS bf16x8*)(w1t + 32 * 2048 + k); }
                __builtin_amdgcn_sched_barrier(0);
#pragma unroll
                for (int e = 0; e < 4; ++e) {
                    v4u xb; xb.x = cvtpk(bflo(xa[e].x) + pa[e].x, bfhi(xa[e].x) + pa[e].y); xb.y = cvtpk(bflo(xa[e].y) + pa[e].z, bfhi(xa[e].y) + pa[e].w);
                    xb.z = cvtpk(bflo(xa[e].z) + pb2[e].x, bfhi(xa[e].z) + pb2[e].y); xb.w = cvtpk(bflo(xa[e].w) + pb2[e].z, bfhi(xa[e].w) + pb2[e].w);
                    const bf16x8 bfr = __builtin_bit_cast(bf16x8, xb);
                    H0 = MFMA32(a0[e], bfr, H0); H1 = MFMA32(a1[e], bfr, H1); }
            }
            { LAS float* part = (LAS float*)(lds + L_BLKA);
              if (wave != 0) { _Pragma("unroll") for (int r = 0; r < 16; ++r) { part[(wave * 32 + r) * 64 + lane] = H0[r]; part[(wave * 32 + 16 + r) * 64 + lane] = H1[r]; } }
              __syncthreads();
              if (wave == 0) {
#pragma unroll 1
                  for (int w = 1; w < 8; ++w) { const LAS float* pw = part + (w * 32) * 64 + lane;
#pragma unroll
                      for (int r = 0; r < 16; ++r) { H0[r] += pw[r * 64]; H1[r] += pw[(16 + r) * 64]; } } } }
            if (wave == 0) {
            float g[32];
#pragma unroll
            for (int r = 0; r < 16; ++r) { const float x0 = H0[r], x1 = H1[r];
                g[r] = 0.5f * x0 * (1.f + tanhf(0.7978845608028654f * (x0 + 0.044715f * x0 * x0 * x0))); g[16 + r] = 0.5f * x1 * (1.f + tanhf(0.7978845608028654f * (x1 + 0.044715f * x1 * x1 * x1))); }
            const float* w2 = a->in[IN_CW2] + ((size_t)layer * 2 + which) * 64 * 64;
            f32x16 E0 = zero16(), E1 = zero16();
#pragma unroll
            for (int s = 0; s < 4; ++s) { v4u gw_; gw_.x = cvtpk(g[8 * s], g[8 * s + 1]); gw_.y = cvtpk(g[8 * s + 2], g[8 * s + 3]); gw_.z = cvtpk(g[8 * s + 4], g[8 * s + 5]); gw_.w = cvtpk(g[8 * s + 6], g[8 * s + 7]);
                const bf16x8 gb = __builtin_bit_cast(bf16x8, gw_);
                float wa[8], wb[8];
#pragma unroll
                for (int j = 0; j < 8; ++j) { const int n = 16 * s + 8 * (j >> 2) + 4 * h2 + (j & 3); wa[j] = w2[(size_t)n * 64 + ql]; wb[j] = w2[(size_t)n * 64 + 32 + ql]; }
                v4u ua, ub; ua.x = cvtpk(wa[0], wa[1]); ua.y = cvtpk(wa[2], wa[3]); ua.z = cvtpk(wa[4], wa[5]); ua.w = cvtpk(wa[6], wa[7]);
                ub.x = cvtpk(wb[0], wb[1]); ub.y = cvtpk(wb[2], wb[3]); ub.z = cvtpk(wb[4], wb[5]); ub.w = cvtpk(wb[6], wb[7]);
                E0 = MFMA32(__builtin_bit_cast(bf16x8, ua), gb, E0); E1 = MFMA32(__builtin_bit_cast(bf16x8, ub), gb, E1); }
            const float zs = (i > 126) ? 0.f : 1.f;
            if (which == 0) store_ot(kcb + ((size_t)b * 128 + i) * 64, E0, E1, zs, h2);
            else {
#pragma unroll
                for (int r = 0; r < 16; ++r) { const int m = (r & 3) + 8 * (r >> 2) + 4 * h2;
                    vct[((size_t)b * 64 + m) * 128 + i] = (bf16)f2bf(E0[r] * zs); vct[((size_t)b * 64 + 32 + m) * 128 + i] = (bf16)f2bf(E1[r] * zs); } }
            }
        }
        if (u < U_CMP) {
            asm volatile("s_waitcnt vmcnt(0)" ::: "memory"); __syncthreads();
            if (tid == 0) { __builtin_amdgcn_fence(__ATOMIC_RELEASE, "agent"); asm volatile("s_waitcnt vmcnt(0)" ::: "memory"); __hip_atomic_fetch_add(cflag + (u >> 3), 1u, __ATOMIC_RELAXED, __HIP_MEMORY_SCOPE_AGENT); } }
        if (tid == 0) LQ[0] = nxt_u;
        __syncthreads();
    }
    __builtin_amdgcn_s_setprio(0);
}


__device__ __forceinline__ void dil_merge_phase(CArgs* a, int G, int c, const int wave) {
    unsigned char* ws = a->ws; bf16* O4 = (bf16*)(ws + A_O4);
    {
        const bf16* DILO = (const bf16*)(ws + A_DIL + DILO_OFF); const float* DILL = (const float*)(ws + A_DIL + DILL_OFF);
        const int lane = lane_id_l(), gw = c * NWAVES + wave, NGW = G * NWAVES, hh = lane >> 4;
        for (int r0 = gw; r0 < TH; r0 += 8 * NGW) {
            float l0[8], l1[8], l2[8]; unsigned long long y0[8], y1[8], y2[8];
#pragma unroll
            for (int q = 0; q < 8; ++q) { const int r = r0 + q * NGW; const int rr = r < TH ? r : gw;
                l0[q] = DILL[((size_t)0 * TH + rr) * 4 + hh]; l1[q] = DILL[((size_t)1 * TH + rr) * 4 + hh]; l2[q] = DILL[((size_t)2 * TH + rr) * 4 + hh];
                y0[q] = *((const GAS unsigned long long*)(DILO + ((size_t)0 * TH + rr) * 256) + lane); y1[q] = *((const GAS unsigned long long*)(DILO + ((size_t)1 * TH + rr) * 256) + lane);
                y2[q] = *((const GAS unsigned long long*)(DILO + ((size_t)2 * TH + rr) * 256) + lane); }
            __builtin_amdgcn_sched_barrier(0);
#pragma unroll
            for (int q = 0; q < 8; ++q) { const int r = r0 + q * NGW; if (r >= TH) break;
                const float mx = fmaxf(l0[q], fmaxf(l1[q], l2[q])); const float e0 = __expf(l0[q] - mx), e1 = __expf(l1[q] - mx), e2 = __expf(l2[q] - mx); const float inv = 1.f / (e0 + e1 + e2);
                const float w0 = e0 * inv, w1 = e1 * inv, w2 = e2 * inv;
                const unsigned a0 = (unsigned)y0[q], b0 = (unsigned)(y0[q] >> 32), a1 = (unsigned)y1[q], b1 = (unsigned)(y1[q] >> 32), a2 = (unsigned)y2[q], b2 = (unsigned)(y2[q] >> 32);
                const unsigned o_lo = pk2(w0 * bflo(a0) + w1 * bflo(a1) + w2 * bflo(a2), w0 * bfhi(a0) + w1 * bfhi(a1) + w2 * bfhi(a2));
                const unsigned o_hi = pk2(w0 * bflo(b0) + w1 * bflo(b1) + w2 * bflo(b2), w0 * bfhi(b0) + w1 * bfhi(b1) + w2 * bfhi(b2));
                *((GAS unsigned long long*)(O4 + (size_t)r * 1024 + 2 * 256) + lane) = (unsigned long long)o_lo | ((unsigned long long)o_hi << 32); }
        }
    }
}

#ifndef PROBE_REP
#define PROBE_REP 0
#endif
#define NREP(k) ((PROBE_REP == (k) || (PROBE_REP == 20 && (k) == 20)) ? 2 : 1)
#ifndef PROBE_SKIP
#define PROBE_SKIP 0
#endif
#define SKIP(k) (PROBE_REP == 20 && PROBE_SKIP == (k) && pass_ == 0)
constexpr int PH_PER_LAYER = 27, PH_END = 1 + 2 * PH_PER_LAYER;
__global__ void __launch_bounds__(NWAVES * 64, 2) fwd(Args args_unused) {
    extern __shared__ __attribute__((aligned(16))) unsigned char lds_raw[];
    LAS unsigned char* lds = (LAS unsigned char*)lds_raw;
    volatile LAS unsigned* MISC = (volatile LAS unsigned*)(lds + MISC_OFF);
    const int GK = gridDim.x, cK = blockIdx.x;
    const int wave_s = __builtin_amdgcn_readfirstlane(threadIdx.x >> 6);
    for (int u = threadIdx.x; u < (LDS_BYTES - MISC_OFF) / 4; u += NWAVES * 64) ((LAS unsigned*)(lds + MISC_OFF))[u] = 0u;
    __syncthreads();
    int lo, hi;
    XcdBarrier bar;
    { CArgs* a = get_args(); lo = a->ph_lo; hi = a->ph_hi; unsigned* ctl0 = (unsigned*)(a->ws + WS_CTL);
      bar.bar = ctl0 + CW_BAR; bar.x = 0; bar.st = MISC + 8;
      if (hi - lo > 1) bar = xcd_barrier_post(ctl0 + CW_BAR, MISC + 8); }
#define IN(k) ({ int l_ = lo, h_ = hi; asm volatile("" : "+s"(l_), "+s"(h_)); (l_ <= (k)) && ((k) < h_); })
#define SEAM(k) do { int h_ = hi; asm volatile("" : "+s"(h_)); if ((k) + 1 < h_) { xcd_barrier(bar, wave_s); if (PROBE_REP == 10) xcd_barrier(bar, wave_s); } } while (0)
#define PHASE_VARS CArgs* a = get_args(); unsigned char* ws = a->ws; int G = GK, c = cK; asm volatile("" : "+s"(G), "+s"(c)); \
    const int NGW = G * NWAVES, lane = lane_id_l(), wave = wave_s, tid = wave_s * 64 + lane, gw = c * NWAVES + wave; (void)lane; (void)gw; (void)ws; (void)tid; (void)NGW;
#define SKIPSEAM(k, id) if (SKIP(k) && IN(id)) { SEAM(id); }
#define WPTR(off) ((const bf16*)(ws + WS_W + (off)))

    if (IN(0)) { _Pragma("unroll") for (int rep_ = 0; rep_ < NREP(1); ++rep_) { PHASE_VARS p0_prologue<0>(a, lds, G, c, wave_s); } SEAM(0); }

    for (int pass_ = 0; pass_ < NREP(20); ++pass_)
    for (int layer = 0; layer < 2; ++layer) {
        const int pb = 1 + layer * PH_PER_LAYER;
        for (int hf = 0; hf < NHALF; ++hf) {
            const int p = pb + 7 * hf;
            if (layer == 0 && IN(p + 0) && !SKIP(11)) { _Pragma("unroll") for (int rep_ = 0; rep_ < NREP(11); ++rep_) { PHASE_VARS
                ln_mod_phase((layer == 0) ? a->in[IN_X] : a->out, (const float*)(ws + WS_MOD) + (size_t)layer * 16 * 6144, (bf16*)(ws + A_HY), hf, G, c, wave, lane, lds); } SEAM(p + 0); }
            if (layer == 0) { SKIPSEAM(11, p + 0) }
            if (IN(p + 1) && !SKIP(4)) { _Pragma("unroll") for (int rep_ = 0; rep_ < NREP(4); ++rep_) { PHASE_VARS
                pg8::Gemm g{(const bf16*)(ws + A_HY), WPTR(W_IN + layer * W_IN_L), TH, D, D}; pg8::InProjOrder S; S.init(TH, 14 * 256, G, c, D);
                pg8::EpiInProj E{(bf16*)(ws + A_QKV), (float*)(ws + WS_NG), HT_ELEMS};
                pg8::gemm_phase<pg8::EpiInProj, pg8::InProjOrder, true, true>(lds, g, S, E, wave_s); }
                SEAM(p + 1);
            }
            SKIPSEAM(4, p + 1)
            if (IN(p + 2) && !SKIP(2)) { _Pragma("unroll") for (int rep_ = 0; rep_ < NREP(2); ++rep_) { PHASE_VARS attn_queue_phase(a, layer, layer + 4 * rep_ + 8 * pass_, lds, wave_s); } SEAM(p + 2); }
            SKIPSEAM(2, p + 2)
            if (IN(p + 3) && !SKIP(3)) { _Pragma("unroll") for (int rep_ = 0; rep_ < NREP(3); ++rep_) { PHASE_VARS dil_merge_phase(a, G, c, wave_s); } SEAM(p + 3); }
            SKIPSEAM(3, p + 3)
            if (IN(p + 4) && !SKIP(5)) { _Pragma("unroll") for (int rep_ = 0; rep_ < NREP(5); ++rep_) { PHASE_VARS
                pg8::Gemm g{(const bf16*)(ws + A_HY), WPTR(W_IN + layer * W_IN_L + W_GATE), TH, D, D};
                const int vc = (G % 8 == 0) ? (c % 8) * (G / 8) + c / 8 : c;
                pg8::MergeOrder S{(TH / 256) * 4, G, vc, (int)((A_O4 - A_HY) / TILE_B), 17};
                pg8::EpiMerge E{(bf16*)(ws + A_MERGED), (bf16*)(ws + A_PS) + (size_t)c * 131072, (int)((A_O4 - A_HY) / TILE_B), 17};
                pg8::gemm_phase<pg8::EpiMerge, pg8::MergeOrder, true, true>(lds, g, S, E, wave_s); }
                SEAM(p + 4);
            }
            SKIPSEAM(5, p + 4)
            if (IN(p + 5) && !SKIP(6)) { _Pragma("unroll") for (int rep_ = 0; rep_ < NREP(6); ++rep_) { PHASE_VARS
                pg8::Gemm g{(const bf16*)(ws + A_MERGED), WPTR(W_OUT + layer * W_OUT_L), TH, D, D}; pg8::StaticOrder S; S.init(TH, D, G, c, D);
                pg8::EpiBf16 E{(bf16*)(ws + A_HY), D, 1 << 20, 1 << 30, 0};
                pg8::gemm_phase<pg8::EpiBf16, pg8::StaticOrder, true, true>(lds, g, S, E, wave_s); }
                SEAM(p + 5);
            }
            SKIPSEAM(6, p + 5)
            if (IN(p + 6) && !(SKIP(12) && layer == 0)) { PHASE_VARS
                const float* mod_l = (const float*)(ws + WS_MOD) + (size_t)layer * 16 * 6144;
                const float* lng = a->in[IN_LNG] + (size_t)(layer * 2 + 0) * D; const float* lnb = a->in[IN_LNB] + (size_t)(layer * 2 + 0) * D;
                if (layer == 0) post_norm_phase<0, true, false>(a, a->in[IN_X], a->out, (const bf16*)(ws + A_HY), (size_t)hf * TH, mod_l + 2048, lng, lnb, mod_l + 3072, (bf16*)(ws + A_H2), hf * TH, TH, G, c, wave, lane, CW_CNT + 32 * pass_, lds);
                else            post_norm_phase<0, true, true >(a, a->out, a->out, (const bf16*)(ws + A_HY), (size_t)hf * TH, mod_l + 2048, lng, lnb, mod_l + 3072, (bf16*)(ws + A_H2), hf * TH, TH, G, c, wave, lane, CW_CNT + 32 * pass_, lds);
                SEAM(p + 6);
            }
            if (SKIP(12) && layer == 0 && IN(p + 6)) { SEAM(p + 6); }
        }
        const int pf = pb + 14;
        if (layer == 0) {
            if (IN(pf + 0) && !SKIP(7)) { _Pragma("unroll") for (int rep_ = 0; rep_ < NREP(7); ++rep_) { PHASE_VARS
                pg8::Gemm g{(const bf16*)(ws + A_H2), WPTR(W_GU), T, D, D}; pg8::StaticOrder S; S.init(T, 2 * DFF, G, c, D);
                pg8::EpiSwiGLU E{(bf16*)(ws + A_ACT), DFF, 1 << 20};
                pg8::gemm_phase<pg8::EpiSwiGLU, pg8::StaticOrder, true, true>(lds, g, S, E, wave_s); }
                SEAM(pf + 0);
            }
            SKIPSEAM(7, pf + 0)
            if (IN(pf + 1) && !SKIP(7)) { _Pragma("unroll") for (int rep_ = 0; rep_ < NREP(7); ++rep_) { PHASE_VARS
                pg8::Gemm g{(const bf16*)(ws + A_ACT), WPTR(W_DN), T, DFF, DFF}; pg8::StaticOrder S; S.init(T, D, G, c, DFF);
                pg8::EpiBf16 E{(bf16*)(ws + A_Y2), D, 1 << 20, 1 << 30, 0};
                pg8::gemm_phase<pg8::EpiBf16, pg8::StaticOrder, true, true>(lds, g, S, E, wave_s); }
                SEAM(pf + 1);
            }
            SKIPSEAM(7, pf + 1)
            if (IN(pf + 2) && !SKIP(13)) { PHASE_VARS
                const float* mod_l = (const float*)(ws + WS_MOD) + (size_t)layer * 16 * 6144;
                const float* lng = a->in[IN_LNG] + (size_t)(layer * 2 + 1) * D; const float* lnb = a->in[IN_LNB] + (size_t)(layer * 2 + 1) * D;
                post_norm_phase<0, true, false>(a, a->out, a->out, (const bf16*)(ws + A_Y2), 0, mod_l + 5120, lng, lnb, mod_l + 16 * 6144  , (bf16*)(ws + A_HY), 0, T, G, c, wave, lane, CW_CNT + 32 * pass_, lds);
                SEAM(pf + 2);
            }
            SKIPSEAM(13, pf + 2)
        } else {
            if (IN(pf + 0) && !SKIP(13)) { PHASE_VARS p0_prologue<1>(a, lds, G, c, wave_s); moe_sort_phase(a, (const bf16*)(ws + A_H2), (bf16*)(ws + A_AS), 0, gw, NGW, lane, CW_CNT + 32 * pass_); SEAM(pf + 0); }
            SKIPSEAM(13, pf + 0)
            for (int ch = 0; ch < NCHUNK; ++ch) {
                const int pc = pf + 1 + 3 * ch;
#define LOAD_NT int nt[8]; { const unsigned* cnt = (const unsigned*)(ws + WS_CTL) + CW_CNT + 32 * pass_ + ch * 8; _Pragma("unroll") for (int e = 0; e < 8; ++e) nt[e] = ((int)__builtin_amdgcn_readfirstlane(cnt[e]) + 255) >> 8; }
#define DYN_GROUPS(ctrw, ...) { unsigned* dctr_ = (unsigned*)(ws + WS_CTL) + (ctrw); for (;;) { if (wave_s == 0 && lane == 0) MISC[20] = atomicAdd(dctr_, 1u); __syncthreads(); const int grp = (int)MISC[20]; __syncthreads(); if (grp >= TCH / 32) break; __VA_ARGS__ } }
                if (IN(pc + 0) && !SKIP(8)) { _Pragma("unroll") for (int rep_ = 0; rep_ < NREP(8); ++rep_) { PHASE_VARS LOAD_NT
                    pg8::Gemm g{(const bf16*)(ws + A_AS), (const bf16*)(ws + A_MGU), CH_ROWS, D, D};
                    pg8::GroupedOrder S{nt[0], nt[1], nt[2], nt[3], nt[4], nt[5], nt[6], nt[7], 2 * DFFE / 256, G, (G % 8 == 0) ? (c % 8) * (G / 8) + c / 8 : c, 1, D};
                    pg8::EpiSwiGLU E{(bf16*)(ws + A_ACTE), DFFE, 2 * DFFE / 256};
                    pg8::gemm_phase<pg8::EpiSwiGLU, pg8::GroupedOrder, true, true>(lds, g, S, E, wave_s); }
                    if (ch == 0) { PHASE_VARS
                        DYN_GROUPS(CW_DYN + (8 * pass_ + 0) * 64, p0_prologue<2>(a, lds, TCH / 32, grp, wave_s);) }
                    if (ch > 0) { PHASE_VARS
                        const float* mod_l = (const float*)(ws + WS_MOD) + (size_t)layer * 16 * 6144;
                        const float* lng = a->in[IN_LNG] + (size_t)(layer * 2 + 1) * D; const float* lnb = a->in[IN_LNB] + (size_t)(layer * 2 + 1) * D;
                        DYN_GROUPS(CW_DYN + (8 * pass_ + ch) * 64, post_norm_phase<1, false, false>(a, a->out, a->out, (const bf16*)(ws + A_YP), 0, mod_l + 5120, lng, lnb, mod_l, nullptr, (ch - 1) * TCH, TCH, TCH / 32, grp, wave, lane, CW_CNT + 32 * pass_, lds, G);) }
                    SEAM(pc + 0);
                }
                SKIPSEAM(8, pc + 0)
                if (IN(pc + 1) && !SKIP(9)) { _Pragma("unroll") for (int rep_ = 0; rep_ < NREP(9); ++rep_) { PHASE_VARS LOAD_NT
                    pg8::Gemm g{(const bf16*)(ws + A_ACTE), (const bf16*)(ws + A_MDN), CH_ROWS, DFFE, DFFE};
                    const int ntl_ = (nt[0] + nt[1] + nt[2] + nt[3] + nt[4] + nt[5] + nt[6] + nt[7]) * (D / 256), R_ = ntl_ / G, lft_ = ntl_ - R_ * G;
                    pg8::TailSplitOrder S{nt[0], nt[1], nt[2], nt[3], nt[4], nt[5], nt[6], nt[7], D / 256, G, (G % 8 == 0) ? (c % 8) * (G / 8) + c / 8 : c, DFFE, DFFE / KSPLIT, R_, lft_, lft_ * KSPLIT};
                    pg8::EpiBf16P E{(bf16*)(ws + A_YP), (bf16*)(ws + A_YP + YPX_OFF), D, nt[0], nt[1], nt[2], nt[3], nt[4], nt[5], nt[6], nt[7], D / 256, R_ * G, lft_, DFFE / KSPLIT};
                    pg8::gemm_phase<pg8::EpiBf16P, pg8::TailSplitOrder, true, true>(lds, g, S, E, wave_s); }
                    if (ch + 1 < NCHUNK) { PHASE_VARS
                        DYN_GROUPS(CW_DYN + (8 * pass_ + 4 + ch) * 64, moe_sort_phase(a, (const bf16*)(ws + A_H2), (bf16*)(ws + A_AS), ch + 1, grp * NWAVES + wave, (TCH / 32) * NWAVES, lane, CW_CNT + 32 * pass_);) }
                    SEAM(pc + 1);
                }
                SKIPSEAM(9, pc + 1)
                if (IN(pc + 2) && !SKIP(13) && ch + 1 == NCHUNK) { PHASE_VARS
                    const float* mod_l = (const float*)(ws + WS_MOD) + (size_t)layer * 16 * 6144;
                    const float* lng = a->in[IN_LNG] + (size_t)(layer * 2 + 1) * D; const float* lnb = a->in[IN_LNB] + (size_t)(layer * 2 + 1) * D;
                    post_norm_phase<1, false, false>(a, a->out, a->out, (const bf16*)(ws + A_YP), 0, mod_l + 5120, lng, lnb, mod_l, nullptr, ch * TCH, TCH, G, c, wave, lane, CW_CNT + 32 * pass_, lds);
                }
#undef DYN_GROUPS
            }
        }
    }
#undef IN
#undef SEAM
}

#ifndef MK_PER_PHASE
#define MK_PER_PHASE 0
#endif
extern "C" void kernel_launch(void* const* d_in, const int* in_sizes, int n_in, void* d_out, int out_size, void* d_ws, size_t ws_size, hipStream_t stream) {
    static int grid = 0;
    if (grid == 0) {
        if (n_in != 21 || out_size != T * D || ws_size < WS_END) { fprintf(stderr, "kernel_launch: unexpected shapes (n_in %d out %d ws %zu need %zu)\n", n_in, out_size, ws_size, (size_t)WS_END); grid = -1; return; }
        int dev = 0, cus = 0, per_cu = 0;
        if (hipGetDevice(&dev) != hipSuccess || hipDeviceGetAttribute(&cus, hipDeviceAttributeMultiprocessorCount, dev) != hipSuccess) { grid = -1; return; }
        if (hipFuncSetAttribute((const void*)fwd, hipFuncAttributeMaxDynamicSharedMemorySize, LDS_BYTES) != hipSuccess) { fprintf(stderr, "kernel_launch: hipFuncSetAttribute failed\n"); grid = -1; return; }
        if (hipOccupancyMaxActiveBlocksPerMultiprocessor(&per_cu, (const void*)fwd, NWAVES * 64, LDS_BYTES) != hipSuccess || per_cu < 1) fprintf(stderr, "kernel_launch: occupancy query reports %d\n", per_cu);
        (void)hipGetLastError();
        grid = cus;
    }
    if (grid < 0) return;
    if (hipMemsetAsync((char*)d_ws + WS_CTL, 0, CTL_ZERO_BYTES, stream) != hipSuccess) return;
    Args a{};
    for (int i = 0; i < 21; ++i) a.in[i] = (const float*)d_in[i];
    a.out = (float*)d_out; a.ws = (unsigned char*)d_ws;
#if MK_PER_PHASE
    for (int ph = 0; ph < PH_END; ++ph) {
        const int k = (ph - 1) % PH_PER_LAYER, layer = (ph - 1) / PH_PER_LAYER;
        if (ph > 0 && layer == 0 && k > 16) continue;
        a.ph_lo = ph; a.ph_hi = ph + 1;
        hipLaunchKernelGGL(fwd, dim3(grid), dim3(NWAVES * 64), LDS_BYTES, stream, a);
    }
#else
    a.ph_lo = 0; a.ph_hi = PH_END;
    hipLaunchKernelGGL(fwd, dim3(grid), dim3(NWAVES * 64), LDS_BYTES, stream, a);
#endif
}
```
